# Optimizing an MI355X kernel written in HIP

```python
import jax, jax.numpy as jnp
from jax import lax
import numpy as np

D_MODEL = 1024
BATCH = 2
SEQ = 8192
DEPTH = 2

N_MOD = 6
CONV_CH = 512
CONV_WIDTH = 31
N_HEADS = 8
HEAD_DIM = 64
ATTN_W = N_HEADS * HEAD_DIM
IDX_HEADS = 8
IDX_DIM = 32
TOPK_MAX = 256
Q_BLOCK = 128
ROPE_THETA = 10000.0
INDEX_SCALE = (IDX_DIM ** -0.5) * (IDX_HEADS ** -0.5)
N_BRANCH = 2
N_GROUPS = 4
EXPERTS_PER_GROUP = 8
N_EXPERTS = N_GROUPS * EXPERTS_PER_GROUP
TOP_K_INNER = 2
D_EXPERT = 256
EPS = 1e-6

IN_SIZES = (CONV_CH, CONV_CH, ATTN_W, HEAD_DIM, HEAD_DIM, IDX_HEADS * IDX_DIM, IDX_DIM, IDX_HEADS, N_BRANCH * D_MODEL)
N_IN = 2 * CONV_CH + ATTN_W + 2 * HEAD_DIM + IDX_HEADS * IDX_DIM + IDX_DIM + IDX_HEADS + N_BRANCH * D_MODEL

kernel_name = "hybrid_conformer_dsa_hmoe_adaln"


def rms_norm(x, g):
    x32 = x.astype(jnp.float32)
    y = x32 * lax.rsqrt(jnp.mean(x32 * x32, axis=-1, keepdims=True) + EPS)
    return (y * g.astype(jnp.float32)).astype(x.dtype)


def layer_norm(x, g, b):
    x32 = x.astype(jnp.float32)
    mu = jnp.mean(x32, axis=-1, keepdims=True)
    xc = x32 - mu
    y = xc * lax.rsqrt(jnp.mean(xc * xc, axis=-1, keepdims=True) + EPS)
    return (y * g.astype(jnp.float32) + b.astype(jnp.float32)).astype(x.dtype)


def rope_tables(length, dim):
    pos = jnp.arange(length, dtype=jnp.float32)
    inv = ROPE_THETA ** (-jnp.arange(0, dim, 2, dtype=jnp.float32) / dim)
    ang = pos[:, None] * inv[None, :]
    return jnp.cos(ang), jnp.sin(ang)


def apply_rope(x, cos, sin):
    L = x.shape[1]
    half = x.shape[-1] // 2
    shp = (1, L) + (1,) * (x.ndim - 3) + (half,)
    cos = cos.reshape(shp)
    sin = sin.reshape(shp)
    x1 = x[..., :half].astype(jnp.float32)
    x2 = x[..., half:].astype(jnp.float32)
    out = jnp.concatenate([x1 * cos - x2 * sin, x2 * cos + x1 * sin], axis=-1)
    return out.astype(x.dtype)


def conformer_conv(a, b, conv_w, conv_b, ln_g, ln_b, w_o, b_o):
    u = a * jax.nn.sigmoid(b)
    y = lax.conv_general_dilated(
        u, conv_w[:, None, :], window_strides=(1,),
        padding=[(CONV_WIDTH - 1, 0)],
        dimension_numbers=("NWC", "WIO", "NWC"),
        feature_group_count=CONV_CH) + conv_b
    y = jax.nn.silu(layer_norm(y, ln_g, ln_b))
    return y @ w_o + b_o


def dsa_attention(q, k, v, iq, ik, iw, w_o):
    B, L = q.shape[0], q.shape[1]
    k_sel = min(TOPK_MAX, L // 4)
    qb = min(Q_BLOCK, L)
    n_blocks = L // qb
    scale = HEAD_DIM ** -0.5
    key_pos = jnp.arange(L)

    def block(i):
        start = i * qb
        q_blk = lax.dynamic_slice_in_dim(q, start, qb, axis=1)
        iq_blk = lax.dynamic_slice_in_dim(iq, start, qb, axis=1)
        iw_blk = lax.dynamic_slice_in_dim(iw, start, qb, axis=1)
        t = start + jnp.arange(qb)
        rel = jax.nn.relu(jnp.einsum("bqhd,bsd->bqhs", iq_blk, ik).astype(jnp.float32))
        score = jnp.einsum("bqhs,bqh->bqs", rel, iw_blk.astype(jnp.float32)) * INDEX_SCALE
        causal = key_pos[None, :] <= t[:, None]
        score = jnp.where(causal[None], score, -jnp.inf)
        _, idx = lax.top_k(score, k_sel)
        valid = idx <= t[None, :, None]
        k_g = jax.vmap(lambda kk, ii: kk[ii])(k, idx)
        v_g = jax.vmap(lambda vv, ii: vv[ii])(v, idx)
        s = jnp.einsum("bqhd,bqkd->bqhk", q_blk, k_g).astype(jnp.float32) * scale
        s = jnp.where(valid[:, :, None, :], s, -jnp.inf)
        p = jax.nn.softmax(s, axis=-1).astype(v.dtype)
        return jnp.einsum("bqhk,bqkd->bqhd", p, v_g)

    out = lax.map(block, jnp.arange(n_blocks))
    out = jnp.transpose(out, (1, 0, 2, 3, 4)).reshape(B, L, ATTN_W)
    return out @ w_o


def hierarchical_moe(h, w_group, b_group, w_router, b_router, w_gate, w_up, w_down):
    B, L, D = h.shape
    t = h.reshape(B * L, D)
    T = B * L
    g_logits = (t @ w_group + b_group).astype(jnp.float32)
    g_prob = jax.nn.softmax(g_logits, axis=-1)
    g_sel = jnp.argmax(g_logits, axis=-1)
    p_group = jnp.take_along_axis(g_prob, g_sel[:, None], axis=-1)
    e_logits = (t @ w_router + b_router).astype(jnp.float32).reshape(T, N_GROUPS, EXPERTS_PER_GROUP)
    e_in = jnp.take_along_axis(e_logits, g_sel[:, None, None], axis=1)[:, 0]
    top_v, top_i = lax.top_k(e_in, TOP_K_INNER)
    p_in = jax.nn.softmax(top_v, axis=-1)
    expert_id = g_sel[:, None] * EXPERTS_PER_GROUP + top_i
    combine = jnp.sum(jax.nn.one_hot(expert_id, N_EXPERTS, dtype=jnp.float32)
                      * (p_group * p_in)[..., None], axis=1).astype(h.dtype)
    y = jnp.zeros_like(t)
    for e in range(N_EXPERTS):
        hid = jax.nn.silu(t @ w_gate[e]) * (t @ w_up[e])
        y = y + combine[:, e:e + 1] * (hid @ w_down[e])
    return y.reshape(B, L, D)


def setup_inputs(seed: int = 0) -> dict:
    key = jax.random.key(seed)
    ks = jax.random.split(key, 32)
    f32 = jnp.float32

    def nrm(k, shape, scale):
        return jax.random.normal(k, shape, f32) * scale

    D = D_MODEL
    return {
        "x": nrm(ks[0], (BATCH, SEQ, D), 1.0),
        "c": nrm(ks[1], (BATCH, D), 1.0),
        "w_ada": nrm(ks[2], (DEPTH, D, N_MOD * D), 0.5 * D ** -0.5),
        "b_ada": nrm(ks[3], (DEPTH, N_MOD * D), 0.02),
        "g_norm1": 1.0 + nrm(ks[4], (DEPTH, D), 0.02),
        "w_in": nrm(ks[5], (DEPTH, D, N_IN), D ** -0.5),
        "q_norm_g": 1.0 + nrm(ks[6], (DEPTH, HEAD_DIM), 0.02),
        "k_norm_g": 1.0 + nrm(ks[7], (DEPTH, HEAD_DIM), 0.02),
        "conv_w": nrm(ks[8], (DEPTH, CONV_WIDTH, CONV_CH), CONV_WIDTH ** -0.5),
        "conv_b": nrm(ks[9], (DEPTH, CONV_CH), 0.02),
        "conv_ln_g": 1.0 + nrm(ks[10], (DEPTH, CONV_CH), 0.02),
        "conv_ln_b": nrm(ks[11], (DEPTH, CONV_CH), 0.02),
        "w_conv_out": nrm(ks[12], (DEPTH, CONV_CH, D), CONV_CH ** -0.5),
        "b_conv_out": nrm(ks[13], (DEPTH, D), 0.02),
        "w_attn_out": nrm(ks[14], (DEPTH, ATTN_W, D), ATTN_W ** -0.5),
        "w_out": nrm(ks[15], (DEPTH, D, D), D ** -0.5),
        "g_norm2": 1.0 + nrm(ks[16], (DEPTH, D), 0.02),
        "w_group": nrm(ks[17], (DEPTH, D, N_GROUPS), D ** -0.5),
        "b_group": nrm(ks[18], (DEPTH, N_GROUPS), 0.01),
        "w_router": nrm(ks[19], (DEPTH, D, N_EXPERTS), D ** -0.5),
        "b_router": nrm(ks[20], (DEPTH, N_EXPERTS), 0.01),
        "w_gate": nrm(ks[21], (DEPTH, N_EXPERTS, D, D_EXPERT), D ** -0.5),
        "w_up": nrm(ks[22], (DEPTH, N_EXPERTS, D, D_EXPERT), D ** -0.5),
        "w_down": nrm(ks[23], (DEPTH, N_EXPERTS, D_EXPERT, D), D_EXPERT ** -0.5),
    }


def reference(x, c, w_ada, b_ada, g_norm1, w_in, q_norm_g, k_norm_g, conv_w, conv_b,
              conv_ln_g, conv_ln_b, w_conv_out, b_conv_out, w_attn_out, w_out, g_norm2,
              w_group, b_group, w_router, b_router, w_gate, w_up, w_down):
    B, L, D = x.shape
    cos_h, sin_h = rope_tables(L, HEAD_DIM)
    cos_i, sin_i = rope_tables(L, IDX_DIM)
    split_at = [int(s) for s in np.cumsum(IN_SIZES)[:-1]]
    for l in range(DEPTH):
        mod = jax.nn.silu(c) @ w_ada[l] + b_ada[l]
        shift1, scale1, gate1, shift2, scale2, gate2 = jnp.split(mod, N_MOD, axis=-1)

        h = rms_norm(x, g_norm1[l]) * (1.0 + scale1[:, None]) + shift1[:, None]
        u = h @ w_in[l]
        ca, cb, uq, uk, uv, uiq, uik, uiw, ug = jnp.split(u, split_at, axis=-1)

        y_conv = conformer_conv(ca, cb, conv_w[l], conv_b[l], conv_ln_g[l], conv_ln_b[l],
                                w_conv_out[l], b_conv_out[l])

        q = apply_rope(rms_norm(uq.reshape(B, L, N_HEADS, HEAD_DIM), q_norm_g[l]), cos_h, sin_h)
        k = apply_rope(rms_norm(uk, k_norm_g[l]), cos_h, sin_h)
        iq = apply_rope(uiq.reshape(B, L, IDX_HEADS, IDX_DIM), cos_i, sin_i)
        ik = apply_rope(uik, cos_i, sin_i)
        y_attn = dsa_attention(q, k, uv, iq, ik, uiw, w_attn_out[l])

        gates = jax.nn.sigmoid(ug.reshape(B, L, N_BRANCH, D))
        merged = (gates[:, :, 0] * y_conv + gates[:, :, 1] * y_attn) @ w_out[l]
        x = x + gate1[:, None] * merged

        h2 = rms_norm(x, g_norm2[l]) * (1.0 + scale2[:, None]) + shift2[:, None]
        x = x + gate2[:, None] * hierarchical_moe(h2, w_group[l], b_group[l], w_router[l],
                                                   b_router[l], w_gate[l], w_up[l], w_down[l])
    return x
```

```cpp
#include <hip/hip_runtime.h>
#include <hip/hip_cooperative_groups.h>
#include <cstdio>
#include <cstdint>
namespace cg = cooperative_groups;

#ifndef ONE_LAUNCH
#define ONE_LAUNCH 0
#endif

#define LAS __attribute__((address_space(3)))
typedef unsigned short bf16_t;
typedef short bf16x8 __attribute__((ext_vector_type(8)));
typedef float f32x4 __attribute__((ext_vector_type(4)));
typedef float f32x2 __attribute__((ext_vector_type(2)));
typedef unsigned u32x4 __attribute__((ext_vector_type(4)));
typedef unsigned u32x2 __attribute__((ext_vector_type(2)));
typedef int i32x4 __attribute__((ext_vector_type(4)));

constexpr int NB = 2, L = 8192, T = NB * L, D = 1024;
constexpr int NTHREADS = 512, NWAVES = 8;
constexpr int CONV_CH = 512, CONV_W = 31;
constexpr int NH = 8, HD = 64, AW = 512;
constexpr int IH = 8, IDIM = 32;
constexpr int TOPK = 256;
constexpr int NE = 32, EPG = 8, NG = 4, DE = 256;
constexpr int NIN = 4008, NINP = 4096;
constexpr float EPS = 1e-6f;
constexpr int MAXSLOT = T * 2 + NE * 256;
constexpr int NPH = 22;

constexpr size_t MiB = 1u << 20;
constexpr size_t WS_CTL = 0;
constexpr size_t CTL_ZERO = 256 * 1024;
constexpr size_t CTL_CNT = 4096;
constexpr size_t CTL_MOD = 65536;
constexpr size_t WS_TAB = 1 * MiB;
constexpr size_t WS_WIN = 4 * MiB;
constexpr size_t WS_WCA = 20 * MiB;
constexpr size_t WS_WO = 24 * MiB;
constexpr size_t WS_WGU = 28 * MiB;
constexpr size_t WS_WD = 60 * MiB;
constexpr size_t WS_H = 76 * MiB;
constexpr size_t WS_UGLU = 108 * MiB;
constexpr size_t WS_RAW = 124 * MiB;
constexpr size_t WS_GATES = 188 * MiB;
constexpr size_t WS_QN = 252 * MiB;
constexpr size_t WS_KN = 268 * MiB;
constexpr size_t WS_VB = 270 * MiB;
constexpr size_t WS_IQ = 272 * MiB;
constexpr size_t WS_IK = 280 * MiB;
constexpr size_t WS_IW = 281 * MiB;
constexpr size_t WS_YO = 282 * MiB;
constexpr size_t WS_ROUTE = 314 * MiB;
constexpr size_t WS_ROWL = 315 * MiB;
constexpr size_t WS_END = 316 * MiB;
constexpr size_t WS_H2 = WS_RAW;
constexpr size_t WS_HID = 156 * MiB;
constexpr size_t WS_YS = 188 * MiB;

constexpr int LDS_BYTES = 160 * 1024;

__device__ __forceinline__ unsigned f2bf(float f) { unsigned u = __float_as_uint(f); return (u + 0x7fffu + ((u >> 16) & 1u)) >> 16; }
__device__ __forceinline__ unsigned pk2(float lo, float hi) { return f2bf(lo) | (f2bf(hi) << 16); }
__device__ __forceinline__ float bflo(unsigned w) { return __uint_as_float(w << 16); }
__device__ __forceinline__ float bfhi(unsigned w) { return __uint_as_float(w & 0xffff0000u); }
__device__ __forceinline__ float bf2f(bf16_t h) { return __uint_as_float((unsigned)h << 16); }
__device__ __forceinline__ float sigmoidf_(float x) { return 1.f / (1.f + __expf(-x)); }
__device__ __forceinline__ float siluf_(float x) { return x / (1.f + __expf(-x)); }
__device__ __forceinline__ unsigned lds_add(LAS unsigned* p, unsigned v) { return __hip_atomic_fetch_add(p, v, __ATOMIC_RELAXED, __HIP_MEMORY_SCOPE_WORKGROUP); }
__device__ __forceinline__ int lds_addi(LAS int* p, int v) { return __hip_atomic_fetch_add(p, v, __ATOMIC_RELAXED, __HIP_MEMORY_SCOPE_WORKGROUP); }
__device__ __forceinline__ float wave_sum(float v) {
#pragma unroll
    for (int o = 1; o < 64; o <<= 1) v += __shfl_xor(v, o);
    return v;
}
__device__ __forceinline__ float wave_max(float v) {
#pragma unroll
    for (int o = 1; o < 64; o <<= 1) v = fmaxf(v, __shfl_xor(v, o));
    return v;
}

struct Params { const float* in[24]; float* out; unsigned char* ws; int ph_lo, ph_hi; };

struct Ctx {
    const float* const* in; float* out; unsigned char* ws;
    LAS unsigned char* lds;
    int tid, lane, wave, bid, nb;
};

__device__ __forceinline__ void transpose_item(const float* W, int ldw, int k0, int c0, int ncol, bf16_t* WT, int ldt, int r0, int kdst0, LAS float* scr, int lane) {
#pragma unroll 8
    for (int i = 0; i < 32; ++i) { const int kk = 2 * i + (lane >> 5), j = lane & 31; scr[kk * 33 + j] = (j < ncol) ? W[(size_t)(k0 + kk) * ldw + c0 + j] : 0.f; }
    asm volatile("s_waitcnt lgkmcnt(0)" ::: "memory");
    const int c = lane & 7;
#pragma unroll
    for (int jj = 0; jj < 4; ++jj) { const int n = (lane >> 3) + 8 * jj; const LAS float* s = scr + (8 * c) * 33 + n;
        u32x4 o; o.x = pk2(s[0 * 33], s[1 * 33]); o.y = pk2(s[2 * 33], s[3 * 33]); o.z = pk2(s[4 * 33], s[5 * 33]); o.w = pk2(s[6 * 33], s[7 * 33]);
        *(u32x4*)(WT + (size_t)(r0 + n) * ldt + kdst0 + k0 + 8 * c) = o; }
    asm volatile("s_waitcnt lgkmcnt(0)" ::: "memory");
}

__device__ __forceinline__ void win_map(int db, int& c0, int& ncol) {
    ncol = 32;
    if (db < 32) { const int i = db >> 3, w = db & 7; c0 = (w < 4) ? (128 * i + 32 * w) : (512 + 128 * i + 32 * (w - 4)); }
    else if (db < 48) c0 = 1024 + 32 * (db - 32);
    else if (db < 56) { const int q = db - 48; if (q < 2) c0 = 1536 + 32 * q; else if (q < 4) c0 = 1600 + 32 * (q - 2); else if (q == 4) c0 = 1920; else if (q == 5) { c0 = 1952; ncol = 8; } else { c0 = 0; ncol = 0; } }
    else if (db < 64) c0 = 1664 + 32 * (db - 56);
    else c0 = 1960 + 32 * (db - 64);
}
constexpr int IT_WIN = 16 * 128, IT_WC = 8 * 32, IT_WA = 8 * 32, IT_WO = 16 * 32, IT_MIX = IT_WIN + IT_WC + IT_WA + IT_WO;
constexpr int IT_GU = 32 * 16 * 16, IT_DN = 32 * 4 * 32, IT_MOE = IT_GU + IT_DN;
__device__ __forceinline__ void conv_mixer_item(const Ctx& c, int l, int it, LAS float* scr) {
    bf16_t* WinT = (bf16_t*)(c.ws + WS_WIN) + (size_t)l * NINP * D;
    bf16_t* WcaT = (bf16_t*)(c.ws + WS_WCA) + (size_t)l * D * D;
    bf16_t* WoT = (bf16_t*)(c.ws + WS_WO) + (size_t)l * D * D;
    if (it < IT_WIN) { const int kb = it / 128, db = it % 128; int c0, nc; win_map(db, c0, nc);
        transpose_item(c.in[5] + (size_t)l * D * NIN, NIN, 64 * kb, c0, nc, WinT, D, 32 * db, 0, scr, c.lane); return; }
    it -= IT_WIN;
    if (it < IT_WC) { const int kb = it / 32, db = it % 32; transpose_item(c.in[12] + (size_t)l * CONV_CH * D, D, 64 * kb, 32 * db, 32, WcaT, D, 32 * db, 0, scr, c.lane); return; }
    it -= IT_WC;
    if (it < IT_WA) { const int kb = it / 32, db = it % 32; transpose_item(c.in[14] + (size_t)l * AW * D, D, 64 * kb, 32 * db, 32, WcaT, D, 32 * db, 512, scr, c.lane); return; }
    it -= IT_WA;
    { const int kb = it / 32, db = it % 32; transpose_item(c.in[15] + (size_t)l * D * D, D, 64 * kb, 32 * db, 32, WoT, D, 32 * db, 0, scr, c.lane); }
}
__device__ __forceinline__ void conv_moe_item(const Ctx& c, int l, int it, LAS float* scr) {
    bf16_t* WguT = (bf16_t*)(c.ws + WS_WGU);
    bf16_t* WdT = (bf16_t*)(c.ws + WS_WD);
    if (it < IT_GU) { const int e = it / 256, r = it % 256, kb = r / 16, db = r % 16, j = db >> 3, w = db & 7;
        const float* src = (w < 4 ? c.in[21] : c.in[22]) + ((size_t)l * NE + e) * D * DE;
        transpose_item(src, DE, 64 * kb, 128 * j + 32 * (w & 3), 32, WguT + (size_t)e * 512 * D, D, 32 * db, 0, scr, c.lane); return; }
    it -= IT_GU;
    { const int e = it / 128, r = it % 128, kb = r / 32, db = r % 32;
        transpose_item(c.in[23] + ((size_t)l * NE + e) * DE * D, D, 64 * kb, 32 * db, 32, WdT + (size_t)e * D * DE, DE, 32 * db, 0, scr, c.lane); }
}

__device__ void phase_prep(const Ctx& c) {
    LAS float* scr = (LAS float*)(c.lds + c.wave * 8704);
    const int gw = c.bid * NWAVES + c.wave, NGW = c.nb * NWAVES;
    float* cosH = (float*)(c.ws + WS_TAB); float* sinH = cosH + L * 32; float* cosI = sinH + L * 32; float* sinI = cosI + L * 16;
    for (int it = gw; it < 128; it += NGW) {
        const int pos = it * 64 + c.lane;
        for (int i = 0; i < 32; ++i) { const float inv = powf(10000.f, -(float)(2 * i) / 64.f); const float ang = (float)pos * inv;
            const double a = (double)ang; cosH[pos * 32 + i] = (float)cos(a); sinH[pos * 32 + i] = (float)sin(a); }
        for (int i = 0; i < 16; ++i) { const float inv = powf(10000.f, -(float)(2 * i) / 32.f); const float ang = (float)pos * inv;
            const double a = (double)ang; cosI[pos * 16 + i] = (float)cos(a); sinI[pos * 16 + i] = (float)sin(a); }
    }
    float* mod = (float*)(c.ws + WS_CTL + CTL_MOD);
    for (int it = c.bid; it < 2 * 24; it += c.nb) {
        const int l = it / 24, cc = it % 24, col = 256 * cc + 4 * c.lane;
        const float* W = c.in[2] + (size_t)l * D * 6144; const float* cv = c.in[1];
        f32x4 a0 = {0.f, 0.f, 0.f, 0.f}, a1 = a0;
#pragma unroll 8
        for (int k = 128 * c.wave; k < 128 * c.wave + 128; ++k) { const f32x4 w = *(const f32x4*)(W + (size_t)k * 6144 + col); const float s0 = siluf_(cv[k]), s1 = siluf_(cv[D + k]); a0 += w * s0; a1 += w * s1; }
        LAS f32x4* red = (LAS f32x4*)(c.lds + 8 * 8704);
        __syncthreads();
        red[(c.wave * 2 + 0) * 64 + c.lane] = a0; red[(c.wave * 2 + 1) * 64 + c.lane] = a1;
        __syncthreads();
        if (c.wave < 2) { f32x4 t = *(const f32x4*)(c.in[3] + l * 6144 + col);
#pragma unroll
            for (int w = 0; w < 8; ++w) t += red[(w * 2 + c.wave) * 64 + c.lane];
            *(f32x4*)(mod + (l * 2 + c.wave) * 6144 + col) = t; }
    }
    for (int it = gw; it < 2 * IT_MIX; it += NGW) conv_mixer_item(c, it / IT_MIX, it % IT_MIX, scr);
    for (int it = gw; it < IT_MOE; it += NGW) conv_moe_item(c, 0, it, scr);
}

__device__ __forceinline__ void norm_row_store(const f32x4 (&v)[4], const float* g, const float* shift, const float* scale, bf16_t* orow, int lane) {
    float s = 0.f;
#pragma unroll
    for (int j = 0; j < 4; ++j) s += (v[j].x * v[j].x + v[j].y * v[j].y) + (v[j].z * v[j].z + v[j].w * v[j].w);
    const float rstd = 1.f / sqrtf(wave_sum(s) * (1.f / D) + EPS);
#pragma unroll
    for (int j = 0; j < 4; ++j) { const int col = 4 * lane + 256 * j; const f32x4 gv = *(const f32x4*)(g + col), sh = *(const f32x4*)(shift + col), sc = *(const f32x4*)(scale + col);
        const f32x4 o = v[j] * rstd * gv * (sc + 1.f) + sh;
        u32x2 w; w.x = pk2(o.x, o.y); w.y = pk2(o.z, o.w); *(u32x2*)(orow + col) = w; }
}
__device__ void phase_norm1(const Ctx& c, int l) {
    const int gw = c.bid * NWAVES + c.wave, NGW = c.nb * NWAVES;
    const float* xin = (l == 0) ? c.in[0] : c.out; const float* mod = (const float*)(c.ws + WS_CTL + CTL_MOD);
    bf16_t* H = (bf16_t*)(c.ws + WS_H);
    for (int m = gw; m < T; m += NGW) { const int b = m / L; const float* mb = mod + (l * 2 + b) * 6144;
        f32x4 v[4];
#pragma unroll
        for (int j = 0; j < 4; ++j) v[j] = *(const f32x4*)(xin + (size_t)m * D + 4 * c.lane + 256 * j);
        norm_row_store(v, c.in[4] + l * D, mb, mb + D, H + (size_t)m * D, c.lane); }
}

template <class ARow, class Epi>
__device__ __forceinline__ void gemm_unit(const ARow& AR, const bf16_t* Bt, int ldb, int K, const Epi& E, int wr, int wc, int fr, int fq) {
    unsigned bo[2][2];
#pragma unroll
    for (int b = 0; b < 2; ++b)
#pragma unroll
        for (int n = 0; n < 2; ++n) bo[b][n] = (unsigned)(128 * b + 32 * wc + 16 * n + fr) * (unsigned)ldb + 8u * fq;
    const bf16_t* Ab = AR.A;
#pragma unroll 1
    for (int ai = 0; ai < 2; ++ai) {
        f32x4 acc[2][4][2];
#pragma unroll
        for (int b = 0; b < 2; ++b)
#pragma unroll
            for (int m = 0; m < 4; ++m)
#pragma unroll
                for (int n = 0; n < 2; ++n) acc[b][m][n] = (f32x4){0.f, 0.f, 0.f, 0.f};
        unsigned ao[4];
#pragma unroll
        for (int m = 0; m < 4; ++m) ao[m] = AR(128 * ai + 64 * wr + 16 * m + fr) + 8u * fq;
#pragma unroll 2
        for (int k0 = 0; k0 < K; k0 += 32) {
            bf16x8 af[4], bfr[2][2];
#pragma unroll
            for (int m = 0; m < 4; ++m) af[m] = *(const bf16x8*)(Ab + ao[m] + k0);
#pragma unroll
            for (int b = 0; b < 2; ++b)
#pragma unroll
                for (int n = 0; n < 2; ++n) bfr[b][n] = *(const bf16x8*)(Bt + bo[b][n] + k0);
#pragma unroll
            for (int b = 0; b < 2; ++b)
#pragma unroll
                for (int m = 0; m < 4; ++m)
#pragma unroll
                    for (int n = 0; n < 2; ++n) acc[b][m][n] = __builtin_amdgcn_mfma_f32_16x16x32_bf16(bfr[b][n], af[m], acc[b][m][n], 0, 0, 0);
        }
        E.half(acc, ai, wr, wc, fr, fq);
    }
}
struct ARowLinear { const bf16_t* A; unsigned lda; __device__ __forceinline__ unsigned operator()(int r) const { return (unsigned)r * lda; } };
struct ARowGather { const bf16_t* A; unsigned lda; const int* rowl; __device__ __forceinline__ unsigned operator()(int r) const { int t = rowl[r]; t = t < 0 ? 0 : t; return (unsigned)t * lda; } };

__device__ __forceinline__ u32x2 pack4(const f32x4 v) { u32x2 w; w.x = pk2(v.x, v.y); w.y = pk2(v.z, v.w); return w; }
__device__ __forceinline__ f32x4 unpack4(const u32x2 w) { return (f32x4){bflo(w.x), bfhi(w.x), bflo(w.y), bfhi(w.y)}; }

struct EpiIn {
    int pm, pn; bf16_t* uglu; float* raw; bf16_t* gates;
    __device__ __forceinline__ void half(const f32x4 (&acc)[2][4][2], int ai, int wr, int wc, int fr, int fq) const {
#pragma unroll
            for (int m = 0; m < 4; ++m) { const size_t row = (size_t)256 * pm + 128 * ai + 64 * wr + 16 * m + fr;
                if (pn < 4) {
#pragma unroll
                    for (int n = 0; n < 2; ++n) { const f32x4 a = acc[0][m][n], b = acc[1][m][n]; f32x4 o;
#pragma unroll
                        for (int i = 0; i < 4; ++i) o[i] = a[i] * sigmoidf_(b[i]);
                        *(u32x2*)(uglu + row * 512 + 128 * pn + 32 * wc + 16 * n + 4 * fq) = pack4(o); }
                } else if (pn < 8) {
#pragma unroll
                    for (int bj = 0; bj < 2; ++bj)
#pragma unroll
                        for (int n = 0; n < 2; ++n) *(f32x4*)(raw + row * 1024 + 256 * (pn - 4) + 128 * bj + 32 * wc + 16 * n + 4 * fq) = acc[bj][m][n];
                } else {
#pragma unroll
                    for (int bj = 0; bj < 2; ++bj)
#pragma unroll
                        for (int n = 0; n < 2; ++n) { const f32x4 a = acc[bj][m][n]; f32x4 o;
#pragma unroll
                            for (int i = 0; i < 4; ++i) o[i] = sigmoidf_(a[i]);
                            *(u32x2*)(gates + row * 2048 + 256 * (pn - 8) + 128 * bj + 32 * wc + 16 * n + 4 * fq) = pack4(o); }
                } }
    }
};
__device__ void phase_gemm_in(const Ctx& c, int l) {
    const int wr = c.wave >> 2, wc = c.wave & 3, fr = c.lane & 15, fq = c.lane >> 4;
    const bf16_t* H = (const bf16_t*)(c.ws + WS_H); const bf16_t* WinT = (const bf16_t*)(c.ws + WS_WIN) + (size_t)l * NINP * D;
    for (int u = c.bid; u < 64 * 16; u += c.nb) { const int pm = u / 16, pn = u % 16;
        ARowLinear AR{H + (size_t)pm * 256 * D, (unsigned)D};
        EpiIn E{pm, pn, (bf16_t*)(c.ws + WS_UGLU), (float*)(c.ws + WS_RAW), (bf16_t*)(c.ws + WS_GATES)};
        gemm_unit(AR, WinT + (size_t)pn * 256 * D, D, D, E, wr, wc, fr, fq); }
}

__device__ void phase_post_conv(const Ctx& c, int l) {
    const int gw = c.bid * NWAVES + c.wave, NGW = c.nb * NWAVES, lane = c.lane;
    const float* RAW = (const float*)(c.ws + WS_RAW);
    const float* cosH = (const float*)(c.ws + WS_TAB); const float* sinH = cosH + L * 32; const float* cosI = sinH + L * 32; const float* sinI = cosI + L * 16;
    bf16_t* QN = (bf16_t*)(c.ws + WS_QN); bf16_t* KN = (bf16_t*)(c.ws + WS_KN); bf16_t* VB = (bf16_t*)(c.ws + WS_VB);
    bf16_t* IQ = (bf16_t*)(c.ws + WS_IQ); bf16_t* IK = (bf16_t*)(c.ws + WS_IK); float* IW = (float*)(c.ws + WS_IW);
    const float* qg = c.in[6] + l * HD; const float* kg = c.in[7] + l * HD;
    for (int m = gw; m < T; m += NGW) {
        const int t = m % L; const float* r = RAW + (size_t)m * 1024;
        const int cc = lane & 7, c4 = cc & 3; const bool hi = cc >= 4;
        {
            const f32x4 a = *(const f32x4*)(r + 8 * lane), b = *(const f32x4*)(r + 8 * lane + 4);
            float x[8] = {a.x, a.y, a.z, a.w, b.x, b.y, b.z, b.w}; float s = 0.f;
#pragma unroll
            for (int i = 0; i < 8; ++i) s += x[i] * x[i];
            s += __shfl_xor(s, 1); s += __shfl_xor(s, 2); s += __shfl_xor(s, 4);
            const float rstd = 1.f / sqrtf(s * (1.f / 64.f) + EPS); float o[8];
#pragma unroll
            for (int i = 0; i < 8; ++i) x[i] = x[i] * rstd * qg[8 * cc + i];
#pragma unroll
            for (int i = 0; i < 8; ++i) { const float other = __shfl_xor(x[i], 4); const float cs = cosH[t * 32 + 8 * c4 + i], sn = sinH[t * 32 + 8 * c4 + i];
                o[i] = (hi ? (x[i] * cs + other * sn) : (x[i] * cs - other * sn)) * 0.125f; }
            u32x4 w; w.x = pk2(o[0], o[1]); w.y = pk2(o[2], o[3]); w.z = pk2(o[4], o[5]); w.w = pk2(o[6], o[7]);
            *(u32x4*)(QN + (size_t)m * 512 + 8 * lane) = w;
        }
        {
            const int off = (lane < 8) ? (512 + 8 * lane) : (576 + 8 * (lane & 7));
            const f32x4 a = *(const f32x4*)(r + off), b = *(const f32x4*)(r + off + 4);
            float x[8] = {a.x, a.y, a.z, a.w, b.x, b.y, b.z, b.w}; float s = 0.f;
#pragma unroll
            for (int i = 0; i < 8; ++i) s += x[i] * x[i];
            s += __shfl_xor(s, 1); s += __shfl_xor(s, 2); s += __shfl_xor(s, 4);
            const float rstd = 1.f / sqrtf(s * (1.f / 64.f) + EPS); float xn[8], o[8];
#pragma unroll
            for (int i = 0; i < 8; ++i) xn[i] = x[i] * rstd * kg[8 * cc + i];
#pragma unroll
            for (int i = 0; i < 8; ++i) { const float other = __shfl_xor(xn[i], 4); const float cs = cosH[t * 32 + 8 * c4 + i], sn = sinH[t * 32 + 8 * c4 + i];
                o[i] = hi ? (xn[i] * cs + other * sn) : (xn[i] * cs - other * sn); }
            if (lane < 8) { u32x4 w; w.x = pk2(o[0], o[1]); w.y = pk2(o[2], o[3]); w.z = pk2(o[4], o[5]); w.w = pk2(o[6], o[7]); *(u32x4*)(KN + (size_t)m * 64 + 8 * lane) = w; }
            else if (lane < 16) { u32x4 w; w.x = pk2(x[0], x[1]); w.y = pk2(x[2], x[3]); w.z = pk2(x[4], x[5]); w.w = pk2(x[6], x[7]); *(u32x4*)(VB + (size_t)m * 64 + 8 * (lane & 7)) = w; }
        }
        {
            const f32x4 a = *(const f32x4*)(r + 768 + 4 * lane); float o[4];
#pragma unroll
            for (int i = 0; i < 4; ++i) { const float other = __shfl_xor(a[i], 4); const float cs = cosI[t * 16 + 4 * c4 + i], sn = sinI[t * 16 + 4 * c4 + i];
                o[i] = hi ? (a[i] * cs + other * sn) : (a[i] * cs - other * sn); }
            u32x2 w; w.x = pk2(o[0], o[1]); w.y = pk2(o[2], o[3]); *(u32x2*)(IQ + (size_t)m * 256 + 4 * lane) = w;
        }
        {
            const f32x4 a = *(const f32x4*)(r + 640 + 4 * (lane & 7)); float o[4];
#pragma unroll
            for (int i = 0; i < 4; ++i) { const float other = __shfl_xor(a[i], 4); const float cs = cosI[t * 16 + 4 * c4 + i], sn = sinI[t * 16 + 4 * c4 + i];
                o[i] = hi ? (a[i] * cs + other * sn) : (a[i] * cs - other * sn); }
            if (lane < 8) { u32x2 w; w.x = pk2(o[0], o[1]); w.y = pk2(o[2], o[3]); *(u32x2*)(IK + (size_t)m * 32 + 4 * lane) = w; }
            else if (lane < 16) IW[(size_t)m * 8 + (lane & 7)] = r[672 + (lane & 7)];
        }
    }
    const bf16_t* UG = (const bf16_t*)(c.ws + WS_UGLU); bf16_t* YO = (bf16_t*)(c.ws + WS_YO);
    const float* cw = c.in[8] + (size_t)l * CONV_W * CONV_CH; const float* cb = c.in[9] + l * CONV_CH; const float* lg = c.in[10] + l * CONV_CH; const float* lb = c.in[11] + l * CONV_CH;
    for (int m = gw; m < T; m += NGW) {
        const int t = m % L; const int ch = 8 * lane;
        float acc[8];
        { const f32x4 b0 = *(const f32x4*)(cb + ch), b1 = *(const f32x4*)(cb + ch + 4); acc[0] = b0.x; acc[1] = b0.y; acc[2] = b0.z; acc[3] = b0.w; acc[4] = b1.x; acc[5] = b1.y; acc[6] = b1.z; acc[7] = b1.w; }
        for (int j = 0; j < CONV_W; ++j) { const int tt = t - 30 + j; if (tt < 0) continue;
            const u32x4 u = *(const u32x4*)(UG + (size_t)(m - 30 + j) * 512 + ch);
            const f32x4 w0 = *(const f32x4*)(cw + j * CONV_CH + ch), w1 = *(const f32x4*)(cw + j * CONV_CH + ch + 4);
            acc[0] += bflo(u.x) * w0.x; acc[1] += bfhi(u.x) * w0.y; acc[2] += bflo(u.y) * w0.z; acc[3] += bfhi(u.y) * w0.w;
            acc[4] += bflo(u.z) * w1.x; acc[5] += bfhi(u.z) * w1.y; acc[6] += bflo(u.w) * w1.z; acc[7] += bfhi(u.w) * w1.w; }
        float s = 0.f;
#pragma unroll
        for (int i = 0; i < 8; ++i) s += acc[i];
        const float mu = wave_sum(s) * (1.f / CONV_CH); float q = 0.f;
#pragma unroll
        for (int i = 0; i < 8; ++i) { acc[i] -= mu; q += acc[i] * acc[i]; }
        const float rstd = 1.f / sqrtf(wave_sum(q) * (1.f / CONV_CH) + EPS); float o[8];
#pragma unroll
        for (int i = 0; i < 8; ++i) o[i] = siluf_(acc[i] * rstd * lg[ch + i] + lb[ch + i]);
        u32x4 w; w.x = pk2(o[0], o[1]); w.y = pk2(o[2], o[3]); w.z = pk2(o[4], o[5]); w.w = pk2(o[6], o[7]);
        *(u32x4*)(YO + (size_t)m * 1024 + ch) = w;
    }
}

__device__ __forceinline__ unsigned score_key(float s) { s += 0.f; const unsigned u = __float_as_uint(s); return (u & 0x80000000u) ? ~u : (u | 0x80000000u); }
__device__ void phase_idx_attn(const Ctx& c, int l) {
    LAS unsigned* keys = (LAS unsigned*)c.lds;
    LAS unsigned* hist = keys + 8192;
    LAS int* misc = (LAS int*)(hist + 256);
    LAS float* iqs = (LAS float*)(misc + 32);
    LAS float* iws = iqs + 256;
    LAS float* qs = iws + 16;
    LAS float* S = qs + 512;
    LAS int* sel = (LAS int*)(S + 2048);
    const int tid = c.tid, lane = c.lane, wave = c.wave;
    const bf16_t* QN = (const bf16_t*)(c.ws + WS_QN); const bf16_t* KN = (const bf16_t*)(c.ws + WS_KN); const bf16_t* VB = (const bf16_t*)(c.ws + WS_VB);
    const bf16_t* IQ = (const bf16_t*)(c.ws + WS_IQ); const bf16_t* IK = (const bf16_t*)(c.ws + WS_IK); const float* IW = (const float*)(c.ws + WS_IW);
    bf16_t* YO = (bf16_t*)(c.ws + WS_YO);
    for (int q = c.bid; q < T; q += c.nb) {
        const int b = q / L, t = q % L, n = t + 1; const size_t kb = (size_t)b * L;
        __syncthreads();
        if (tid < 256) iqs[tid] = bf2f(IQ[(size_t)q * 256 + tid]);
        if (tid < 8) iws[tid] = IW[(size_t)q * 8 + tid];
        qs[tid] = bf2f(QN[(size_t)q * 512 + tid]);
        if (tid == 0) { misc[0] = 0; misc[1] = TOPK; misc[3] = 0; }
        __syncthreads();
        int cnt;
        if (n <= TOPK) { if (tid < n) sel[tid] = tid; cnt = n; }
        else {
#pragma unroll 1
            for (int s = tid; s < n; s += NTHREADS) {
                asm volatile("" ::: "memory");
                const u32x4* kr = (const u32x4*)(IK + (kb + s) * 32); float kf[32];
#pragma unroll
                for (int i = 0; i < 4; ++i) { const u32x4 w = kr[i]; kf[8 * i + 0] = bflo(w.x); kf[8 * i + 1] = bfhi(w.x); kf[8 * i + 2] = bflo(w.y); kf[8 * i + 3] = bfhi(w.y); kf[8 * i + 4] = bflo(w.z); kf[8 * i + 5] = bfhi(w.z); kf[8 * i + 6] = bflo(w.w); kf[8 * i + 7] = bfhi(w.w); }
                float sc = 0.f;
#pragma unroll 1
                for (int h = 0; h < 8; ++h) { float d = 0.f;
#pragma unroll
                    for (int i = 0; i < 8; ++i) { const f32x4 qv = *(const LAS f32x4*)(iqs + 32 * h + 4 * i); d += qv.x * kf[4 * i] + qv.y * kf[4 * i + 1] + qv.z * kf[4 * i + 2] + qv.w * kf[4 * i + 3]; }
                    sc = fmaf(fmaxf(d, 0.f), iws[h], sc); }
                keys[s] = score_key(sc);
            }
            for (int rd = 0; rd < 4; ++rd) {
                const int shift = 24 - 8 * rd;
                if (tid < 256) hist[tid] = 0u;
                __syncthreads();
                const unsigned prefix = (unsigned)misc[0];
                for (int s = tid; s < n; s += NTHREADS) { const unsigned k = keys[s]; if (rd == 0 || (k >> (shift + 8)) == prefix) lds_add(&hist[(k >> shift) & 255u], 1u); }
                __syncthreads();
                if (wave == 0) {
                    const int need = misc[1];
                    unsigned cb[4]; unsigned sl = 0;
#pragma unroll
                    for (int j = 0; j < 4; ++j) { cb[j] = hist[4 * lane + j]; sl += cb[j]; }
                    unsigned suf = sl;
#pragma unroll
                    for (int o = 1; o < 64; o <<= 1) { const unsigned v = __shfl_down(suf, o); if (lane + o < 64) suf += v; }
                    unsigned above = suf - sl;
                    if (above < (unsigned)need && (unsigned)need <= suf) {
                        bool done = false;
#pragma unroll
                        for (int j = 3; j >= 0; --j) { if (!done) { if ((unsigned)need <= above + cb[j]) { misc[0] = (int)((prefix << 8) | (unsigned)(4 * lane + j)); misc[1] = need - (int)above; misc[2] = (int)cb[j]; done = true; } else above += cb[j]; } }
                    }
                }
                __syncthreads();
            }
            const unsigned Tk = (unsigned)misc[0]; const int need_eq = misc[1];
            const int seg = (((n + 7) >> 3) + 63) & ~63, s_lo = wave * seg, s_hi = (s_lo + seg < n) ? (s_lo + seg) : n;
            int ngt = 0, neq = 0;
            for (int s0 = s_lo; s0 < s_hi; s0 += 64) { const int s = s0 + lane; const unsigned k = (s < s_hi) ? keys[s] : 0u; const bool gt = (s < s_hi) && k > Tk, eq = (s < s_hi) && k == Tk;
                ngt += __popcll(__ballot(gt)); neq += __popcll(__ballot(eq)); }
            if (lane == 0) { misc[4 + wave] = ngt; misc[12 + wave] = neq; }
            __syncthreads();
            int pgt = 0, peq = 0;
            for (int w = 0; w < wave; ++w) { pgt += misc[4 + w]; peq += misc[12 + w]; }
            for (int s0 = s_lo; s0 < s_hi; s0 += 64) { const int s = s0 + lane; const unsigned k = (s < s_hi) ? keys[s] : 0u; const bool gt = (s < s_hi) && k > Tk, eq = (s < s_hi) && k == Tk;
                const unsigned long long bg_ = __ballot(gt), be_ = __ballot(eq); const unsigned long long lt = (1ull << lane) - 1ull;
                const int mygt = pgt + __popcll(bg_ & lt), myeq = peq + __popcll(be_ & lt);
                const int eqsel_before = myeq < need_eq ? myeq : need_eq;
                if (gt || (eq && myeq < need_eq)) sel[mygt + eqsel_before] = s;
                pgt += __popcll(bg_); peq += __popcll(be_); }
            cnt = TOPK;
        }
        __syncthreads();
        { const int j = tid & 255, hg = tid >> 8;
            if (j < cnt) { const u32x4* kr = (const u32x4*)(KN + (kb + sel[j]) * 64); float d[4] = {0.f, 0.f, 0.f, 0.f};
#pragma unroll 2
                for (int i = 0; i < 8; ++i) { const u32x4 w = kr[i]; const float kf[8] = {bflo(w.x), bfhi(w.x), bflo(w.y), bfhi(w.y), bflo(w.z), bfhi(w.z), bflo(w.w), bfhi(w.w)};
#pragma unroll
                    for (int h = 0; h < 4; ++h) { const f32x4 q0 = *(const LAS f32x4*)(qs + (4 * hg + h) * 64 + 8 * i), q1 = *(const LAS f32x4*)(qs + (4 * hg + h) * 64 + 8 * i + 4);
                        d[h] += q0.x * kf[0] + q0.y * kf[1] + q0.z * kf[2] + q0.w * kf[3] + q1.x * kf[4] + q1.y * kf[5] + q1.z * kf[6] + q1.w * kf[7]; } }
#pragma unroll
                for (int h = 0; h < 4; ++h) S[(4 * hg + h) * 256 + j] = d[h]; }
            else {
#pragma unroll
                for (int h = 0; h < 4; ++h) S[(4 * hg + h) * 256 + j] = -INFINITY; } }
        __syncthreads();
        { float v[4]; float mx = -INFINITY;
#pragma unroll
            for (int i = 0; i < 4; ++i) { v[i] = S[wave * 256 + lane + 64 * i]; mx = fmaxf(mx, v[i]); }
            mx = wave_max(mx); float sm = 0.f;
#pragma unroll
            for (int i = 0; i < 4; ++i) { v[i] = __expf(v[i] - mx); sm += v[i]; }
            sm = wave_sum(sm); const float inv = 1.f / sm;
#pragma unroll
            for (int i = 0; i < 4; ++i) S[wave * 256 + lane + 64 * i] = v[i] * inv; }
        __syncthreads();
        { const int h = wave, d = lane; float o = 0.f;
#pragma unroll 4
            for (int j = 0; j < cnt; ++j) o += S[h * 256 + j] * bf2f(VB[(kb + sel[j]) * 64 + d]);
            YO[(size_t)q * 1024 + 512 + h * 64 + d] = (bf16_t)f2bf(o); }
    }
}

struct EpiD1 {
    int pm, pn, which; const bf16_t* gates; const float* bc; bf16_t* Mo;
    __device__ __forceinline__ void half(const f32x4 (&acc)[2][4][2], int ai, int wr, int wc, int fr, int fq) const {
#pragma unroll
            for (int m = 0; m < 4; ++m) { const size_t row = (size_t)256 * pm + 128 * ai + 64 * wr + 16 * m + fr;
#pragma unroll
                for (int bj = 0; bj < 2; ++bj)
#pragma unroll
                    for (int n = 0; n < 2; ++n) { const int col = 256 * pn + 128 * bj + 32 * wc + 16 * n + 4 * fq;
                        const f32x4 g = unpack4(*(const u32x2*)(gates + row * 2048 + which * 1024 + col)); f32x4 o;
                        if (which == 0) o = g * (acc[bj][m][n] + *(const f32x4*)(bc + col));
                        else o = unpack4(*(const u32x2*)(Mo + row * 1024 + col)) + g * acc[bj][m][n];
                        *(u32x2*)(Mo + row * 1024 + col) = pack4(o); } }
    }
};
__device__ void phase_gemm_d1(const Ctx& c, int l) {
    const int wr = c.wave >> 2, wc = c.wave & 3, fr = c.lane & 15, fq = c.lane >> 4;
    const bf16_t* YO = (const bf16_t*)(c.ws + WS_YO); const bf16_t* WcaT = (const bf16_t*)(c.ws + WS_WCA) + (size_t)l * D * D;
    for (int u = c.bid; u < 64 * 4; u += c.nb) { const int pm = u / 4, pn = u % 4;
        for (int which = 0; which < 2; ++which) {
            ARowLinear AR{YO + (size_t)pm * 256 * 1024 + which * 512, 1024u};
            EpiD1 E{pm, pn, which, (const bf16_t*)(c.ws + WS_GATES), c.in[13] + l * D, (bf16_t*)(c.ws + WS_H)};
            gemm_unit(AR, WcaT + (size_t)pn * 256 * D + which * 512, D, 512, E, wr, wc, fr, fq); } }
}
struct EpiD2 {
    int pm, pn; const float* xin; float* xout; const float* gate;
    __device__ __forceinline__ void half(const f32x4 (&acc)[2][4][2], int ai, int wr, int wc, int fr, int fq) const {
#pragma unroll
            for (int m = 0; m < 4; ++m) { const size_t row = (size_t)256 * pm + 128 * ai + 64 * wr + 16 * m + fr;
#pragma unroll
                for (int bj = 0; bj < 2; ++bj)
#pragma unroll
                    for (int n = 0; n < 2; ++n) { const int col = 256 * pn + 128 * bj + 32 * wc + 16 * n + 4 * fq;
                        const f32x4 xv = *(const f32x4*)(xin + row * D + col), gv = *(const f32x4*)(gate + col);
                        *(f32x4*)(xout + row * D + col) = xv + gv * acc[bj][m][n]; } }
    }
};
__device__ void phase_gemm_d2(const Ctx& c, int l) {
    const int wr = c.wave >> 2, wc = c.wave & 3, fr = c.lane & 15, fq = c.lane >> 4;
    const bf16_t* Mb = (const bf16_t*)(c.ws + WS_H); const bf16_t* WoT = (const bf16_t*)(c.ws + WS_WO) + (size_t)l * D * D;
    const float* mod = (const float*)(c.ws + WS_CTL + CTL_MOD);
    for (int u = c.bid; u < 64 * 4; u += c.nb) { const int pm = u / 4, pn = u % 4; const int b = (pm * 256) / L;
        ARowLinear AR{Mb + (size_t)pm * 256 * D, (unsigned)D};
        EpiD2 E{pm, pn, (l == 0) ? c.in[0] : c.out, c.out, mod + (l * 2 + b) * 6144 + 2 * D};
        gemm_unit(AR, WoT + (size_t)pn * 256 * D, D, D, E, wr, wc, fr, fq); }
}

__device__ void phase_norm2_route(const Ctx& c, int l) {
    LAS float* WR = (LAS float*)c.lds;
    const float* wg = c.in[17] + (size_t)l * D * NG; const float* wrt = c.in[19] + (size_t)l * D * NE;
    for (int i = c.tid; i < D * NG; i += NTHREADS) WR[(i % NG) * 1024 + i / NG] = wg[i];
    for (int i = c.tid; i < D * NE; i += NTHREADS) WR[(4 + i % NE) * 1024 + i / NE] = wrt[i];
    __syncthreads();
    const int gw = c.bid * NWAVES + c.wave, NGW = c.nb * NWAVES, lane = c.lane;
    const float* mod = (const float*)(c.ws + WS_CTL + CTL_MOD); const float* g2 = c.in[16] + l * D;
    bf16_t* H2 = (bf16_t*)(c.ws + WS_H2); int* cnt = (int*)(c.ws + WS_CTL + CTL_CNT) + l * NE;
    i32x4* rt = (i32x4*)(c.ws + WS_ROUTE); f32x2* rw = (f32x2*)(c.ws + WS_ROUTE + 512 * 1024);
    const float* bg = c.in[18] + l * NG; const float* br = c.in[20] + l * NE;
    for (int m = gw; m < T; m += NGW) { const int b = m / L; const float* mb = mod + (l * 2 + b) * 6144;
        f32x4 v[4]; float s = 0.f;
#pragma unroll
        for (int j = 0; j < 4; ++j) { v[j] = *(const f32x4*)(c.out + (size_t)m * D + 4 * lane + 256 * j); s += (v[j].x * v[j].x + v[j].y * v[j].y) + (v[j].z * v[j].z + v[j].w * v[j].w); }
        const float rstd = 1.f / sqrtf(wave_sum(s) * (1.f / D) + EPS);
#pragma unroll
        for (int j = 0; j < 4; ++j) { const int col = 4 * lane + 256 * j; const f32x4 gv = *(const f32x4*)(g2 + col), sh = *(const f32x4*)(mb + 3 * D + col), sc = *(const f32x4*)(mb + 4 * D + col);
            v[j] = v[j] * rstd * gv * (sc + 1.f) + sh; *(u32x2*)(H2 + (size_t)m * D + col) = pack4(v[j]); }
        float mylg = 0.f;
#pragma unroll 1
        for (int o = 0; o < 36; ++o) { float a = 0.f;
#pragma unroll
            for (int j = 0; j < 4; ++j) { const f32x4 w = *(const LAS f32x4*)(WR + o * 1024 + 4 * lane + 256 * j); a += (v[j].x * w.x + v[j].y * w.y) + (v[j].z * w.z + v[j].w * w.w); }
            a = wave_sum(a); if (lane == o) mylg = a; }
        float gl[4]; int gs = 0;
#pragma unroll
        for (int g = 0; g < 4; ++g) gl[g] = __shfl(mylg, g) + bg[g];
        float gm = gl[0];
#pragma unroll
        for (int g = 1; g < 4; ++g) if (gl[g] > gm) { gm = gl[g]; gs = g; }
        float gsum = 0.f;
#pragma unroll
        for (int g = 0; g < 4; ++g) gsum += expf(gl[g] - gm);
        const float pg = 1.f / gsum;
        float ev[8];
#pragma unroll
        for (int e = 0; e < 8; ++e) ev[e] = __shfl(mylg, 4 + gs * 8 + e) + br[gs * 8 + e];
        int i1 = 0; float v1 = ev[0];
#pragma unroll
        for (int e = 1; e < 8; ++e) if (ev[e] > v1) { v1 = ev[e]; i1 = e; }
        int i2 = -1; float v2 = -INFINITY;
#pragma unroll
        for (int e = 0; e < 8; ++e) { if (e != i1 && (i2 < 0 || ev[e] > v2)) { i2 = e; v2 = ev[e]; } }
        const float e2 = expf(v2 - v1), p1 = 1.f / (1.f + e2), p2 = e2 / (1.f + e2);
        if (lane == 0) { const int ea = gs * 8 + i1, eb = gs * 8 + i2; const int ra = atomicAdd(cnt + ea, 1), rb = atomicAdd(cnt + eb, 1);
            rt[m] = (i32x4){ea, ra, eb, rb}; rw[m] = (f32x2){pg * p1, pg * p2}; }
    }
}
__device__ __forceinline__ void expert_bases(const int* cnt, LAS int* base  , int tid) {
    if (tid == 0) { int a = 0; for (int e = 0; e < NE; ++e) { base[e] = a; a += (cnt[e] + 255) & ~255; } base[NE] = a; }
    __syncthreads();
}
__device__ void phase_scatter(const Ctx& c, int l) {
    LAS int* base = (LAS int*)c.lds; const int* cnt = (const int*)(c.ws + WS_CTL + CTL_CNT) + l * NE;
    expert_bases(cnt, base, c.tid);
    const i32x4* rt = (const i32x4*)(c.ws + WS_ROUTE); int* slots = (int*)(c.ws + WS_ROUTE + 768 * 1024); int* rowl = (int*)(c.ws + WS_ROWL);
    for (int m = c.bid * NTHREADS + c.tid; m < T; m += c.nb * NTHREADS) { const i32x4 r = rt[m]; const int s1 = base[r.x] + r.y, s2 = base[r.z] + r.w;
        slots[2 * m] = s1; slots[2 * m + 1] = s2; rowl[s1] = m; rowl[s2] = m; }
    for (int e = c.bid; e < NE; e += c.nb) for (int s = base[e] + cnt[e] + c.tid; s < base[e + 1]; s += NTHREADS) rowl[s] = -1;
}
struct EpiMoe1 {
    int row0, j; bf16_t* hid;
    __device__ __forceinline__ void half(const f32x4 (&acc)[2][4][2], int ai, int wr, int wc, int fr, int fq) const {
#pragma unroll
            for (int m = 0; m < 4; ++m) { const size_t row = (size_t)row0 + 128 * ai + 64 * wr + 16 * m + fr;
#pragma unroll
                for (int n = 0; n < 2; ++n) { const f32x4 a = acc[0][m][n], b = acc[1][m][n]; f32x4 o;
#pragma unroll
                    for (int i = 0; i < 4; ++i) o[i] = siluf_(a[i]) * b[i];
                    *(u32x2*)(hid + row * DE + 128 * j + 32 * wc + 16 * n + 4 * fq) = pack4(o); } }
    }
};
struct EpiMoe2 {
    int row0, pn; bf16_t* ys;
    __device__ __forceinline__ void half(const f32x4 (&acc)[2][4][2], int ai, int wr, int wc, int fr, int fq) const {
#pragma unroll
            for (int m = 0; m < 4; ++m) { const size_t row = (size_t)row0 + 128 * ai + 64 * wr + 16 * m + fr;
#pragma unroll
                for (int bj = 0; bj < 2; ++bj)
#pragma unroll
                    for (int n = 0; n < 2; ++n) *(u32x2*)(ys + row * D + 256 * pn + 128 * bj + 32 * wc + 16 * n + 4 * fq) = pack4(acc[bj][m][n]); }
    }
};
__device__ __forceinline__ int tile_expert(const LAS int* base, int rt) { int e = 0; for (int i = 1; i < NE; ++i) if (base[i] <= rt * 256) e = i; return e; }
__device__ void phase_moe1(const Ctx& c, int l) {
    LAS int* base = (LAS int*)c.lds; const int* cnt = (const int*)(c.ws + WS_CTL + CTL_CNT) + l * NE;
    expert_bases(cnt, base, c.tid);
    const int wr = c.wave >> 2, wc = c.wave & 3, fr = c.lane & 15, fq = c.lane >> 4;
    const int ntile = base[NE] / 256; const int* rowl = (const int*)(c.ws + WS_ROWL);
    for (int u = c.bid; u < ntile * 2; u += c.nb) { const int rt = u / 2, j = u % 2; const int e = tile_expert(base, rt);
        ARowGather AR{(const bf16_t*)(c.ws + WS_H2), (unsigned)D, rowl + rt * 256};
        EpiMoe1 E{rt * 256, j, (bf16_t*)(c.ws + WS_HID)};
        gemm_unit(AR, (const bf16_t*)(c.ws + WS_WGU) + ((size_t)e * 512 + 256 * j) * D, D, D, E, wr, wc, fr, fq); }
}
__device__ void phase_moe2(const Ctx& c, int l) {
    LAS int* base = (LAS int*)c.lds; const int* cnt = (const int*)(c.ws + WS_CTL + CTL_CNT) + l * NE;
    expert_bases(cnt, base, c.tid);
    const int wr = c.wave >> 2, wc = c.wave & 3, fr = c.lane & 15, fq = c.lane >> 4;
    const int ntile = base[NE] / 256;
    for (int u = c.bid; u < ntile * 4; u += c.nb) { const int rt = u / 4, pn = u % 4; const int e = tile_expert(base, rt);
        ARowLinear AR{(const bf16_t*)(c.ws + WS_HID) + (size_t)rt * 256 * DE, (unsigned)DE};
        EpiMoe2 E{rt * 256, pn, (bf16_t*)(c.ws + WS_YS)};
        gemm_unit(AR, (const bf16_t*)(c.ws + WS_WD) + ((size_t)e * D + 256 * pn) * DE, DE, DE, E, wr, wc, fr, fq); }
}
__device__ void phase_combine(const Ctx& c, int l) {
    const int gw = c.bid * NWAVES + c.wave, NGW = c.nb * NWAVES, lane = c.lane;
    const float* mod = (const float*)(c.ws + WS_CTL + CTL_MOD);
    const bf16_t* YS = (const bf16_t*)(c.ws + WS_YS); const int* slots = (const int*)(c.ws + WS_ROUTE + 768 * 1024); const f32x2* rw = (const f32x2*)(c.ws + WS_ROUTE + 512 * 1024);
    bf16_t* H = (bf16_t*)(c.ws + WS_H);
    for (int m = gw; m < T; m += NGW) { const int b = m / L; const float* mb = mod + (l * 2 + b) * 6144;
        const int s1 = slots[2 * m], s2 = slots[2 * m + 1]; const f32x2 w = rw[m];
        f32x4 v[4];
#pragma unroll
        for (int j = 0; j < 4; ++j) { const int col = 4 * lane + 256 * j; const f32x4 xv = *(const f32x4*)(c.out + (size_t)m * D + col), gv = *(const f32x4*)(mb + 5 * D + col);
            const f32x4 y1 = unpack4(*(const u32x2*)(YS + (size_t)s1 * D + col)), y2 = unpack4(*(const u32x2*)(YS + (size_t)s2 * D + col));
            v[j] = xv + gv * (y1 * w.x + y2 * w.y); *(f32x4*)(c.out + (size_t)m * D + col) = v[j]; }
        if (l == 0) { const float* m1 = mod + (2 + b) * 6144; norm_row_store(v, c.in[4] + D, m1, m1 + D, H + (size_t)m * D, lane); }
    }
    if (l == 0) { LAS float* scr = (LAS float*)(c.lds + c.wave * 8704); for (int it = gw; it < IT_MOE; it += NGW) conv_moe_item(c, 1, it, scr); }
}

__global__ void __launch_bounds__(NTHREADS, 2) mega(Params p) {
    extern __shared__ __attribute__((aligned(16))) unsigned char lds[];
    Ctx c; c.in = p.in; c.out = p.out; c.ws = p.ws; c.lds = (LAS unsigned char*)lds;
    c.tid = threadIdx.x; c.lane = c.tid & 63; c.wave = __builtin_amdgcn_readfirstlane(c.tid >> 6); c.bid = blockIdx.x; c.nb = gridDim.x;
    const int lo = p.ph_lo, hi = p.ph_hi;
#if ONE_LAUNCH
    cg::grid_group grid = cg::this_grid();
#define SEAM(k) do { if ((k) + 1 < hi) grid.sync(); } while (0)
#else
#define SEAM(k) do { } while (0)
#endif
#define IN(k) (lo <= (k) && (k) < hi)
#define PHASE(k, call) do { if (IN(k)) { Ctx cc = c; asm volatile("" : "+s"(cc.ws), "+s"(cc.out), "+v"(cc.tid), "+v"(cc.lane), "+s"(cc.wave), "+s"(cc.bid), "+s"(cc.nb)); call; SEAM(k); } } while (0)
    PHASE(0, phase_prep(cc));
    PHASE(1, phase_norm1(cc, 0));
#define LAYER(l) do { constexpr int p0 = 2 + 10 * (l); \
        PHASE(p0 + 0, phase_gemm_in(cc, l)); \
        PHASE(p0 + 1, phase_post_conv(cc, l)); \
        PHASE(p0 + 2, phase_idx_attn(cc, l)); \
        PHASE(p0 + 3, phase_gemm_d1(cc, l)); \
        PHASE(p0 + 4, phase_gemm_d2(cc, l)); \
        PHASE(p0 + 5, phase_norm2_route(cc, l)); \
        PHASE(p0 + 6, phase_scatter(cc, l)); \
        PHASE(p0 + 7, phase_moe1(cc, l)); \
        PHASE(p0 + 8, phase_moe2(cc, l)); \
        PHASE(p0 + 9, phase_combine(cc, l)); } while (0)
    LAYER(0);
    LAYER(1);
#undef LAYER
#undef PHASE
#undef IN
#undef SEAM
}

extern "C" void kernel_launch(void* const* d_in, const int* in_sizes, int n_in, void* d_out, int out_size, void* d_ws, size_t ws_size, hipStream_t stream) {
    static int grid = 0;
    if (grid == 0) {
        if (n_in != 24 || out_size != T * D || ws_size < WS_END) { fprintf(stderr, "kernel_launch: unexpected shapes (n_in %d out %d ws %zu)\n", n_in, out_size, ws_size); grid = -1; return; }
        int dev = 0, cus = 0, per_cu = 0;
        hipGetDevice(&dev); hipDeviceGetAttribute(&cus, hipDeviceAttributeMultiprocessorCount, dev);
        if (hipFuncSetAttribute((const void*)mega, hipFuncAttributeMaxDynamicSharedMemorySize, LDS_BYTES) != hipSuccess) { fprintf(stderr, "kernel_launch: hipFuncSetAttribute failed\n"); grid = -1; return; }
        if (hipOccupancyMaxActiveBlocksPerMultiprocessor(&per_cu, (const void*)mega, NTHREADS, LDS_BYTES) != hipSuccess || per_cu < 1) { fprintf(stderr, "kernel_launch: occupancy query says %d\n", per_cu); per_cu = 1; }
        (void)hipGetLastError();
        grid = cus;
    }
    if (grid < 0) return;
    hipMemsetAsync((char*)d_ws + WS_CTL, 0, CTL_ZERO, stream);
    Params p{};
    for (int i = 0; i < 24; ++i) p.in[i] = (const float*)d_in[i];
    p.out = (float*)d_out; p.ws = (unsigned char*)d_ws;
#if ONE_LAUNCH
    p.ph_lo = 0; p.ph_hi = NPH;
    void* args[] = {&p};
    hipError_t e = hipLaunchCooperativeKernel((void*)mega, dim3(grid), dim3(NTHREADS), args, LDS_BYTES, stream);
    if (e != hipSuccess) fprintf(stderr, "cooperative launch failed: %s (grid %d)\n", hipGetErrorString(e), grid);
#else
    for (int ph = 0; ph < NPH; ++ph) { p.ph_lo = ph; p.ph_hi = ph + 1; hipLaunchKernelGGL(mega, dim3(grid), dim3(NTHREADS), LDS_BYTES, stream, p); }
#endif
}
```

```cpp
#include <hip/hip_runtime.h>
#include <cstdio>
#include <cstdint>

#ifndef ONE_LAUNCH
#define ONE_LAUNCH 1
#endif

#define LAS __attribute__((address_space(3)))
typedef unsigned short bf16_t;
typedef short bf16x8 __attribute__((ext_vector_type(8)));
typedef float f32x4 __attribute__((ext_vector_type(4)));
typedef float f32x2 __attribute__((ext_vector_type(2)));
typedef unsigned u32x4 __attribute__((ext_vector_type(4)));
typedef unsigned u32x2 __attribute__((ext_vector_type(2)));
typedef int i32x4 __attribute__((ext_vector_type(4)));

constexpr int NB = 2, L = 8192, T = NB * L, D = 1024;
constexpr int NTHREADS = 512, NWAVES = 8;
constexpr int CONV_CH = 512, CONV_W = 31;
constexpr int NH = 8, HD = 64, AW = 512;
constexpr int IH = 8, IDIM = 32;
constexpr int TOPK = 256;
constexpr int NE = 32, EPG = 8, NG = 4, DE = 256;
constexpr int NIN = 4008, NINP = 4096;
constexpr float EPS = 1e-6f;
constexpr int MAXSLOT = T * 2 + NE * 256;
constexpr int NPH = 22;

constexpr size_t MiB = 1u << 20;
constexpr size_t WS_CTL = 0;
constexpr size_t CTL_ZERO = 256 * 1024;
constexpr size_t CTL_CNT = 4096;
constexpr size_t CTL_MOD = 65536;
constexpr size_t CTL_BAR = 16384;
constexpr size_t CTL_MAXIK = 8192;
constexpr size_t WS_TAB = 1 * MiB;
constexpr size_t WS_WIN = 4 * MiB;
constexpr size_t WS_WCA = 20 * MiB;
constexpr size_t WS_WO = 24 * MiB;
constexpr size_t WS_WGU = 28 * MiB;
constexpr size_t WS_WD = 60 * MiB;
constexpr size_t WS_H = 76 * MiB;
constexpr size_t WS_UGLU = 108 * MiB;
constexpr size_t WS_RAW = 124 * MiB;
constexpr size_t WS_RAWF = 156 * MiB;
constexpr size_t WS_GATES = 188 * MiB;
constexpr size_t WS_QN = 252 * MiB;
constexpr size_t WS_KN = 268 * MiB;
constexpr size_t WS_VB = 270 * MiB;
constexpr size_t WS_IQ = 272 * MiB;
constexpr size_t WS_IK = 280 * MiB;
constexpr size_t WS_IW = 281 * MiB;
constexpr size_t WS_YO = 282 * MiB;
constexpr size_t WS_PR = 315 * MiB;
constexpr size_t WS_ROUTE = 314 * MiB;
constexpr size_t WS_INV = 316 * MiB;
constexpr size_t WS_END = 318 * MiB;
constexpr size_t WS_XS = 144 * MiB;
constexpr size_t WS_H2 = 108 * MiB;
constexpr size_t WS_ROWL = 315 * MiB + 128 * 1024;
constexpr size_t WS_HID = 76 * MiB;
constexpr size_t WS_X1 = 156 * MiB;
constexpr size_t WS_YS = 188 * MiB;

constexpr int LDS_BYTES = 160 * 1024;

__device__ __forceinline__ unsigned f2bf(float f) { unsigned u = __float_as_uint(f); return (u + 0x7fffu + ((u >> 16) & 1u)) >> 16; }
typedef __bf16 hwbf16x2 __attribute__((ext_vector_type(2)));
__device__ __forceinline__ unsigned pk2(float lo, float hi) { const f32x2 v = {lo, hi}; return __builtin_bit_cast(unsigned, __builtin_convertvector(v, hwbf16x2)); }
__device__ __forceinline__ float bflo(unsigned w) { return __uint_as_float(w << 16); }
__device__ __forceinline__ float bfhi(unsigned w) { return __uint_as_float(w & 0xffff0000u); }
__device__ __forceinline__ float bf2f(bf16_t h) { return __uint_as_float((unsigned)h << 16); }
__device__ __forceinline__ float sigmoidf_(float x) { return __builtin_amdgcn_rcpf(1.f + __expf(-x)); }
__device__ __forceinline__ float siluf_(float x) { return x * __builtin_amdgcn_rcpf(1.f + __expf(-x)); }
__device__ __forceinline__ unsigned lds_add(LAS unsigned* p, unsigned v) { return __hip_atomic_fetch_add(p, v, __ATOMIC_RELAXED, __HIP_MEMORY_SCOPE_WORKGROUP); }
__device__ __forceinline__ int lds_addi(LAS int* p, int v) { return __hip_atomic_fetch_add(p, v, __ATOMIC_RELAXED, __HIP_MEMORY_SCOPE_WORKGROUP); }
template <int CTRL> __device__ __forceinline__ float dpp_f(float v) { return __int_as_float(__builtin_amdgcn_update_dpp(0, __float_as_int(v), CTRL, 0xf, 0xf, true)); }
__device__ __forceinline__ float row16_sum(float v) { v += dpp_f<0xB1>(v); v += dpp_f<0x4E>(v); v += dpp_f<0x141>(v); v += dpp_f<0x140>(v); return v; }
__device__ __forceinline__ float row16_max(float v) { v = fmaxf(v, dpp_f<0xB1>(v)); v = fmaxf(v, dpp_f<0x4E>(v)); v = fmaxf(v, dpp_f<0x141>(v)); v = fmaxf(v, dpp_f<0x140>(v)); return v; }
__device__ __forceinline__ float rl_f(float v, int l) { return __int_as_float(__builtin_amdgcn_readlane(__float_as_int(v), l)); }
__device__ __forceinline__ float wave_sum(float v) { v = row16_sum(v); return (rl_f(v, 0) + rl_f(v, 16)) + (rl_f(v, 32) + rl_f(v, 48)); }
__device__ __forceinline__ float wave_max(float v) { v = row16_max(v); return fmaxf(fmaxf(rl_f(v, 0), rl_f(v, 16)), fmaxf(rl_f(v, 32), rl_f(v, 48))); }
__device__ __forceinline__ unsigned wave_incl_scan(unsigned v) {
    v += (unsigned)__builtin_amdgcn_update_dpp(0, (int)v, 0x111, 0xf, 0xf, true);
    v += (unsigned)__builtin_amdgcn_update_dpp(0, (int)v, 0x112, 0xf, 0xf, true);
    v += (unsigned)__builtin_amdgcn_update_dpp(0, (int)v, 0x114, 0xf, 0xf, true);
    v += (unsigned)__builtin_amdgcn_update_dpp(0, (int)v, 0x118, 0xf, 0xf, true);
    v += (unsigned)__builtin_amdgcn_update_dpp(0, (int)v, 0x142, 0xa, 0xf, false);
    v += (unsigned)__builtin_amdgcn_update_dpp(0, (int)v, 0x143, 0xc, 0xf, false);
    return v;
}
__device__ __forceinline__ float xor16_f(float v) { return __int_as_float(__builtin_amdgcn_ds_swizzle(__float_as_int(v), (16 << 10) | 0x1f)); }
__device__ __forceinline__ float max_x32(float v) { const auto r = __builtin_amdgcn_permlane32_swap(__float_as_uint(v), __float_as_uint(v), false, false); return fmaxf(__uint_as_float(r[0]), __uint_as_float(r[1])); }
__device__ __forceinline__ float sum_x32(float v) { const auto r = __builtin_amdgcn_permlane32_swap(__float_as_uint(v), __float_as_uint(v), false, false); return __uint_as_float(r[0]) + __uint_as_float(r[1]); }
__device__ __forceinline__ float oct_sum(float v) { v += dpp_f<0xB1>(v); v += dpp_f<0x4E>(v); v += dpp_f<0x141>(v); return v; }
__device__ __forceinline__ int opaque_u(int x) { asm volatile("" : "+v"(x)); return __builtin_amdgcn_readfirstlane(x); }
template <class P> __device__ __forceinline__ P* opaque_p(P* p) { const unsigned long long v = (unsigned long long)p; unsigned lo = (unsigned)v, hi = (unsigned)(v >> 32); asm volatile("" : "+v"(lo), "+v"(hi));
    lo = __builtin_amdgcn_readfirstlane(lo); hi = __builtin_amdgcn_readfirstlane(hi);
    return (P*)(__attribute__((address_space(1))) P*)(((unsigned long long)hi << 32) | lo); }
struct Params { const float* in[24]; float* out; unsigned char* ws; int ph_lo, ph_hi; };

struct Ctx {
    const float* const* in; float* out; unsigned char* ws;
    LAS unsigned char* lds;
    int tid, lane, wave, bid, nb;
};

struct TItem { const float* src; bf16_t* dst; int ldw, ldt, ncol; };
__device__ __forceinline__ void titem_load(const TItem& t, float (&v)[32], int lane) {
    const int j = lane & 31, kh = lane >> 5;
#pragma unroll
    for (int i = 0; i < 32; ++i) v[i] = (j < t.ncol) ? t.src[(size_t)(2 * i + kh) * t.ldw + j] : 0.f;
}
__device__ __forceinline__ void titem_store(const TItem& t, const float (&v)[32], LAS float* scr, int lane) {
    const int j = lane & 31, kh = lane >> 5;
#pragma unroll
    for (int i = 0; i < 32; ++i) scr[(2 * i + kh) * 33 + j] = v[i];
    asm volatile("s_waitcnt lgkmcnt(0)" ::: "memory");
    const int c = lane & 7;
#pragma unroll
    for (int jj = 0; jj < 4; ++jj) { const int n = (lane >> 3) + 8 * jj; const LAS float* s = scr + (8 * c) * 33 + n;
        u32x4 o; o.x = pk2(s[0 * 33], s[1 * 33]); o.y = pk2(s[2 * 33], s[3 * 33]); o.z = pk2(s[4 * 33], s[5 * 33]); o.w = pk2(s[6 * 33], s[7 * 33]);
        *(u32x4*)(t.dst + (size_t)n * t.ldt + 8 * c) = o; }
    asm volatile("s_waitcnt lgkmcnt(0)" ::: "memory");
}
__device__ __forceinline__ TItem titem(const float* W, int ldw, int k0, int c0, int ncol, bf16_t* WT, int ldt, int r0, int kdst0) {
    TItem t; t.src = W + (size_t)k0 * ldw + c0; t.dst = WT + (size_t)r0 * ldt + kdst0 + k0; t.ldw = ldw; t.ldt = ldt; t.ncol = ncol; return t; }

__device__ __forceinline__ void win_map(int db, int& c0, int& ncol) {
    ncol = 32;
    if (db < 32) { const int i = db >> 3, w = db & 7; c0 = (w < 4) ? (128 * i + 32 * w) : (512 + 128 * i + 32 * (w - 4)); }
    else if (db < 48) c0 = 1024 + 32 * (db - 32);
    else if (db < 56) { const int q = db - 48; if (q < 2) c0 = 1536 + 32 * q; else if (q < 4) c0 = 1600 + 32 * (q - 2); else if (q == 4) c0 = 1920; else if (q == 5) { c0 = 1952; ncol = 8; } else { c0 = 0; ncol = 0; } }
    else if (db < 64) c0 = 1664 + 32 * (db - 56);
    else c0 = 1960 + 32 * (db - 64);
}
constexpr int IT_WIN = 16 * 128, IT_WC = 8 * 32, IT_WA = 8 * 32, IT_WO = 16 * 32, IT_MIX = IT_WIN + IT_WC + IT_WA + IT_WO;
constexpr int IT_GU = 32 * 16 * 16, IT_DN = 32 * 4 * 32, IT_MOE = IT_GU + IT_DN;
__device__ __forceinline__ TItem mixer_item(const Ctx& c, int l, int it) {
    bf16_t* WinT = (bf16_t*)(c.ws + WS_WIN) + (size_t)l * NINP * D;
    bf16_t* WcaT = (bf16_t*)(c.ws + WS_WCA) + (size_t)l * D * D;
    bf16_t* WoT = (bf16_t*)(c.ws + WS_WO) + (size_t)l * D * D;
    if (it < IT_WIN) { const int kb = it / 128, db = it % 128; int c0, nc; win_map(db, c0, nc); return titem(c.in[5] + (size_t)l * D * NIN, NIN, 64 * kb, c0, nc, WinT, D, 32 * db, 0); }
    it -= IT_WIN;
    if (it < IT_WC) { const int kb = it / 32, db = it % 32; return titem(c.in[12] + (size_t)l * CONV_CH * D, D, 64 * kb, 32 * db, 32, WcaT, D, 32 * db, 0); }
    it -= IT_WC;
    if (it < IT_WA) { const int kb = it / 32, db = it % 32; return titem(c.in[14] + (size_t)l * AW * D, D, 64 * kb, 32 * db, 32, WcaT, D, 32 * db, 512); }
    it -= IT_WA;
    { const int kb = it / 32, db = it % 32; return titem(c.in[15] + (size_t)l * D * D, D, 64 * kb, 32 * db, 32, WoT, D, 32 * db, 0); }
}
__device__ __forceinline__ TItem moe_item(const Ctx& c, int l, int it) {
    bf16_t* WguT = (bf16_t*)(c.ws + WS_WGU);
    bf16_t* WdT = (bf16_t*)(c.ws + WS_WD);
    if (it < IT_GU) { const int e = it / 256, r = it % 256, kb = r / 16, db = r % 16, j = db >> 3, w = db & 7;
        const float* src = (w < 4 ? c.in[21] : c.in[22]) + ((size_t)l * NE + e) * D * DE;
        return titem(src, DE, 64 * kb, 128 * j + 32 * (w & 3), 32, WguT + (size_t)e * 512 * D, D, 32 * db, 0); }
    it -= IT_GU;
    { const int e = it / 128, r = it % 128, kb = r / 32, db = r % 32;
        return titem(c.in[23] + ((size_t)l * NE + e) * DE * D, D, 64 * kb, 32 * db, 32, WdT + (size_t)e * D * DE, DE, 32 * db, 0); }
}
template <int KIND>
__device__ __forceinline__ void convert_items(const Ctx& c, int l, int first, int step, int nitems, LAS float* scr) {
    if (first >= nitems) return;
    auto get = [&](int it) { return KIND == 0 ? mixer_item(c, it / IT_MIX, it % IT_MIX) : moe_item(c, l, it); };
    TItem cur = get(first); float v[32]; titem_load(cur, v, c.lane);
    for (int it = first; it < nitems; it += step) {
        const int nx = it + step; TItem nt = cur; float nv[32];
        if (nx < nitems) { nt = get(nx); titem_load(nt, nv, c.lane); }
        titem_store(cur, v, scr, c.lane);
        if (nx < nitems) { cur = nt;
#pragma unroll
            for (int i = 0; i < 32; ++i) v[i] = nv[i]; }
    }
}

__device__ __forceinline__ void phase_prep(const Ctx& c) {
    LAS float* scr = (LAS float*)(c.lds + c.wave * 8704);
    const int gw = c.bid * NWAVES + c.wave, NGW = c.nb * NWAVES;
    float* cosH = (float*)(c.ws + WS_TAB); float* sinH = cosH + L * 32; float* cosI = sinH + L * 32; float* sinI = cosI + L * 16;
    for (int it = gw; it < (L * 32 + L * 16) / 64; it += NGW) {
        const bool hd = it < (L * 32) / 64; const int e = (hd ? it : it - (L * 32) / 64) * 64 + c.lane;
        const int pos = hd ? (e >> 5) : (e >> 4), i = hd ? (e & 31) : (e & 15);
        const float inv = powf(10000.f, -(float)(2 * i) / (hd ? 64.f : 32.f)); const float ang = (float)pos * inv;
        const float n = rintf(ang * 0.15915494309189535f); float r = fmaf(-n, 6.2831854820251465f, ang); r = fmaf(-n, -1.7484555314695172e-07f, r);
        const float cv_ = cosf(r), sv_ = sinf(r);
        if (hd) { cosH[e] = cv_; sinH[e] = sv_; } else { cosI[e] = cv_; sinI[e] = sv_; }
    }
    float* mod = (float*)(c.ws + WS_CTL + CTL_MOD);
    for (int it = c.bid; it < 2 * 96; it += c.nb) {
        const int l = it / 96, cc = it % 96, cg = c.lane & 15, ks = c.lane >> 4, col = 64 * cc + 4 * cg;
        const float* W = c.in[2] + (size_t)l * D * 6144; const float* cv = c.in[1];
        f32x4 a0 = {0.f, 0.f, 0.f, 0.f}, a1 = a0;
#pragma unroll 8
        for (int kk = 0; kk < 32; ++kk) { const int k = 128 * c.wave + 4 * kk + ks; const f32x4 w = *(const f32x4*)(W + (size_t)k * 6144 + col); const float s0 = siluf_(cv[k]), s1 = siluf_(cv[D + k]); a0 += w * s0; a1 += w * s1; }
#pragma unroll
        for (int i = 0; i < 4; ++i) { a0[i] += xor16_f(a0[i]); a0[i] = sum_x32(a0[i]); a1[i] += xor16_f(a1[i]); a1[i] = sum_x32(a1[i]); }
        LAS f32x4* red = (LAS f32x4*)(c.lds + 8 * 8704);
        __syncthreads();
        if (ks == 0) { red[(c.wave * 2 + 0) * 16 + cg] = a0; red[(c.wave * 2 + 1) * 16 + cg] = a1; }
        __syncthreads();
        if (c.tid < 32) { const int b = c.tid >> 4; f32x4 t = *(const f32x4*)(c.in[3] + l * 6144 + col);
#pragma unroll
            for (int w = 0; w < 8; ++w) t += red[(w * 2 + b) * 16 + cg];
            *(f32x4*)(mod + (l * 2 + b) * 6144 + col) = t; }
    }
    convert_items<0>(c, 0, gw, NGW, 2 * IT_MIX, scr);
    convert_items<1>(c, 0, gw, NGW, IT_MOE, scr);
}

__device__ __forceinline__ void norm_row_store(const f32x4 (&v)[4], const float* g, const float* shift, const float* scale, bf16_t* orow, int lane) {
    float s = 0.f;
#pragma unroll
    for (int j = 0; j < 4; ++j) s += (v[j].x * v[j].x + v[j].y * v[j].y) + (v[j].z * v[j].z + v[j].w * v[j].w);
    const float rstd = __builtin_amdgcn_rsqf(wave_sum(s) * (1.f / D) + EPS);
#pragma unroll
    for (int j = 0; j < 4; ++j) { const int col = 4 * lane + 256 * j; const f32x4 gv = *(const f32x4*)(g + col), sh = *(const f32x4*)(shift + col), sc = *(const f32x4*)(scale + col);
        const f32x4 o = v[j] * rstd * gv * (sc + 1.f) + sh;
        u32x2 w; w.x = pk2(o.x, o.y); w.y = pk2(o.z, o.w); *(u32x2*)(orow + col) = w; }
}
__device__ __forceinline__ void phase_norm1(const Ctx& c, int l) {
    const int gw = c.bid * NWAVES + c.wave, NGW = c.nb * NWAVES;
    const float* xin = (l == 0) ? c.in[0] : c.out; const float* mod = (const float*)(c.ws + WS_CTL + CTL_MOD);
    bf16_t* H = (bf16_t*)(c.ws + WS_H);
    for (int m0 = gw; m0 < T; m0 += 4 * NGW) {
        f32x4 v[4][4];
#pragma unroll
        for (int i = 0; i < 4; ++i) { const int m = (m0 + i * NGW < T) ? m0 + i * NGW : m0;
#pragma unroll
            for (int j = 0; j < 4; ++j) v[i][j] = *(const f32x4*)(xin + (size_t)m * D + 4 * c.lane + 256 * j); }
#pragma unroll
        for (int i = 0; i < 4; ++i) { const int m = m0 + i * NGW; if (m < T) { const float* mb = mod + (l * 2 + m / L) * 6144; norm_row_store(v[i], c.in[4] + l * D, mb, mb + D, H + (size_t)m * D, c.lane); } }
    }
}

namespace pg8 {
#define PG8_LAS __attribute__((address_space(3)))
constexpr int BM = 256, BK = 64, HALF = 128, HTB = HALF * BK * 2  , STAGE_BYTES = 8 * HTB, NXCD = 8, WGM = 8;
__host__ __device__ __forceinline__ int lds_byte(int r, int c) { const int st = (r >> 4) * 2 + (c >> 5), rr = r & 15, cc = c & 31, ob = rr * 64 + cc * 2; return st * 1024 + (ob ^ (((ob >> 9) & 1) << 5)); }
__host__ __device__ __forceinline__ void stage_rc(int b, int& R, int& C) { const int st = b / 1024, sb = b % 1024, swz = sb ^ (((sb >> 9) & 1) << 5); R = (st >> 1) * 16 + swz / 64; C = (st & 1) * 32 + (swz % 64) / 2; }
__host__ __device__ __forceinline__ int perm32(int rho) { const int n = rho >> 4, i = rho & 15; return 8 * (i >> 2) + 4 * n + (i & 3); }
struct GUnit { const char* A; const char* B; const int* rows; int pm, pn, aux, row0; };
struct Gemm { int lda, ldb, K, M; };
__device__ __forceinline__ void tile_order(int L, int nM, int nN, int& pm, int& pn) {
    const int nwg = nM * nN; int wgid = L; { const int q = nwg / NXCD, r = nwg % NXCD, xcd = wgid % NXCD, off = wgid / NXCD; wgid = (xcd < r ? xcd * (q + 1) : r * (q + 1) + (xcd - r) * q) + off; }
    const int nig = WGM * nN, gid = wgid / nig, fm = gid * WGM, gsz = (nM - fm) < WGM ? (nM - fm) : WGM;
    pm = fm + ((wgid % nig) % gsz); pn = (wgid % nig) / gsz;
}
template <class Epi, class Sched, bool ALIGN_EPI = false, bool SP2 = false, bool GATHER = false>
__device__ __forceinline__ void gemm_phase(PG8_LAS unsigned char* lds, const Gemm g, const Sched& S, const Epi& E, const int tid_in) {
    const int tid = tid_in, wid = __builtin_amdgcn_readfirstlane(tid >> 6), lane = tid & 63, wr = wid >> 2, wc = wid & 3, fr = lane & 15, fq = lane >> 4;
    const int K = g.K, nt = K / BK;
    unsigned voffA[2], voffB[2];
#pragma unroll
    for (int i = 0; i < 2; ++i) { int R, C; stage_rc(tid * 16 + i * 8192, R, C); const int Rb = Epi::PERM ? ((R & ~31) + perm32(R & 31)) : R;
        voffA[i] = (unsigned)(R * g.lda + C) * 2u; voffB[i] = (unsigned)(Rb * g.ldb + C) * 2u; }
    const size_t kstep = (size_t)(BK * 2);
    const size_t hstepA = (size_t)HALF * g.lda * 2, hstepB = (size_t)HALF * g.ldb * 2;
    const unsigned ldsw = (unsigned)wid * 1024u;
    const int aoff = lds_byte(wr * 64 + fr, fq * 8), boff = lds_byte(wc * 32 + fr, fq * 8);
#define PG8_SA(b, h) (((b) * 2 + (h)) * HTB)
#define PG8_SB(b, h) ((4 + (b) * 2 + (h)) * HTB)
#define PG8_STAGE(bufoff, gbase, voff) do { _Pragma("unroll") for (int _i = 0; _i < 2; ++_i) \
        __builtin_amdgcn_global_load_lds((const unsigned*)((const char*)(gbase) + (voff)[_i]), (PG8_LAS unsigned*)(lds + (bufoff) + ldsw + _i * 8192), 16, 0, 0); } while (0)
#define PG8_STAGE_A(bufoff, gbase, off2) do { _Pragma("unroll") for (int _i = 0; _i < 2; ++_i) \
        __builtin_amdgcn_global_load_lds((const unsigned*)((const char*)(gbase) + (off2)[_i]), (PG8_LAS unsigned*)(lds + (bufoff) + ldsw + _i * 8192), 16, 0, 0); } while (0)
#define PG8_LDA(dst, b, h) do { _Pragma("unroll") for (int m = 0; m < 4; ++m) _Pragma("unroll") for (int k = 0; k < 2; ++k) dst[m][k] = *(const PG8_LAS bf16x8*)(lds + PG8_SA(b, h) + aoff + m * 2048 + k * 1024); } while (0)
#define PG8_LDB(dst, b, h) do { _Pragma("unroll") for (int n = 0; n < 2; ++n) _Pragma("unroll") for (int k = 0; k < 2; ++k) dst[n][k] = *(const PG8_LAS bf16x8*)(lds + PG8_SB(b, h) + boff + n * 2048 + k * 1024); } while (0)
#define PG8_MMA(ai, bj, At, Bt) do { __builtin_amdgcn_s_setprio(1); _Pragma("unroll") for (int m = 0; m < 4; ++m) _Pragma("unroll") for (int n = 0; n < 2; ++n) _Pragma("unroll") for (int k = 0; k < 2; ++k) \
        acc[ai][bj][m][n] = __builtin_amdgcn_mfma_f32_16x16x32_bf16(Bt[n][k], At[m][k], acc[ai][bj][m][n], 0, 0, 0); __builtin_amdgcn_s_setprio(0); } while (0)
#define PG8_WAIT_V(n) asm volatile("s_waitcnt vmcnt(" #n ")" ::: "memory")
#define PG8_WAIT_L(n) asm volatile("s_waitcnt lgkmcnt(" #n ")" ::: "memory")
#define PG8_BAR __builtin_amdgcn_s_barrier()
#define PG8_SCHED __builtin_amdgcn_sched_barrier(0)
    GUnit cur, nxt; int ui = 0;
    if (!S.next(0, cur)) return;
    f32x4 acc[2][2][4][2];
#pragma unroll
    for (int a = 0; a < 2; ++a)
#pragma unroll
        for (int b = 0; b < 2; ++b)
#pragma unroll
            for (int m = 0; m < 4; ++m)
#pragma unroll
                for (int n = 0; n < 2; ++n) acc[a][b][m][n] = (f32x4){0.f, 0.f, 0.f, 0.f};
    bf16x8 At[4][2], B0[2][2], B1[2][2];
    const char* cA = cur.A; const char* cB = cur.B;
    int stR[2], stC[2];
#pragma unroll
    for (int i = 0; i < 2; ++i) stage_rc(tid * 16 + i * 8192, stR[i], stC[i]);
    unsigned coff[2][2], noff[2][2];
#pragma unroll
    for (int h = 0; h < 2; ++h)
#pragma unroll
        for (int i = 0; i < 2; ++i) { if (GATHER) { int r = cur.rows[128 * h + stR[i]]; r = (unsigned)r < (unsigned)g.M ? r : 0; coff[h][i] = ((unsigned)r * (unsigned)g.lda + (unsigned)stC[i]) * 2u; } else coff[h][i] = voffA[i] + (unsigned)(h * hstepA); noff[h][i] = coff[h][i]; }
    S.a_ready(cur);
    if constexpr (SP2) {
        PG8_STAGE(PG8_SB(0, 0), cB, voffB); PG8_STAGE(PG8_SB(0, 1), cB + hstepB, voffB); PG8_STAGE_A(PG8_SA(0, 0), cA, coff[0]); PG8_STAGE_A(PG8_SA(0, 1), cA, coff[1]);
        if (wr == 1) PG8_BAR;
        PG8_WAIT_V(2); PG8_BAR;
        PG8_STAGE(PG8_SB(1, 0), cB + kstep, voffB); PG8_STAGE_A(PG8_SA(1, 0), cA + kstep, coff[0]); PG8_STAGE(PG8_SB(1, 1), cB + hstepB + kstep, voffB);
        PG8_WAIT_V(6); PG8_BAR;
    } else {
        PG8_STAGE(PG8_SB(0, 0), cB, voffB); PG8_STAGE_A(PG8_SA(0, 0), cA, coff[0]); PG8_STAGE(PG8_SB(0, 1), cB + hstepB, voffB); PG8_STAGE_A(PG8_SA(0, 1), cA, coff[1]);
        if (wr == 1) PG8_BAR;
        PG8_WAIT_V(4); PG8_BAR;
        PG8_STAGE(PG8_SB(1, 0), cB + kstep, voffB); PG8_STAGE_A(PG8_SA(1, 0), cA + kstep, coff[0]); PG8_STAGE(PG8_SB(1, 1), cB + hstepB + kstep, voffB);
        PG8_WAIT_V(6); PG8_BAR;
    }
    for (;;) {
        const bool has_next = S.next(ui + 1, nxt);
        const char* nA = has_next ? nxt.A : cA; const char* nB = has_next ? nxt.B : cB;
        if (GATHER) {
#pragma unroll
            for (int h = 0; h < 2; ++h)
#pragma unroll
                for (int i = 0; i < 2; ++i) { if (has_next) { int r = nxt.rows[128 * h + stR[i]]; r = (unsigned)r < (unsigned)g.M ? r : 0; noff[h][i] = ((unsigned)r * (unsigned)g.lda + (unsigned)stC[i]) * 2u; } else noff[h][i] = coff[h][i]; } }
        for (int t = 0; t < nt; t += 2) {
            const bool last = (t == nt - 2);
            const char* a1 = cA + (size_t)(t + 1) * kstep;
            const char* a2 = last ? nA : cA + (size_t)(t + 2) * kstep; const char* b2 = last ? nB : cB + (size_t)(t + 2) * kstep;
            const char* a3 = a2 + kstep; const char* b3 = b2 + kstep;
            unsigned xoff[2][2];
#pragma unroll
            for (int h = 0; h < 2; ++h)
#pragma unroll
                for (int i = 0; i < 2; ++i) xoff[h][i] = (GATHER && last) ? noff[h][i] : coff[h][i];
            if (last && has_next) S.a_ready(nxt);
            if constexpr (SP2) {
            PG8_LDB(B0, 0, 0); PG8_LDB(B1, 0, 1); PG8_SCHED; PG8_LDA(At, 0, 0); PG8_STAGE_A(PG8_SA(1, 1), a1, coff[1]);
            PG8_WAIT_V(8); PG8_WAIT_L(0); PG8_BAR; PG8_MMA(0, 0, At, B0); PG8_MMA(0, 1, At, B1); PG8_BAR; PG8_SCHED;
            PG8_LDA(At, 0, 1); PG8_STAGE(PG8_SB(0, 0), b2, voffB); PG8_STAGE(PG8_SB(0, 1), b2 + hstepB, voffB); PG8_STAGE_A(PG8_SA(0, 0), a2, xoff[0]);
            PG8_WAIT_V(8); PG8_WAIT_L(0); PG8_BAR; PG8_MMA(1, 0, At, B0); PG8_MMA(1, 1, At, B1); PG8_BAR; PG8_SCHED;
            PG8_LDB(B0, 1, 0); PG8_LDB(B1, 1, 1); PG8_SCHED; PG8_LDA(At, 1, 0); PG8_STAGE_A(PG8_SA(0, 1), a2, xoff[1]);
            PG8_WAIT_V(8); PG8_WAIT_L(0); PG8_BAR; PG8_MMA(0, 0, At, B0); PG8_MMA(0, 1, At, B1); PG8_BAR; PG8_SCHED;
            PG8_LDA(At, 1, 1); PG8_STAGE(PG8_SB(1, 0), b3, voffB); PG8_STAGE(PG8_SB(1, 1), b3 + hstepB, voffB); PG8_STAGE_A(PG8_SA(1, 0), a3, xoff[0]);
            PG8_WAIT_V(8); PG8_WAIT_L(0); PG8_BAR; PG8_MMA(1, 0, At, B0); PG8_MMA(1, 1, At, B1); PG8_BAR; PG8_SCHED;
            } else {
            PG8_LDB(B0, 0, 0); PG8_SCHED; PG8_LDA(At, 0, 0); PG8_STAGE_A(PG8_SA(1, 1), a1, coff[1]);
            PG8_WAIT_L(8); PG8_BAR; PG8_WAIT_L(0); PG8_MMA(0, 0, At, B0); PG8_BAR; PG8_SCHED;
            PG8_LDB(B1, 0, 1); PG8_STAGE(PG8_SB(0, 0), b2, voffB);
            PG8_BAR; PG8_WAIT_L(0); PG8_MMA(0, 1, At, B1); PG8_BAR;
            PG8_LDA(At, 0, 1); PG8_STAGE_A(PG8_SA(0, 0), a2, xoff[0]);
            PG8_BAR; PG8_WAIT_L(0); PG8_MMA(1, 0, At, B0); PG8_BAR; PG8_SCHED;
            PG8_STAGE(PG8_SB(0, 1), b2 + hstepB, voffB);
            PG8_WAIT_V(6); PG8_BAR; PG8_MMA(1, 1, At, B1); PG8_BAR;
            PG8_LDB(B0, 1, 0); PG8_SCHED; PG8_LDA(At, 1, 0); PG8_STAGE_A(PG8_SA(0, 1), a2, xoff[1]);
            PG8_WAIT_L(8); PG8_BAR; PG8_WAIT_L(0); PG8_MMA(0, 0, At, B0); PG8_BAR; PG8_SCHED;
            PG8_LDB(B1, 1, 1); PG8_STAGE(PG8_SB(1, 0), b3, voffB);
            PG8_BAR; PG8_WAIT_L(0); PG8_MMA(0, 1, At, B1); PG8_BAR;
            PG8_LDA(At, 1, 1); PG8_STAGE_A(PG8_SA(1, 0), a3, xoff[0]);
            PG8_BAR; PG8_WAIT_L(0); PG8_MMA(1, 0, At, B0); PG8_BAR; PG8_SCHED;
            PG8_STAGE(PG8_SB(1, 1), b3 + hstepB, voffB);
            PG8_WAIT_V(6); PG8_BAR; PG8_MMA(1, 1, At, B1); PG8_BAR;
            }
        }
        if constexpr (ALIGN_EPI) { if (wr == 0) PG8_BAR; }
        if constexpr (!Epi::AFTER_DRAIN) { E(acc, cur, wr, wc, fr, fq); S.done(cur); }
        if (!has_next) break;
#pragma unroll
        for (int a = 0; a < 2; ++a)
#pragma unroll
            for (int b = 0; b < 2; ++b)
#pragma unroll
                for (int m = 0; m < 4; ++m)
#pragma unroll
                    for (int n = 0; n < 2; ++n) acc[a][b][m][n] = (f32x4){0.f, 0.f, 0.f, 0.f};
        cur = nxt; cA = nA; cB = nB; ++ui;
        if (GATHER) {
#pragma unroll
            for (int h = 0; h < 2; ++h)
#pragma unroll
                for (int i = 0; i < 2; ++i) coff[h][i] = noff[h][i]; }
        if constexpr (ALIGN_EPI) { if (wr == 1) PG8_BAR; }
    }
    PG8_WAIT_V(0);
    if constexpr (!ALIGN_EPI) { if (wr == 0) PG8_BAR; }
    PG8_BAR;
    if constexpr (Epi::AFTER_DRAIN) { E.fused(acc, cur, wr, wc, fr, fq, lds, wid, lane); S.done(cur); }
#undef PG8_SA
#undef PG8_SB
#undef PG8_STAGE
#undef PG8_STAGE_A
#undef PG8_LDA
#undef PG8_LDB
#undef PG8_MMA
#undef PG8_WAIT_V
#undef PG8_WAIT_L
#undef PG8_BAR
#undef PG8_SCHED
}
}
using pg8::GUnit;
#define EPI_COMMON_P static constexpr bool PERM = true, AFTER_DRAIN = false; \
    __device__ __forceinline__ void operator()(const f32x4 (&acc)[2][2][4][2], const GUnit& u, int wr, int wc, int fr, int fq) const { half(acc[0], 0, u, wr, wc, fr, fq); half(acc[1], 1, u, wr, wc, fr, fq); }
#define EPI_COMMON static constexpr bool PERM = false, AFTER_DRAIN = false; \
    __device__ __forceinline__ void operator()(const f32x4 (&acc)[2][2][4][2], const GUnit& u, int wr, int wc, int fr, int fq) const { half(acc[0], 0, u, wr, wc, fr, fq); half(acc[1], 1, u, wr, wc, fr, fq); }

__device__ __forceinline__ u32x2 pack4(const f32x4 v) { u32x2 w; w.x = pk2(v.x, v.y); w.y = pk2(v.z, v.w); return w; }
__device__ __forceinline__ u32x4 pack8(const f32x4 a, const f32x4 b) { return (u32x4){pk2(a.x, a.y), pk2(a.z, a.w), pk2(b.x, b.y), pk2(b.z, b.w)}; }
__device__ __forceinline__ f32x4 unpack4(const u32x2 w) { return (f32x4){bflo(w.x), bfhi(w.x), bflo(w.y), bfhi(w.y)}; }

struct EpiIn {
    EPI_COMMON_P
    bf16_t* uglu; bf16_t* rawb; float* rawf; bf16_t* gates;
    __device__ __forceinline__ void half(const f32x4 (&acc)[2][4][2], int ai, const GUnit& u, int wr, int wc, int fr, int fq) const {
        const int pn = u.pn, c8 = 32 * wc + 8 * fq;
#pragma unroll
        for (int m = 0; m < 4; ++m) { const size_t row = (size_t)u.row0 + 128 * ai + 64 * wr + 16 * m + fr;
            if (pn < 4) { f32x4 o[2];
#pragma unroll
                for (int n = 0; n < 2; ++n)
#pragma unroll
                    for (int i = 0; i < 4; ++i) o[n][i] = acc[0][m][n][i] * sigmoidf_(acc[1][m][n][i]);
                *(u32x4*)(uglu + row * 512 + 128 * pn + c8) = pack8(o[0], o[1]);
            } else if (pn == 6) {
#pragma unroll
                for (int bj = 0; bj < 2; ++bj)
#pragma unroll
                    for (int n = 0; n < 2; ++n) *(f32x4*)(rawf + row * 256 + 128 * bj + c8 + 4 * n) = acc[bj][m][n];
            } else if (pn < 8) { const int cb0 = (pn == 7) ? 512 : 256 * (pn - 4);
#pragma unroll
                for (int bj = 0; bj < 2; ++bj) *(u32x4*)(rawb + row * 768 + cb0 + 128 * bj + c8) = pack8(acc[bj][m][0], acc[bj][m][1]);
            } else {
#pragma unroll
                for (int bj = 0; bj < 2; ++bj) { f32x4 o[2];
#pragma unroll
                    for (int n = 0; n < 2; ++n)
#pragma unroll
                        for (int i = 0; i < 4; ++i) o[n][i] = sigmoidf_(acc[bj][m][n][i]);
                    *(u32x4*)(gates + row * 2048 + 256 * (pn - 8) + 128 * bj + c8) = pack8(o[0], o[1]); }
            } }
    }
};
struct SchedIn { const char* A; const char* B; int G, c;
    __device__ __forceinline__ bool next(int i, GUnit& u) const { const int Lq = i * G + c; if (Lq >= 64 * 16) return false; int pm, pn; pg8::tile_order(Lq, 64, 16, pm, pn);
        u.pm = pm; u.pn = pn; u.aux = 0; u.row0 = pm * 256; u.rows = nullptr; u.A = A + (size_t)pm * 256 * D * 2; u.B = B + (size_t)pn * 256 * D * 2; return true; }
    __device__ __forceinline__ void a_ready(const GUnit&) const {}
    __device__ __forceinline__ void done(const GUnit&) const {}
};
__device__ __forceinline__ void phase_gemm_in(const Ctx& c, int l) {
    SchedIn S{(const char*)(c.ws + WS_H), (const char*)(c.ws + WS_WIN) + (size_t)l * NINP * D * 2, c.nb, c.bid};
    EpiIn E{(bf16_t*)(c.ws + WS_UGLU), (bf16_t*)(c.ws + WS_RAW), (float*)(c.ws + WS_RAWF), (bf16_t*)(c.ws + WS_GATES)};
    pg8::gemm_phase<EpiIn, SchedIn, true, true>(c.lds, pg8::Gemm{D, D, opaque_u(D), T}, S, E, c.tid);
}

template <int PART>
__device__ __forceinline__ void phase_post_conv(const Ctx& c, int l) {
    const int gw = c.bid * NWAVES + c.wave, NGW = c.nb * NWAVES, lane = c.lane;
    const bf16_t* RAWB = (const bf16_t*)(c.ws + WS_RAW); const float* RAWF = (const float*)(c.ws + WS_RAWF);
    const float* cosH = (const float*)(c.ws + WS_TAB); const float* sinH = cosH + L * 32; const float* cosI = sinH + L * 32; const float* sinI = cosI + L * 16;
    bf16_t* QN = (bf16_t*)(c.ws + WS_QN); bf16_t* KN = (bf16_t*)(c.ws + WS_KN); bf16_t* VB = (bf16_t*)(c.ws + WS_VB);
    bf16_t* IQ = (bf16_t*)(c.ws + WS_IQ); bf16_t* IK = (bf16_t*)(c.ws + WS_IK); float* IW = (float*)(c.ws + WS_IW);
    const float* qg = c.in[6] + l * HD; const float* kg = c.in[7] + l * HD; float* PRo = (float*)(c.ws + WS_PR);
    float mxk0 = 0.f, mxk1 = 0.f;
    struct PostIn { f32x4 q0, q1, kv0, kv1, iq, ik, ch0, ch1, sh0, sh1, ci, si; float iw; };
    const int cc = lane & 7, c4 = cc & 3; const bool hi = cc >= 4;
    auto load_in = [&](int m) { PostIn p; const int t = m % L; const bf16_t* rb_ = RAWB + (size_t)m * 768; const float* r = RAWF + (size_t)m * 256;
        { const u32x4 wq = *(const u32x4*)(rb_ + 8 * lane); p.q0 = (f32x4){bflo(wq.x), bfhi(wq.x), bflo(wq.y), bfhi(wq.y)}; p.q1 = (f32x4){bflo(wq.z), bfhi(wq.z), bflo(wq.w), bfhi(wq.w)}; }
        const int off = (lane < 8) ? (8 * lane) : (64 + 8 * (lane & 7)); p.kv0 = *(const f32x4*)(r + off); p.kv1 = *(const f32x4*)(r + off + 4);
        { const u32x2 wi = *(const u32x2*)(rb_ + 512 + 4 * lane); p.iq = (f32x4){bflo(wi.x), bfhi(wi.x), bflo(wi.y), bfhi(wi.y)}; }
        p.ik = *(const f32x4*)(r + 128 + 4 * (lane & 7)); p.iw = r[160 + (lane & 7)];
        p.ch0 = *(const f32x4*)(cosH + t * 32 + 8 * c4); p.ch1 = *(const f32x4*)(cosH + t * 32 + 8 * c4 + 4); p.sh0 = *(const f32x4*)(sinH + t * 32 + 8 * c4); p.sh1 = *(const f32x4*)(sinH + t * 32 + 8 * c4 + 4);
        p.ci = *(const f32x4*)(cosI + t * 16 + 4 * c4); p.si = *(const f32x4*)(sinI + t * 16 + 4 * c4); return p; };
    float qgr[8], kgr[8];
    { const f32x4 a = *(const f32x4*)(qg + 8 * cc), b = *(const f32x4*)(qg + 8 * cc + 4), d = *(const f32x4*)(kg + 8 * cc), e = *(const f32x4*)(kg + 8 * cc + 4);
        qgr[0] = a.x; qgr[1] = a.y; qgr[2] = a.z; qgr[3] = a.w; qgr[4] = b.x; qgr[5] = b.y; qgr[6] = b.z; qgr[7] = b.w;
        kgr[0] = d.x; kgr[1] = d.y; kgr[2] = d.z; kgr[3] = d.w; kgr[4] = e.x; kgr[5] = e.y; kgr[6] = e.z; kgr[7] = e.w; }
    LAS unsigned* mxl = (LAS unsigned*)(c.lds + 64512);
    if (c.tid < 2) mxl[c.tid] = 0u;
    __syncthreads();
    PostIn nx = load_in(gw < T ? gw : 0);
    for (int m = gw; m < ((PART & 1) ? T : 0); m += NGW) {
        const PostIn p = nx; { const int mn = m + NGW; nx = load_in(mn < T ? mn : m); }
        const float csq[8] = {p.ch0.x, p.ch0.y, p.ch0.z, p.ch0.w, p.ch1.x, p.ch1.y, p.ch1.z, p.ch1.w}, snq[8] = {p.sh0.x, p.sh0.y, p.sh0.z, p.sh0.w, p.sh1.x, p.sh1.y, p.sh1.z, p.sh1.w};
        {
            float x[8] = {p.q0.x, p.q0.y, p.q0.z, p.q0.w, p.q1.x, p.q1.y, p.q1.z, p.q1.w}; float s = 0.f;
#pragma unroll
            for (int i = 0; i < 8; ++i) s += x[i] * x[i];
            s = oct_sum(s);
            const float rstd = __builtin_amdgcn_rsqf(s * (1.f / 64.f) + EPS); float o[8];
#pragma unroll
            for (int i = 0; i < 8; ++i) x[i] = x[i] * rstd * qgr[i];
#pragma unroll
            for (int i = 0; i < 8; ++i) { const float other = __shfl_xor(x[i], 4); o[i] = (hi ? (x[i] * csq[i] + other * snq[i]) : (x[i] * csq[i] - other * snq[i])) * 0.125f; }
            u32x4 w; w.x = pk2(o[0], o[1]); w.y = pk2(o[2], o[3]); w.z = pk2(o[4], o[5]); w.w = pk2(o[6], o[7]);
            *(u32x4*)(QN + (size_t)m * 512 + 8 * lane) = w;
        }
        {
            float x[8] = {p.kv0.x, p.kv0.y, p.kv0.z, p.kv0.w, p.kv1.x, p.kv1.y, p.kv1.z, p.kv1.w}; float s = 0.f;
#pragma unroll
            for (int i = 0; i < 8; ++i) s += x[i] * x[i];
            s = oct_sum(s);
            const float rstd = __builtin_amdgcn_rsqf(s * (1.f / 64.f) + EPS); float xn[8], o[8];
#pragma unroll
            for (int i = 0; i < 8; ++i) xn[i] = x[i] * rstd * kgr[i];
#pragma unroll
            for (int i = 0; i < 8; ++i) { const float other = __shfl_xor(xn[i], 4); o[i] = hi ? (xn[i] * csq[i] + other * snq[i]) : (xn[i] * csq[i] - other * snq[i]); }
            if (lane < 8) { u32x4 w; w.x = pk2(o[0], o[1]); w.y = pk2(o[2], o[3]); w.z = pk2(o[4], o[5]); w.w = pk2(o[6], o[7]); *(u32x4*)(KN + (size_t)m * 64 + 8 * lane) = w; }
            else if (lane < 16) { u32x4 w; w.x = pk2(x[0], x[1]); w.y = pk2(x[2], x[3]); w.z = pk2(x[4], x[5]); w.w = pk2(x[6], x[7]); *(u32x4*)(VB + (size_t)m * 64 + 8 * (lane & 7)) = w; }
        }
        const float csi[4] = {p.ci.x, p.ci.y, p.ci.z, p.ci.w}, sni[4] = {p.si.x, p.si.y, p.si.z, p.si.w};
        {
            const f32x4 a = p.iq; float o[4];
#pragma unroll
            for (int i = 0; i < 4; ++i) { const float other = __shfl_xor(a[i], 4); o[i] = hi ? (a[i] * csi[i] + other * sni[i]) : (a[i] * csi[i] - other * sni[i]); }
            u32x2 w; w.x = pk2(o[0], o[1]); w.y = pk2(o[2], o[3]); *(u32x2*)(IQ + (size_t)m * 256 + 4 * lane) = w;
            float n2 = bflo(w.x) * bflo(w.x) + bfhi(w.x) * bfhi(w.x) + bflo(w.y) * bflo(w.y) + bfhi(w.y) * bfhi(w.y);
            n2 = oct_sum(n2);
            const float wh = __shfl(p.iw, lane >> 3);
            const float prs = wave_sum((lane & 7) == 0 ? fabsf(wh) * sqrtf(n2) : 0.f);
            if (lane == 0) PRo[m] = prs;
        }
        {
            const f32x4 a = p.ik; float o[4];
#pragma unroll
            for (int i = 0; i < 4; ++i) { const float other = __shfl_xor(a[i], 4); o[i] = hi ? (a[i] * csi[i] + other * sni[i]) : (a[i] * csi[i] - other * sni[i]); }
            u32x2 w; w.x = pk2(o[0], o[1]); w.y = pk2(o[2], o[3]);
            if (lane < 8) *(u32x2*)(IK + (size_t)m * 32 + 4 * lane) = w;
            else if (lane < 16) IW[(size_t)m * 8 + (lane & 7)] = p.iw;
            float n2 = bflo(w.x) * bflo(w.x) + bfhi(w.x) * bfhi(w.x) + bflo(w.y) * bflo(w.y) + bfhi(w.y) * bfhi(w.y);
            n2 = oct_sum(n2);
            if (m < L) mxk0 = fmaxf(mxk0, n2); else mxk1 = fmaxf(mxk1, n2);
        }
    }
    if (lane == 0) { __hip_atomic_fetch_max(mxl, __float_as_uint(mxk0), __ATOMIC_RELAXED, __HIP_MEMORY_SCOPE_WORKGROUP); __hip_atomic_fetch_max(mxl + 1, __float_as_uint(mxk1), __ATOMIC_RELAXED, __HIP_MEMORY_SCOPE_WORKGROUP); }
    const bf16_t* UG = (const bf16_t*)(c.ws + WS_UGLU); bf16_t* YO = (bf16_t*)(c.ws + WS_YO);
    const float* cw = c.in[8] + (size_t)l * CONV_W * CONV_CH; const float* cb = c.in[9] + l * CONV_CH; const float* lg = c.in[10] + l * CONV_CH; const float* lb = c.in[11] + l * CONV_CH;
    LAS unsigned char* ut = c.lds; LAS float* st = (LAS float*)(c.lds + 63488); LAS f32x2* ys = (LAS f32x2*)(c.lds + 65536) + c.wave * 1024;
    const int half = c.wave >> 2, wq = c.wave & 3, ch = 128 * wq + 2 * lane;
    f32x2 w2[CONV_W];
#pragma unroll
    for (int j = 0; j < CONV_W; ++j) w2[j] = *(const f32x2*)(cw + j * CONV_CH + ch);
    const f32x2 bv = *(const f32x2*)(cb + ch), gv = *(const f32x2*)(lg + ch), lv = *(const f32x2*)(lb + ch);
    for (int tile = c.bid; tile < ((PART & 2) ? T / 32 : 0); tile += c.nb) {
        const int m0 = tile * 32, tl0 = m0 % L;
        __syncthreads();
        { u32x4 sv[8];
#pragma unroll
            for (int k = 0; k < 8; ++k) { const int i = c.tid + NTHREADS * k, row = i >> 6, pc = i & 63; sv[k] = (u32x4){0u, 0u, 0u, 0u};
                if (row < 62 && tl0 - 30 + row >= 0) sv[k] = *(const u32x4*)(UG + (size_t)(m0 - 30 + row) * 512 + 8 * pc); }
#pragma unroll
            for (int k = 0; k < 8; ++k) { const int i = c.tid + NTHREADS * k, row = i >> 6, pc = i & 63; if (row < 62) *(LAS u32x4*)(ut + row * 1024 + 16 * pc) = sv[k]; } }
        __syncthreads();
        {
            f32x2 y16[16];
#pragma unroll
            for (int tk = 0; tk < 16; ++tk) y16[tk] = bv;
            const LAS unsigned char* ub = ut + (16 * half) * 1024 + ch * 2;
#pragma unroll
            for (int i = 0; i < 46; ++i) { const unsigned uu = *(const LAS unsigned*)(ub + i * 1024); const f32x2 u2 = {bflo(uu), bfhi(uu)};
#pragma unroll
                for (int tk = 0; tk < 16; ++tk) if (i - tk >= 0 && i - tk < CONV_W) y16[tk] = __builtin_elementwise_fma(u2, w2[i - tk], y16[tk]); }
#pragma unroll
            for (int tk = 0; tk < 16; ++tk) { const int tr = 16 * half + tk; const f32x2 y2 = y16[tk];
                ys[tk * 64 + lane] = y2;
                const float s1 = wave_sum(y2.x + y2.y), s2 = wave_sum(y2.x * y2.x + y2.y * y2.y);
                if (lane == 0) { st[(tr * 4 + wq) * 2] = s1; st[(tr * 4 + wq) * 2 + 1] = s2; } } }
        __syncthreads();
#pragma unroll 1
        for (int tk = 0; tk < 16; ++tk) { const int tr = 16 * half + tk; const f32x2 y2 = ys[tk * 64 + lane];
            const f32x4 sa = *(const LAS f32x4*)(st + tr * 8), sb = *(const LAS f32x4*)(st + tr * 8 + 4);
            const float mu = ((sa.x + sa.z) + (sb.x + sb.z)) * (1.f / CONV_CH), ex2 = ((sa.y + sa.w) + (sb.y + sb.w)) * (1.f / CONV_CH);
            const float rstd = __builtin_amdgcn_rsqf(fmaxf(ex2 - mu * mu, 0.f) + EPS);
            const float o0 = siluf_((y2.x - mu) * rstd * gv.x + lv.x), o1 = siluf_((y2.y - mu) * rstd * gv.y + lv.y);
            *(unsigned*)(YO + (size_t)(m0 + tr) * 1024 + ch) = pk2(o0, o1); }
    }
    __syncthreads();
    if (c.tid < 2) atomicMax((unsigned*)(c.ws + WS_CTL + CTL_MAXIK) + l * 2 + c.tid, mxl[c.tid]);
}

typedef float f32x16 __attribute__((ext_vector_type(16)));
typedef short s16x4 __attribute__((ext_vector_type(4)));
constexpr int IDX_NB = 2048, IDX_QB = 16, IDX_G = 4;
#ifndef IDX_ZOOM
#define IDX_ZOOM 3
#endif
#ifndef IDX_CAP
#define IDX_CAP 256
#endif
constexpr int IL_HIST = 0;
constexpr int IL_FHIST = 32768;
constexpr int IL_VS = 32768;
constexpr int IL_MASK = 114688;
constexpr int IL_SEL = 131072;
constexpr int IL_QI = 139264;
constexpr int IL_FMISC = IL_QI + 512;
constexpr int IL_FIQ = IL_FMISC + 128;

__device__ __forceinline__ unsigned score_key(float s) { s += 0.f; const unsigned u = __float_as_uint(s); return (u & 0x80000000u) ? ~u : (u | 0x80000000u); }

template <int PASS, int MODE, bool EDGE>
__device__ __forceinline__ void idx_tile(LAS unsigned char* lds, const bf16x8 b0, const bf16x8 b1, int kt, const bf16x8 (&A)[IDX_G][2], const float (&w)[IDX_G][16], const float (&scq)[IDX_G][2], const float (&thr)[IDX_G][2], const float (&thr1)[IDX_G][2], const f32x16& zero16, int t0, int lane) {
    const int r32 = lane & 31, hi = lane >> 5, key = kt * 32 + r32;
    LAS unsigned* mask = (LAS unsigned*)(lds + IL_MASK); LAS int* qi = (LAS int*)(lds + IL_QI); LAS u32x2* cand = (LAS u32x2*)(lds + IL_HIST);
#pragma unroll
    for (int g = 0; g < IDX_G; ++g) {
        f32x16 acc = __builtin_amdgcn_mfma_f32_32x32x16_bf16(A[g][0], b0, zero16, 0, 0, 0);
        acc = __builtin_amdgcn_mfma_f32_32x32x16_bf16(A[g][1], b1, acc, 0, 0, 0);
#pragma unroll
        for (int j = 0; j < 2; ++j) {
            float sA = 0.f, sB = 0.f;
#pragma unroll
            for (int h = 0; h < 8; h += 2) { const float r0 = __builtin_amdgcn_fmed3f(acc[8 * j + h], 0.f, 3.0e38f), r1 = __builtin_amdgcn_fmed3f(acc[8 * j + h + 1], 0.f, 3.0e38f);
                sA = fmaf(r0, w[g][8 * j + h], sA); sB = fmaf(r1, w[g][8 * j + h + 1], sB); }
            asm volatile("" : "+v"(sA), "+v"(sB));
            const float sc = sA + sB;
            const int ql = 4 * g + 2 * hi + j;
            const bool valid = !EDGE || key <= t0 + ql;
            const float x = __builtin_amdgcn_fmed3f(fmaf(sc, scq[g][j], (float)(IDX_NB / 2)), 0.f, (float)IDX_NB - 0.5f);
            if (PASS == 1) { const unsigned bin = (unsigned)x;
                if (MODE & 4) { asm volatile("" :: "v"(bin), "v"((int)valid)); }
                else { const unsigned addr = ((bin & 0x7feu) << 1) + (unsigned)(IL_HIST + ql * 4096); unsigned val = 1u << ((bin << 4) & 31u); if (EDGE) val = valid ? val : 0u;
                    lds_add((LAS unsigned*)(lds + addr), val); }
            } else {
                const bool ge1 = x >= thr1[g][j], ge0 = x >= thr[g][j];
                const bool above = valid && ge1, cnd = valid && ge0 && !ge1;
                const unsigned long long bal = __ballot(above);
                if (r32 == 0) mask[ql * 256 + kt] = hi ? (unsigned)(bal >> 32) : (unsigned)bal;
                if (cnd) { const int pos = lds_addi(qi + ql * 8 + 3, 1); if (pos < IDX_CAP) cand[ql * 256 + pos] = (u32x2){__float_as_uint(sc + 0.f), (unsigned)key}; }
            }
        }
    }
}
constexpr int IDX_RING = 2;
__device__ __forceinline__ void idx_ring_fill(bf16x8 (&rb)[IDX_RING][2], const bf16_t* IKb, int NT, int wave, int lane) {
    const bf16_t* kp = IKb + (size_t)(lane & 31) * 32 + 8 * (lane >> 5);
#pragma unroll
    for (int d = 0; d < IDX_RING; ++d) { int k2 = wave + 8 * d; k2 = k2 < NT ? k2 : NT - 1; rb[d][0] = *(const bf16x8*)(kp + (size_t)k2 * 1024); rb[d][1] = *(const bf16x8*)(kp + (size_t)k2 * 1024 + 16); }
}
template <int PASS, int MODE>
__device__ __forceinline__ void idx_pass(LAS unsigned char* lds, const bf16_t* IKb, bf16x8 (&rb)[IDX_RING][2], const bf16x8 (&A)[IDX_G][2], const float (&w)[IDX_G][16], const float (&scq)[IDX_G][2], const float (&thr)[IDX_G][2], const float (&thr1)[IDX_G][2], int t0, int NT, int wave, int lane) {
    const int r32 = lane & 31, hi = lane >> 5;
    const bf16_t* kp = IKb + (size_t)r32 * 32 + 8 * hi;
    f32x16 zero16;
#pragma unroll
    for (int i = 0; i < 16; ++i) zero16[i] = 0.f;
    asm volatile("" : "+v"(zero16));
#pragma unroll 1
    for (int kt = wave; kt < NT; kt += IDX_RING * NWAVES) {
#pragma unroll
        for (int d = 0; d < IDX_RING; ++d) { const int ktd = kt + 8 * d;
            const bf16x8 c0 = rb[d][0], c1 = rb[d][1];
            { int k2 = ktd + IDX_RING * NWAVES; if (k2 >= NT) { k2 = wave + 8 * d; k2 = k2 < NT ? k2 : NT - 1; } rb[d][0] = *(const bf16x8*)(kp + (size_t)k2 * 1024); rb[d][1] = *(const bf16x8*)(kp + (size_t)k2 * 1024 + 16); }
            if (ktd < NT) { if (32 * ktd + 31 <= t0) idx_tile<PASS, MODE, false>(lds, c0, c1, ktd, A, w, scq, thr, thr1, zero16, t0, lane); else idx_tile<PASS, MODE, true>(lds, c0, c1, ktd, A, w, scq, thr, thr1, zero16, t0, lane); } }
    }
}

__device__ __forceinline__ void idx_fallback(const Ctx& c, const bf16_t* IQ, const bf16_t* IK, const float* IW, size_t kb, int t, int ql) {
    LAS unsigned* keys = (LAS unsigned*)(c.lds + IL_HIST); LAS unsigned* hist = (LAS unsigned*)(c.lds + IL_FHIST); LAS int* misc = (LAS int*)(c.lds + IL_FMISC);
    LAS float* iqs = (LAS float*)(c.lds + IL_FIQ); LAS float* iws = iqs + 256; LAS unsigned* mask = (LAS unsigned*)(c.lds + IL_MASK);
    const int tid = c.tid, lane = c.lane, wave = c.wave, n = t + 1; const size_t q = kb + t;
    if (tid < 256) iqs[tid] = bf2f(IQ[q * 256 + tid]);
    if (tid < 8) iws[tid] = IW[q * 8 + tid];
    if (tid == 0) { misc[0] = 0; misc[1] = TOPK; }
    __syncthreads();
#pragma unroll 1
    for (int s = tid; s < n; s += NTHREADS) {
        const u32x4* kr = (const u32x4*)(IK + (kb + s) * 32);
        float sc = 0.f;
#pragma unroll 1
        for (int h = 0; h < 8; ++h) { float d = 0.f;
#pragma unroll 1
            for (int i = 0; i < 4; ++i) { asm volatile("" ::: "memory"); const u32x4 w = kr[i]; const f32x4 q0 = *(const LAS f32x4*)(iqs + 32 * h + 8 * i), q1 = *(const LAS f32x4*)(iqs + 32 * h + 8 * i + 4);
                d += q0.x * bflo(w.x) + q0.y * bfhi(w.x) + q0.z * bflo(w.y) + q0.w * bfhi(w.y) + q1.x * bflo(w.z) + q1.y * bfhi(w.z) + q1.z * bflo(w.w) + q1.w * bfhi(w.w); }
            sc = fmaf(fmaxf(d, 0.f), iws[h], sc); }
        keys[s] = score_key(sc);
    }
    for (int rd = 0; rd < 4; ++rd) {
        const int shift = 24 - 8 * rd;
        if (tid < 256) hist[tid] = 0u;
        __syncthreads();
        const unsigned prefix = (unsigned)misc[0];
        for (int s = tid; s < n; s += NTHREADS) { const unsigned k = keys[s]; if (rd == 0 || (k >> (shift + 8)) == prefix) lds_add(&hist[(k >> shift) & 255u], 1u); }
        __syncthreads();
        if (wave == 0) {
            const int need = misc[1];
            unsigned cb[4]; unsigned sl = 0;
#pragma unroll
            for (int j = 0; j < 4; ++j) { cb[j] = hist[4 * lane + j]; sl += cb[j]; }
            const unsigned pre = wave_incl_scan(sl), totw = (unsigned)__builtin_amdgcn_readlane((int)pre, 63);
            const unsigned suf = totw - pre + sl;
            unsigned above = suf - sl;
            if (above < (unsigned)need && (unsigned)need <= suf) {
                bool done = false;
#pragma unroll
                for (int j = 3; j >= 0; --j) { if (!done) { if ((unsigned)need <= above + cb[j]) { misc[0] = (int)((prefix << 8) | (unsigned)(4 * lane + j)); misc[1] = need - (int)above; misc[2] = (int)cb[j]; done = true; } else above += cb[j]; } }
            }
        }
        __syncthreads();
    }
    const unsigned Tk = (unsigned)misc[0]; const int need_eq = misc[1];
    const int seg = (((n + 7) >> 3) + 63) & ~63, s_lo = wave * seg, s_hi = (s_lo + seg < n) ? (s_lo + seg) : n;
    int neq = 0;
    for (int s0 = s_lo; s0 < s_hi; s0 += 64) { const int s = s0 + lane; const bool eq = (s < s_hi) && keys[s] == Tk; neq += __popcll(__ballot(eq)); }
    if (lane == 0) misc[12 + wave] = neq;
    __syncthreads();
    int peq = 0;
    for (int w = 0; w < wave; ++w) peq += misc[12 + w];
    for (int s0 = s_lo; s0 < s_hi; s0 += 64) { const int s = s0 + lane; const unsigned k = (s < s_hi) ? keys[s] : 0u; const bool gt = (s < s_hi) && k > Tk, eq = (s < s_hi) && k == Tk;
        const unsigned long long be_ = __ballot(eq); const int myeq = peq + __popcll(be_ & ((1ull << lane) - 1ull));
        const unsigned long long bs = __ballot(gt || (eq && myeq < need_eq));
        if (lane == 0) { mask[ql * 256 + (s0 >> 5)] = (unsigned)bs; if ((s0 >> 5) + 1 < 256) mask[ql * 256 + (s0 >> 5) + 1] = (unsigned)(bs >> 32); }
        peq += __popcll(be_); }
    __syncthreads();
}

__device__ __forceinline__ void idx_attend(LAS unsigned char* lds, const bf16_t* QN, const bf16_t* KN, const bf16_t* VB, bf16_t* YO, size_t kb, int t, int ql, int NT, int wave, int lane) {
    LAS unsigned* mask = (LAS unsigned*)(lds + IL_MASK) + ql * 256; LAS int* sel = (LAS int*)(lds + IL_SEL) + wave * 256; LAS unsigned char* vs = lds + IL_VS + wave * 10240;
    const size_t tok = kb + t; const int fr = lane & 15, fq = lane >> 4;
    unsigned wd[4]; int cntl = 0;
#pragma unroll
    for (int i = 0; i < 4; ++i) { const int kt = 4 * lane + i; wd[i] = (kt < NT) ? mask[kt] : 0u; cntl += __popc(wd[i]); }
    const int incl = (int)wave_incl_scan((unsigned)cntl);
    const int nsel = __builtin_amdgcn_readlane(incl, 63); int pos = incl - cntl;
#pragma unroll
    for (int i = 0; i < 4; ++i) { unsigned wv = wd[i]; while (wv) { const int bpos = __builtin_ctz(wv); if (pos < 256) sel[pos] = (4 * lane + i) * 32 + bpos; ++pos; wv &= wv - 1u; } }
    for (int p = nsel + lane; p < 256; p += 64) sel[p] = 0;
    asm volatile("s_waitcnt lgkmcnt(0)" ::: "memory");
    const bf16_t* qrow = QN + tok * 512 + (fr & 7) * 64 + 8 * fq; const bf16x8 qb0 = *(const bf16x8*)qrow, qb1 = *(const bf16x8*)(qrow + 32);
    const char* KNb = (const char*)(KN + kb * 64); const char* VBb = (const char*)(VB + kb * 64);
    const unsigned vlo = 16u * (unsigned)(lane & 7), klo = 16u * (unsigned)fq;
    f32x4 sc[16];
    {   bf16x8 kf[16][2];
#pragma unroll
        for (int k8 = 0; k8 < 16; ++k8) { const unsigned key = (unsigned)sel[16 * k8 + fr]; const char* kr = KNb + (key * 128u + klo); kf[k8][0] = *(const bf16x8*)kr; kf[k8][1] = *(const bf16x8*)(kr + 64); }
        __builtin_amdgcn_sched_barrier(0);
#pragma unroll
        for (int k8 = 0; k8 < 16; ++k8) { f32x4 a = {0.f, 0.f, 0.f, 0.f}; a = __builtin_amdgcn_mfma_f32_16x16x32_bf16(kf[k8][0], qb0, a, 0, 0, 0); a = __builtin_amdgcn_mfma_f32_16x16x32_bf16(kf[k8][1], qb1, a, 0, 0, 0); sc[k8] = a; }
        __builtin_amdgcn_sched_barrier(0);
    }
    u32x4 vr[4][8];
#pragma unroll
    for (int c2 = 0; c2 < 3; ++c2)
#pragma unroll
        for (int i = 0; i < 8; ++i) { const unsigned key = (unsigned)sel[64 * c2 + (lane >> 3) + 8 * i]; vr[c2][i] = *(const u32x4*)(VBb + (key * 128u + vlo)); }
    __builtin_amdgcn_sched_barrier(0);
    float mx = -INFINITY;
#pragma unroll
    for (int kt = 0; kt < 16; ++kt)
#pragma unroll
        for (int i = 0; i < 4; ++i) { if (16 * kt + 4 * fq + i >= nsel) sc[kt][i] = -INFINITY; mx = fmaxf(mx, sc[kt][i]); }
    mx = fmaxf(mx, xor16_f(mx)); mx = max_x32(mx);
    float sm = 0.f;
#pragma unroll
    for (int kt = 0; kt < 16; ++kt)
#pragma unroll
        for (int i = 0; i < 4; ++i) { sc[kt][i] = __expf(sc[kt][i] - mx); sm += sc[kt][i]; }
    sm += xor16_f(sm); sm = sum_x32(sm);
    const float inv = __builtin_amdgcn_rcpf(sm);
    bf16x8 pf[8];
#pragma unroll
    for (int s = 0; s < 8; ++s) { const u32x2 lo = pack4(sc[2 * s] * inv), hi2 = pack4(sc[2 * s + 1] * inv); const u32x4 w4 = {lo.x, lo.y, hi2.x, hi2.y}; pf[s] = __builtin_bit_cast(bf16x8, w4); }
    __builtin_amdgcn_sched_barrier(0);
#pragma unroll
    for (int i = 0; i < 8; ++i) { const unsigned key = (unsigned)sel[64 * 3 + (lane >> 3) + 8 * i]; vr[3][i] = *(const u32x4*)(VBb + (key * 128u + vlo)); }
    __builtin_amdgcn_sched_barrier(0);
    f32x4 o[4];
#pragma unroll
    for (int dt = 0; dt < 4; ++dt) o[dt] = (f32x4){0.f, 0.f, 0.f, 0.f};
#pragma unroll
    for (int ch = 0; ch < 4; ++ch) {
#pragma unroll
        for (int i = 0; i < 8; ++i) *(LAS u32x4*)(vs + ((lane >> 3) + 8 * i) * 160 + 16 * (lane & 7)) = vr[ch][i];
        __builtin_amdgcn_sched_barrier(0);
#pragma unroll
        for (int ls = 0; ls < 2; ++ls)
#pragma unroll
            for (int dt = 0; dt < 4; ++dt) {
                LAS unsigned char* ad = vs + (32 * ls + 4 * fq + (fr >> 2)) * 160 + (16 * dt + 4 * (lane & 3)) * 2;
                const s16x4 lo = __builtin_amdgcn_ds_read_tr16_b64_v4i16((LAS s16x4*)ad), hi2 = __builtin_amdgcn_ds_read_tr16_b64_v4i16((LAS s16x4*)(ad + 16 * 160));
                const bf16x8 vf = {lo[0], lo[1], lo[2], lo[3], hi2[0], hi2[1], hi2[2], hi2[3]};
                o[dt] = __builtin_amdgcn_mfma_f32_16x16x32_bf16(vf, pf[2 * ch + ls], o[dt], 0, 0, 0);
            }
        __builtin_amdgcn_sched_barrier(0);
    }
    if (fr < 8) {
#pragma unroll
        for (int dt = 0; dt < 4; ++dt) *(u32x2*)(YO + tok * 1024 + 512 + fr * 64 + 16 * dt + 4 * fq) = pack4(o[dt]);
    }
}

template <int MODE  >
__device__ __forceinline__ void phase_idx_attn(const Ctx& c, int l) {
    const int tid = c.tid, lane = c.lane, wave = c.wave;
    const bf16_t* QN = (const bf16_t*)(c.ws + WS_QN); const bf16_t* KN = (const bf16_t*)(c.ws + WS_KN); const bf16_t* VB = (const bf16_t*)(c.ws + WS_VB);
    const bf16_t* IQ = (const bf16_t*)(c.ws + WS_IQ); const bf16_t* IK = (const bf16_t*)(c.ws + WS_IK); const float* IW = (const float*)(c.ws + WS_IW);
    bf16_t* YO = (bf16_t*)(c.ws + WS_YO);
    LAS int* qi = (LAS int*)(c.lds + IL_QI);
    const unsigned* maxik = (const unsigned*)(c.ws + WS_CTL + CTL_MAXIK) + l * 2; const float* PR = (const float*)(c.ws + WS_PR);
    constexpr int UPB = L / IDX_QB;
    for (int o = c.bid; o < 2 * UPB; o += c.nb) {
        const int b = o / UPB, w_ = o % UPB, ub = (w_ < UPB / 2) ? w_ : (UPB + UPB / 2 - 1 - w_);
        const int t0 = ub * IDX_QB, NT = (t0 + IDX_QB + 31) >> 5; const size_t kb = (size_t)b * L;
        const bool need_select = (t0 + IDX_QB - 1 >= TOPK) && !(MODE & 2);
        __syncthreads();
        { LAS u32x4* h4 = (LAS u32x4*)(c.lds + IL_HIST);
#pragma unroll
            for (int i = 0; i < 8; ++i) h4[tid + NTHREADS * i] = (u32x4){0u, 0u, 0u, 0u}; }
        if (tid < IDX_QB) { qi[tid * 8 + 1] = -1; qi[tid * 8 + 2] = 0; qi[tid * 8 + 3] = 0; qi[tid * 8 + 4] = 0; }
        const int NTP = (MODE & 16) ? 8 : NT;
        if (need_select) {
            int lane1 = lane; asm volatile("" : "+v"(lane1));
            const int r32 = lane1 & 31, hi = lane1 >> 5;
            bf16x8 A[IDX_G][2]; float w[IDX_G][16]; float scq[IDX_G][2]; float thr[IDX_G][2], thr1[IDX_G][2]; bf16x8 rb[IDX_RING][2];
            const int qsel = 2 * ((r32 >> 2) & 1) + ((r32 >> 4) & 1), head = (r32 & 3) + 4 * ((r32 >> 3) & 1);
            const float mk = sqrtf(__uint_as_float(maxik[b])) * 1.001f;
#pragma unroll
            for (int g = 0; g < IDX_G; ++g) { const bf16_t* ar = IQ + (kb + t0 + 4 * g + qsel) * 256 + head * 32 + 8 * hi; A[g][0] = *(const bf16x8*)ar; A[g][1] = *(const bf16x8*)(ar + 16);
#pragma unroll
                for (int j = 0; j < 2; ++j) { const int ql = 4 * g + 2 * hi + j; const f32x4 w0 = *(const f32x4*)(IW + (kb + t0 + ql) * 8), w1 = *(const f32x4*)(IW + (kb + t0 + ql) * 8 + 4);
                    w[g][8 * j + 0] = w0.x; w[g][8 * j + 1] = w0.y; w[g][8 * j + 2] = w0.z; w[g][8 * j + 3] = w0.w; w[g][8 * j + 4] = w1.x; w[g][8 * j + 5] = w1.y; w[g][8 * j + 6] = w1.z; w[g][8 * j + 7] = w1.w;
                    scq[g][j] = (float)(IDX_ZOOM * (IDX_NB / 2)) / (PR[kb + t0 + ql] * mk + 1e-30f); thr[g][j] = -1.f; thr1[g][j] = 0.f; } }
            idx_ring_fill(rb, IK + kb * 32, NTP, wave, lane1);
            __syncthreads();
            idx_pass<1, MODE>(c.lds, IK + kb * 32, rb, A, w, scq, thr, thr1, t0, NTP, wave, lane1);
            __syncthreads();
#pragma unroll 1
            for (int qq = 0; qq < 2; ++qq) { const int ql = 2 * wave + qq;
                if (t0 + ql + 1 > TOPK) {
                    const LAS u32x4* hq = (const LAS u32x4*)(c.lds + IL_HIST + ql * 4096) + 4 * lane; unsigned wv[16]; unsigned tot = 0;
#pragma unroll
                    for (int i = 0; i < 4; ++i) { const u32x4 x = hq[i]; wv[4 * i] = x.x; wv[4 * i + 1] = x.y; wv[4 * i + 2] = x.z; wv[4 * i + 3] = x.w; }
#pragma unroll
                    for (int i = 0; i < 16; ++i) tot += (wv[i] & 0xffffu) + (wv[i] >> 16);
                    const unsigned pre = wave_incl_scan(tot), totw = (unsigned)__builtin_amdgcn_readlane((int)pre, 63);
                    const unsigned suf = totw - pre + tot;
                    unsigned above = suf - tot;
                    if (above < (unsigned)TOPK && (unsigned)TOPK <= suf) { bool done = false;
#pragma unroll
                        for (int i = 15; i >= 0; --i)
#pragma unroll
                            for (int hf = 1; hf >= 0; --hf) { const unsigned cn = hf ? (wv[i] >> 16) : (wv[i] & 0xffffu);
                                if (!done) { if ((unsigned)TOPK <= above + cn) { qi[ql * 8 + 1] = 2 * (16 * lane + i) + hf; qi[ql * 8 + 2] = TOPK - (int)above; done = true; } else above += cn; } } }
                } }
            __syncthreads();
#pragma unroll
            for (int g = 0; g < IDX_G; ++g)
#pragma unroll
                for (int j = 0; j < 2; ++j) { const float tf = (float)qi[(4 * g + 2 * hi + j) * 8 + 1]; thr[g][j] = tf; thr1[g][j] = tf + 1.f; }
            if (!(MODE & 8)) idx_pass<2, MODE>(c.lds, IK + kb * 32, rb, A, w, scq, thr, thr1, t0, NTP, wave, lane1);
            __syncthreads();
#pragma unroll 1
            for (int qq = 0; qq < 2; ++qq) { const int ql = 2 * wave + qq; const int cn = qi[ql * 8 + 3], need = qi[ql * 8 + 2];
                if (cn > IDX_CAP) { if (lane == 0) qi[ql * 8 + 4] = 1; }
                else { const LAS u32x2* cd = (const LAS u32x2*)(c.lds + IL_HIST) + ql * 256; LAS unsigned* mq = (LAS unsigned*)(c.lds + IL_MASK) + ql * 256;
                    for (int i0 = 0; i0 < cn; i0 += 64) { const int i = i0 + lane; const u32x2 me = cd[i < cn ? i : 0]; const float ms = __uint_as_float(me.x); int rank = 0;
                        for (int j = 0; j < cn; ++j) { const u32x2 ot = cd[j]; const float os = __uint_as_float(ot.x); rank += (os > ms || (os == ms && ot.y < me.y)) ? 1 : 0; }
                        if (i < cn && rank < need) __hip_atomic_fetch_or(mq + (me.y >> 5), 1u << (me.y & 31u), __ATOMIC_RELAXED, __HIP_MEMORY_SCOPE_WORKGROUP); } } }
            __syncthreads();
#pragma unroll 1
            for (int ql = 0; ql < IDX_QB; ++ql) if (qi[ql * 8 + 4] != 0) idx_fallback(c, IQ, IK, IW, kb, t0 + ql, ql);
        } else {
            __syncthreads();
            LAS unsigned* mask = (LAS unsigned*)(c.lds + IL_MASK);
            for (int i = tid; i < IDX_QB * NT; i += NTHREADS) { const int ql = i / NT, kt = i % NT; const int hi_key = t0 + ql - 32 * kt;
                mask[ql * 256 + kt] = hi_key < 0 ? 0u : (hi_key >= 31 ? 0xffffffffu : ((2u << hi_key) - 1u)); }
            __syncthreads();
        }
        if (!(MODE & 1)) {
#pragma unroll 1
            for (int qq = 0; qq < 2; ++qq) { int lane2 = lane; asm volatile("" : "+v"(lane2)); idx_attend(c.lds, QN, KN, VB, YO, kb, t0 + 2 * wave + qq, 2 * wave + qq, NT, wave, lane2); } }
    }
}

struct EpiD1 {
    EPI_COMMON_P
    const bf16_t* gates; const float* bc; bf16_t* Mo;
    __device__ __forceinline__ void half(const f32x4 (&acc)[2][4][2], int ai, const GUnit& u, int wr, int wc, int fr, int fq) const {
        const int which = u.aux;
#pragma unroll
        for (int m = 0; m < 4; ++m) { const size_t row = (size_t)u.row0 + 128 * ai + 64 * wr + 16 * m + fr;
#pragma unroll
            for (int bj = 0; bj < 2; ++bj) { const int col = 256 * u.pn + 128 * bj + 32 * wc + 8 * fq;
                const u32x4 gw = *(const u32x4*)(gates + row * 2048 + which * 1024 + col);
                const f32x4 g0 = {bflo(gw.x), bfhi(gw.x), bflo(gw.y), bfhi(gw.y)}, g1 = {bflo(gw.z), bfhi(gw.z), bflo(gw.w), bfhi(gw.w)}; f32x4 o0, o1;
                if (which == 0) { o0 = g0 * (acc[bj][m][0] + *(const f32x4*)(bc + col)); o1 = g1 * (acc[bj][m][1] + *(const f32x4*)(bc + col + 4)); }
                else { const u32x4 pw = *(const u32x4*)(Mo + row * 1024 + col);
                    o0 = (f32x4){bflo(pw.x), bfhi(pw.x), bflo(pw.y), bfhi(pw.y)} + g0 * acc[bj][m][0]; o1 = (f32x4){bflo(pw.z), bfhi(pw.z), bflo(pw.w), bfhi(pw.w)} + g1 * acc[bj][m][1]; }
                *(u32x4*)(Mo + row * 1024 + col) = pack8(o0, o1); } }
    }
};
struct SchedD1 { const char* A; const char* B; int G, c;
    __device__ __forceinline__ bool next(int i, GUnit& u) const { const int Lq = (i >> 1) * G + c, which = i & 1; if (Lq >= 64 * 4) return false; int pm, pn; pg8::tile_order(Lq, 64, 4, pm, pn);
        u.pm = pm; u.pn = pn; u.aux = which; u.row0 = pm * 256; u.rows = nullptr; u.A = A + ((size_t)pm * 256 * 1024 + which * 512) * 2; u.B = B + ((size_t)pn * 256 * 1024 + which * 512) * 2; return true; }
    __device__ __forceinline__ void a_ready(const GUnit&) const {}
    __device__ __forceinline__ void done(const GUnit&) const {}
};
__device__ __forceinline__ void phase_gemm_d1(const Ctx& c, int l) {
    SchedD1 S{(const char*)(c.ws + WS_YO), (const char*)(c.ws + WS_WCA) + (size_t)l * D * D * 2, c.nb, c.bid};
    EpiD1 E{(const bf16_t*)(c.ws + WS_GATES), c.in[13] + l * D, (bf16_t*)(c.ws + WS_H)};
    pg8::gemm_phase<EpiD1, SchedD1, true, true>(c.lds, pg8::Gemm{1024, 1024, opaque_u(512), T}, S, E, c.tid);
}
template <bool XBF>
struct EpiD2 {
    EPI_COMMON_P
    const void* xin; bf16_t* xout; const float* gate;
    __device__ __forceinline__ void half(const f32x4 (&acc)[2][4][2], int ai, const GUnit& u, int wr, int wc, int fr, int fq) const {
        const float* gb = gate + (u.row0 / L) * 6144;
#pragma unroll
        for (int m = 0; m < 4; ++m) { const size_t row = (size_t)u.row0 + 128 * ai + 64 * wr + 16 * m + fr;
#pragma unroll
            for (int bj = 0; bj < 2; ++bj) { const int col = 256 * u.pn + 128 * bj + 32 * wc + 8 * fq; f32x4 x0, x1;
                if (XBF) { const u32x4 xw = *(const u32x4*)((const bf16_t*)xin + row * D + col); x0 = (f32x4){bflo(xw.x), bfhi(xw.x), bflo(xw.y), bfhi(xw.y)}; x1 = (f32x4){bflo(xw.z), bfhi(xw.z), bflo(xw.w), bfhi(xw.w)}; }
                else { x0 = *(const f32x4*)((const float*)xin + row * D + col); x1 = *(const f32x4*)((const float*)xin + row * D + col + 4); }
                const f32x4 g0 = *(const f32x4*)(gb + col), g1 = *(const f32x4*)(gb + col + 4);
                *(u32x4*)(xout + row * D + col) = pack8(x0 + g0 * acc[bj][m][0], x1 + g1 * acc[bj][m][1]); } }
    }
};
struct SchedD2 { const char* A; const char* B; int G, c;
    __device__ __forceinline__ bool next(int i, GUnit& u) const { const int Lq = i * G + c; if (Lq >= 64 * 4) return false; int pm, pn; pg8::tile_order(Lq, 64, 4, pm, pn);
        u.pm = pm; u.pn = pn; u.aux = 0; u.row0 = pm * 256; u.rows = nullptr; u.A = A + (size_t)pm * 256 * D * 2; u.B = B + (size_t)pn * 256 * D * 2; return true; }
    __device__ __forceinline__ void a_ready(const GUnit&) const {}
    __device__ __forceinline__ void done(const GUnit&) const {}
};
__device__ __forceinline__ void phase_gemm_d2(const Ctx& c, int l) {
    SchedD2 S{(const char*)(c.ws + WS_H), (const char*)(c.ws + WS_WO) + (size_t)l * D * D * 2, c.nb, c.bid};
    const float* gate = (const float*)(c.ws + WS_CTL + CTL_MOD) + (l * 2) * 6144 + 2 * D; bf16_t* X1 = (bf16_t*)(c.ws + WS_X1);
    if (l == 0) { EpiD2<false> E{c.in[0], X1, gate}; pg8::gemm_phase<EpiD2<false>, SchedD2, true, true>(c.lds, pg8::Gemm{D, D, opaque_u(D), T}, S, E, c.tid); }
    else { EpiD2<true> E{c.out, X1, gate}; pg8::gemm_phase<EpiD2<true>, SchedD2, true, true>(c.lds, pg8::Gemm{D, D, opaque_u(D), T}, S, E, c.tid); }
}

constexpr int RT_ROWE = 1032, RT_WLO = 36 * RT_ROWE * 2, RT_LG = 2 * RT_WLO;
template <bool DRY>
__device__ __forceinline__ void phase_norm2_route(const Ctx& c, int l) {
    const float* wg = c.in[17] + (size_t)l * D * NG; const float* wrt = c.in[19] + (size_t)l * D * NE;
    LAS bf16_t* Whi = (LAS bf16_t*)c.lds; LAS bf16_t* Wlo = (LAS bf16_t*)(c.lds + RT_WLO);
    for (int i = c.tid; i < D * NG; i += NTHREADS) { const float w = wg[i]; const unsigned h = f2bf(w); Whi[(i % NG) * RT_ROWE + i / NG] = (bf16_t)h; Wlo[(i % NG) * RT_ROWE + i / NG] = (bf16_t)f2bf(w - __uint_as_float(h << 16)); }
    for (int i = c.tid; i < D * NE; i += NTHREADS) { const float w = wrt[i]; const unsigned h = f2bf(w); Whi[(4 + i % NE) * RT_ROWE + i / NE] = (bf16_t)h; Wlo[(4 + i % NE) * RT_ROWE + i / NE] = (bf16_t)f2bf(w - __uint_as_float(h << 16)); }
    LAS int* lcnt = (LAS int*)(c.lds + RT_LG + 12288 + 128); LAS int* gbase = lcnt + 64;
    if (c.tid < NE) lcnt[c.tid] = 0;
    __syncthreads();
    const int lane = c.lane, wave = c.wave, tk = lane & 7, fr = lane & 15, fq = lane >> 4;
    const float* mod = (const float*)(c.ws + WS_CTL + CTL_MOD); const float* g2 = c.in[16] + l * D;
    int* cnt = (int*)(c.ws + WS_CTL + CTL_CNT) + l * NE; bf16_t* H2 = (bf16_t*)(c.ws + WS_H2);
    i32x4* rt = (i32x4*)(c.ws + WS_ROUTE); f32x2* rw = (f32x2*)(c.ws + WS_ROUTE + 512 * 1024); int* inv = (int*)(c.ws + WS_INV);
    const float* bg = c.in[18] + l * NG; const float* br = c.in[20] + l * NE;
    LAS float* LG = (LAS float*)(c.lds + RT_LG) + wave * (8 * 48);
    for (int m0 = c.bid * 64; m0 < T; m0 += c.nb * 64) {
        const int m = m0 + 8 * wave + tk; const float* mb = mod + (l * 2 + m0 / L) * 6144; const bf16_t* xr = (const bf16_t*)(c.ws + WS_X1) + (size_t)m * D + 8 * fq;
        float ssq = 0.f;
#pragma unroll
        for (int ch = 0; ch < 2; ++ch) { u32x4 xw[16];
#pragma unroll
            for (int s8 = 0; s8 < 16; ++s8) xw[s8] = *(const u32x4*)(xr + 32 * (16 * ch + s8));
#pragma unroll
            for (int s8 = 0; s8 < 16; ++s8) { const f32x4 xa = {bflo(xw[s8].x), bfhi(xw[s8].x), bflo(xw[s8].y), bfhi(xw[s8].y)}, xb = {bflo(xw[s8].z), bfhi(xw[s8].z), bflo(xw[s8].w), bfhi(xw[s8].w)};
                ssq += (xa.x * xa.x + xa.y * xa.y) + (xa.z * xa.z + xa.w * xa.w) + (xb.x * xb.x + xb.y * xb.y) + (xb.z * xb.z + xb.w * xb.w); } }
        ssq += xor16_f(ssq); ssq = sum_x32(ssq);
        const float rstd = __builtin_amdgcn_rsqf(ssq * (1.f / D) + EPS);
        f32x4 acc[3];
#pragma unroll
        for (int n = 0; n < 3; ++n) acc[n] = (f32x4){0.f, 0.f, 0.f, 0.f};
        const int wrow[3] = {fr, 16 + fr, (32 + fr) < 36 ? 32 + fr : 35};
#pragma unroll 2
        for (int s = 0; s < 32; ++s) { const int k0 = 32 * s + 8 * fq;
            const u32x4 xw = *(const u32x4*)(xr + 32 * s); const f32x4 x0 = {bflo(xw.x), bfhi(xw.x), bflo(xw.y), bfhi(xw.y)}, x1 = {bflo(xw.z), bfhi(xw.z), bflo(xw.w), bfhi(xw.w)};
            const f32x4 ga = *(const f32x4*)(g2 + k0), gb = *(const f32x4*)(g2 + k0 + 4), sa = *(const f32x4*)(mb + 4 * D + k0), sb = *(const f32x4*)(mb + 4 * D + k0 + 4), ha = *(const f32x4*)(mb + 3 * D + k0), hb = *(const f32x4*)(mb + 3 * D + k0 + 4);
            const f32x4 h0 = x0 * rstd * ga * (sa + 1.f) + ha, h1 = x1 * rstd * gb * (sb + 1.f) + hb;
            const u32x4 hi4 = {pk2(h0.x, h0.y), pk2(h0.z, h0.w), pk2(h1.x, h1.y), pk2(h1.z, h1.w)};
            const f32x4 l0 = h0 - (f32x4){bflo(hi4.x), bfhi(hi4.x), bflo(hi4.y), bfhi(hi4.y)}, l1 = h1 - (f32x4){bflo(hi4.z), bfhi(hi4.z), bflo(hi4.w), bfhi(hi4.w)};
            const u32x4 lo4 = {pk2(l0.x, l0.y), pk2(l0.z, l0.w), pk2(l1.x, l1.y), pk2(l1.z, l1.w)};
            if (!DRY && fr < 8) *(u32x4*)(H2 + (size_t)m * D + k0) = hi4;
            const bf16x8 ahi = __builtin_bit_cast(bf16x8, hi4), alo = __builtin_bit_cast(bf16x8, lo4);
#pragma unroll
            for (int n = 0; n < 3; ++n) { const bf16x8 bhi = *(const LAS bf16x8*)(Whi + wrow[n] * RT_ROWE + k0), blo = *(const LAS bf16x8*)(Wlo + wrow[n] * RT_ROWE + k0);
                acc[n] = __builtin_amdgcn_mfma_f32_16x16x32_bf16(ahi, bhi, acc[n], 0, 0, 0);
                acc[n] = __builtin_amdgcn_mfma_f32_16x16x32_bf16(ahi, blo, acc[n], 0, 0, 0);
                acc[n] = __builtin_amdgcn_mfma_f32_16x16x32_bf16(alo, bhi, acc[n], 0, 0, 0); } }
        if (fq < 2) {
#pragma unroll
            for (int n = 0; n < 3; ++n)
#pragma unroll
                for (int i = 0; i < 4; ++i) LG[(4 * fq + i) * 48 + 16 * n + fr] = acc[n][i]; }
        asm volatile("s_waitcnt lgkmcnt(0)" ::: "memory");
        int ea = 0, eb = 0, la = 0, lb = 0; float wa = 0.f, wb = 0.f;
        if (lane < 8) { const LAS f32x4* lg4 = (const LAS f32x4*)(LG + lane * 48);
            const f32x4 g4 = lg4[0];
            float gl[4] = {g4.x + bg[0], g4.y + bg[1], g4.z + bg[2], g4.w + bg[3]}; int gs = 0; float gm = gl[0];
#pragma unroll
            for (int g = 1; g < 4; ++g) if (gl[g] > gm) { gm = gl[g]; gs = g; }
            float gsum = 0.f;
#pragma unroll
            for (int g = 0; g < 4; ++g) gsum += __expf(gl[g] - gm);
            const float pg = __builtin_amdgcn_rcpf(gsum);
            const f32x4 ea4 = lg4[1 + 2 * gs], eb4 = lg4[2 + 2 * gs]; const f32x4 ba4 = *(const f32x4*)(br + 8 * gs), bb4 = *(const f32x4*)(br + 8 * gs + 4);
            const float ev[8] = {ea4.x + ba4.x, ea4.y + ba4.y, ea4.z + ba4.z, ea4.w + ba4.w, eb4.x + bb4.x, eb4.y + bb4.y, eb4.z + bb4.z, eb4.w + bb4.w};
            int i1 = 0; float v1 = ev[0];
#pragma unroll
            for (int e = 1; e < 8; ++e) if (ev[e] > v1) { v1 = ev[e]; i1 = e; }
            int i2 = -1; float v2 = -INFINITY;
#pragma unroll
            for (int e = 0; e < 8; ++e) { if (e != i1 && (i2 < 0 || ev[e] > v2)) { i2 = e; v2 = ev[e]; } }
            const float e2 = __expf(v2 - v1), p1 = __builtin_amdgcn_rcpf(1.f + e2), p2 = e2 * p1;
            if (DRY) { asm volatile("" :: "v"(pg * p1), "v"(pg * p2), "v"(gs * 8 + i1), "v"(gs * 8 + i2)); }
            else { ea = gs * 8 + i1; eb = gs * 8 + i2; wa = pg * p1; wb = pg * p2; la = lds_addi(lcnt + ea, 1); lb = lds_addi(lcnt + eb, 1); } }
        if (!DRY) {
            __syncthreads();
            if (c.tid < NE) { const int n = lcnt[c.tid]; gbase[c.tid] = n ? atomicAdd(cnt + c.tid, n) : 0; }
            __syncthreads();
            if (lane < 8) { const int mt = m0 + 8 * wave + lane; const int ra = gbase[ea] + la, rb = gbase[eb] + lb;
                rt[mt] = (i32x4){ea, ra, eb, rb}; rw[mt] = (f32x2){wa, wb}; inv[(size_t)ea * T + ra] = mt; inv[(size_t)eb * T + rb] = mt; }
            __syncthreads();
            if (c.tid < NE) lcnt[c.tid] = 0;
            __syncthreads();
        }
    }
}
__device__ __forceinline__ void expert_bases(const int* cnt, LAS int* base  , int tid) {
    if (tid < 64) {
        const int n = (tid < NE) ? cnt[tid] : 0, nt_ = (n + 255) >> 8; const int incl = (int)wave_incl_scan((unsigned)nt_), start = incl - nt_;
        if (tid < NE) { base[tid] = start << 8; for (int i = 0; i < nt_; ++i) base[40 + start + i] = tid; }
        if (tid == NE - 1) base[NE] = incl << 8; }
    __syncthreads();
}
__device__ __forceinline__ void phase_scatter(const Ctx& c, int l) {
    LAS int* base = (LAS int*)(c.lds + 131072); const int* cnt = (const int*)(c.ws + WS_CTL + CTL_CNT) + l * NE;
    expert_bases(cnt, base, c.tid);
    const i32x4* rt = (const i32x4*)(c.ws + WS_ROUTE); int* slots = (int*)(c.ws + WS_ROUTE + 768 * 1024); int* rowl = (int*)(c.ws + WS_ROWL);
    for (int m = c.bid * NTHREADS + c.tid; m < T; m += c.nb * NTHREADS) { const i32x4 r = rt[m]; const int s1 = base[r.x] + r.y, s2 = base[r.z] + r.w;
        slots[2 * m] = s1; slots[2 * m + 1] = s2; rowl[s1] = m; rowl[s2] = m; }
    for (int e = c.bid; e < NE; e += c.nb) for (int sidx = base[e] + cnt[e] + c.tid; sidx < base[e + 1]; sidx += NTHREADS) rowl[sidx] = -1;
}
struct EpiMoe1 {
    EPI_COMMON_P
    bf16_t* hid;
    __device__ __forceinline__ void half(const f32x4 (&acc)[2][4][2], int ai, const GUnit& u, int wr, int wc, int fr, int fq) const {
#pragma unroll
        for (int m = 0; m < 4; ++m) { const size_t row = (size_t)u.row0 + 128 * ai + 64 * wr + 16 * m + fr; f32x4 o[2];
#pragma unroll
            for (int n = 0; n < 2; ++n)
#pragma unroll
                for (int i = 0; i < 4; ++i) o[n][i] = siluf_(acc[0][m][n][i]) * acc[1][m][n][i];
            *(u32x4*)(hid + row * DE + 128 * u.pn + 32 * wc + 8 * fq) = pack8(o[0], o[1]); }
    }
};
struct EpiMoe2 {
    EPI_COMMON_P
    bf16_t* ys;
    __device__ __forceinline__ void half(const f32x4 (&acc)[2][4][2], int ai, const GUnit& u, int wr, int wc, int fr, int fq) const {
#pragma unroll
        for (int m = 0; m < 4; ++m) { const size_t row = (size_t)u.row0 + 128 * ai + 64 * wr + 16 * m + fr;
#pragma unroll
            for (int bj = 0; bj < 2; ++bj) *(u32x4*)(ys + row * D + 256 * u.pn + 128 * bj + 32 * wc + 8 * fq) = pack8(acc[bj][m][0], acc[bj][m][1]); }
    }
};
__device__ __forceinline__ int tile_expert(const LAS int* base, int rt) { return __builtin_amdgcn_readfirstlane(base[40 + rt]); }
struct SchedMoe1 { const char* A; const char* B; const int* rowl; const LAS int* base; int nunit, G, c;
    __device__ __forceinline__ bool next(int i, GUnit& u) const { const int Lq = i * G + c; if (Lq >= nunit) return false; const int rt = Lq >> 1, j = Lq & 1, e = tile_expert(base, rt);
        u.pm = rt; u.pn = j; u.aux = e; u.row0 = rt * 256; u.rows = rowl + (size_t)e * T + (rt * 256 - __builtin_amdgcn_readfirstlane(base[e])); u.A = A; u.B = B + ((size_t)e * 512 + 256 * j) * D * 2; return true; }
    __device__ __forceinline__ void a_ready(const GUnit&) const {}
    __device__ __forceinline__ void done(const GUnit&) const {}
};
struct SchedMoe2 { const char* A; const char* B; const LAS int* base; int nunit, G, c;
    __device__ __forceinline__ bool next(int i, GUnit& u) const { const int Lq = i * G + c; if (Lq >= nunit) return false; const int rt = Lq >> 2, pn = Lq & 3, e = tile_expert(base, rt);
        u.pm = rt; u.pn = pn; u.aux = e; u.row0 = rt * 256; u.rows = nullptr; u.A = A + (size_t)rt * 256 * DE * 2; u.B = B + ((size_t)e * D + 256 * pn) * DE * 2; return true; }
    __device__ __forceinline__ void a_ready(const GUnit&) const {}
    __device__ __forceinline__ void done(const GUnit&) const {}
};
__device__ __forceinline__ void phase_moe1(const Ctx& c, int l) {
    LAS int* base = (LAS int*)(c.lds + 131072); const int* cnt = (const int*)(c.ws + WS_CTL + CTL_CNT) + l * NE;
    expert_bases(cnt, base, c.tid);
    SchedMoe1 S{(const char*)(c.ws + WS_H2), (const char*)(c.ws + WS_WGU), (const int*)(c.ws + WS_INV), base, __builtin_amdgcn_readfirstlane(base[NE] / 256) * 2, c.nb, c.bid};
    EpiMoe1 E{(bf16_t*)(c.ws + WS_HID)};
    pg8::gemm_phase<EpiMoe1, SchedMoe1, true, true, true>(c.lds, pg8::Gemm{D, D, opaque_u(D), T}, S, E, c.tid);
}
__device__ __forceinline__ void phase_moe2(const Ctx& c, int l) {
    LAS int* base = (LAS int*)(c.lds + 131072); const int* cnt = (const int*)(c.ws + WS_CTL + CTL_CNT) + l * NE;
    expert_bases(cnt, base, c.tid);
    SchedMoe2 S{(const char*)(c.ws + WS_HID), (const char*)(c.ws + WS_WD), base, __builtin_amdgcn_readfirstlane(base[NE] / 256) * 4, c.nb, c.bid};
    EpiMoe2 E{(bf16_t*)(c.ws + WS_YS)};
    pg8::gemm_phase<EpiMoe2, SchedMoe2, true, true>(c.lds, pg8::Gemm{DE, DE, opaque_u(DE), MAXSLOT}, S, E, c.tid);
}
template <bool DRY>
__device__ __forceinline__ void phase_combine(const Ctx& c, int l) {
    const int gw = c.bid * NWAVES + c.wave, NGW = c.nb * NWAVES, lane = c.lane;
    const float* mod = (const float*)(c.ws + WS_CTL + CTL_MOD);
    const bf16_t* YS = (const bf16_t*)(c.ws + WS_YS); const i32x4* rt = (const i32x4*)(c.ws + WS_ROUTE); const f32x2* rw = (const f32x2*)(c.ws + WS_ROUTE + 512 * 1024);
    LAS int* base = (LAS int*)(c.lds + 131072); expert_bases((const int*)(c.ws + WS_CTL + CTL_CNT) + l * NE, base, c.tid);
    bf16_t* H = (bf16_t*)(c.ws + WS_H); const bf16_t* X1 = (const bf16_t*)(c.ws + WS_X1);
    for (int m0 = gw; m0 < T; m0 += 4 * NGW) {
        int s1[4], s2[4]; f32x2 w[4]; u32x2 xv[4][4]; u32x2 y1[4][4], y2[4][4];
#pragma unroll
        for (int i = 0; i < 4; ++i) { const int m = (m0 + i * NGW < T) ? m0 + i * NGW : m0; { const i32x4 r = rt[m]; s1[i] = base[r.x] + r.y; s2[i] = base[r.z] + r.w; } w[i] = rw[m];
#pragma unroll
            for (int j = 0; j < 4; ++j) xv[i][j] = *(const u32x2*)(X1 + (size_t)m * D + 4 * lane + 256 * j); }
#pragma unroll
        for (int i = 0; i < 4; ++i)
#pragma unroll
            for (int j = 0; j < 4; ++j) { y1[i][j] = *(const u32x2*)(YS + (size_t)s1[i] * D + 4 * lane + 256 * j); y2[i][j] = *(const u32x2*)(YS + (size_t)s2[i] * D + 4 * lane + 256 * j); }
#pragma unroll
        for (int i = 0; i < 4; ++i) { const int m = m0 + i * NGW; if (m < T) { const int b = m / L; const float* mb = mod + (l * 2 + b) * 6144;
            f32x4 v[4];
#pragma unroll
            for (int j = 0; j < 4; ++j) { const int col = 4 * lane + 256 * j; const f32x4 gv = *(const f32x4*)(mb + 5 * D + col);
                v[j] = unpack4(xv[i][j]) + gv * (unpack4(y1[i][j]) * w[i].x + unpack4(y2[i][j]) * w[i].y);
                if (DRY) { asm volatile("" :: "v"(v[j])); } else if (l == 0) *(u32x2*)((bf16_t*)c.out + (size_t)m * D + col) = pack4(v[j]); else *(f32x4*)(c.out + (size_t)m * D + col) = v[j]; }
            if (l == 0 && !DRY) { const float* m1 = mod + (2 + b) * 6144; norm_row_store(v, c.in[4] + D, m1, m1 + D, H + (size_t)m * D, lane); } } }
    }
    if (l == 0) { LAS float* scr = (LAS float*)(c.lds + c.wave * 8704); convert_items<1>(c, 1, gw, NGW, IT_MOE, scr); }
}

__device__ __forceinline__ void phase_valutest(const Ctx& c) {
    float a[8];
#pragma unroll
    for (int i = 0; i < 8; ++i) a[i] = (float)(c.lane + i);
    const float m = 1.0000001f, b = 1e-9f;
#pragma unroll 1
    for (int it = 0; it < 4096; ++it) {
#pragma unroll
        for (int i = 0; i < 8; ++i) a[i] = fmaf(a[i], m, b);
        asm volatile("" : "+v"(a[0]), "+v"(a[1]), "+v"(a[2]), "+v"(a[3]), "+v"(a[4]), "+v"(a[5]), "+v"(a[6]), "+v"(a[7]));
    }
    float s = 0.f;
#pragma unroll
    for (int i = 0; i < 8; ++i) s += a[i];
    if (s == 12345.678f) ((float*)(c.ws + WS_XS))[c.tid] = s;
}
template <int TB>
__device__ __forceinline__ void phase_memtest(const Ctx& c) {
    const int gw = c.bid * NWAVES + c.wave, NGW = c.nb * NWAVES;
    float* dst = (float*)(c.ws + WS_XS);
    for (int m0 = gw; m0 < T; m0 += TB * NGW) {
        f32x4 v[TB][4];
#pragma unroll
        for (int i = 0; i < TB; ++i) { const int m = (m0 + i * NGW < T) ? m0 + i * NGW : m0;
#pragma unroll
            for (int j = 0; j < 4; ++j) v[i][j] = *(const f32x4*)(c.out + (size_t)m * D + 4 * c.lane + 256 * j); }
#pragma unroll
        for (int i = 0; i < TB; ++i) { const int m = m0 + i * NGW; if (m < T) {
#pragma unroll
            for (int j = 0; j < 4; ++j) *(f32x4*)(dst + (size_t)m * D + 4 * c.lane + 256 * j) = v[i][j]; } }
    }
}

#define XB_TMO      128
#define XB_XCNT(j)  (256  + 64 * (j))
#define XB_XSUB(j)  (1280 + 64 * (j))
#define XB_XGEN(j)  (2304 + 64 * (j))
#define XB_TOP      3328
#define XB_TOPGEN   3392
#define XCD_BAR_WORDS 3456
#define XB_SPIN_CAP (1u << 18)

__device__ __forceinline__ unsigned xb_ld(unsigned* p)              { return __hip_atomic_load(p, __ATOMIC_RELAXED, __HIP_MEMORY_SCOPE_AGENT); }
__device__ __forceinline__ unsigned xb_add(unsigned* p, unsigned v) { return __hip_atomic_fetch_add(p, v, __ATOMIC_RELAXED, __HIP_MEMORY_SCOPE_AGENT); }
__device__ __forceinline__ unsigned xb_xcc_id() { return (unsigned)__builtin_amdgcn_s_getreg((3 << 11) | 20) & 0xFu; }
#define XB_SPIN(cond, bar) do { unsigned _sp = 0; while (cond) { __builtin_amdgcn_s_sleep(1); \
    if ((++_sp & 255u) == 0u) { if (xb_ld(&(bar)[XB_TMO])) break; if (_sp > XB_SPIN_CAP) { atomicAdd(&(bar)[XB_TMO], 1u); break; } } } } while (0)

struct XcdBarrier {
    unsigned* bar; unsigned x;
    volatile LAS unsigned* st;
};

__device__ __forceinline__ XcdBarrier xcd_barrier_post(unsigned* bar, volatile LAS unsigned* st) {
    XcdBarrier b; b.bar = bar; b.x = xb_xcc_id(); b.st = st;
    if (threadIdx.x == 0) (void)xb_add(&bar[XB_XCNT(b.x)], 1u);
    return b;
}
__device__ __forceinline__ void xcd_barrier_complete(unsigned* bar, unsigned x, unsigned& nloc, unsigned& nx) {
    const unsigned G = gridDim.x * gridDim.y * gridDim.z;
    unsigned sum, cnt, mine, sp = 0u;
    for (;;) {
        sum = 0u; cnt = 0u; mine = 0u;
#pragma unroll
        for (unsigned j = 0; j < 16; ++j) { const unsigned c = xb_ld(&bar[XB_XCNT(j)]); sum += c; cnt += (c > 0u) ? 1u : 0u; mine = (j == x) ? c : mine; }
        if (sum == G) break;
        __builtin_amdgcn_s_sleep(1);
        if ((++sp & 255u) == 0u) { if (xb_ld(&bar[XB_TMO])) break; if (sp > XB_SPIN_CAP) { atomicAdd(&bar[XB_TMO], 1u); break; } }
    }
    nloc = mine > 0u ? mine : 1u; nx = cnt > 0u ? cnt : 1u;
}

__device__ __forceinline__ void xcd_barrier(const XcdBarrier& b, bool leader_thread) {
    asm volatile("s_waitcnt vmcnt(0)" ::: "memory");
    __syncthreads();
    if (leader_thread) {
        unsigned* bar = b.bar;
        __builtin_amdgcn_s_waitcnt(0);
        unsigned nloc = b.st[0], nx = b.st[1];
        if (nloc == 0u) { xcd_barrier_complete(bar, b.x, nloc, nx); b.st[0] = nloc; b.st[1] = nx; }
        const unsigned old = xb_add(&bar[XB_XSUB(b.x)], 1u);
        const unsigned gen = old / nloc;
        if (old + 1u == (gen + 1u) * nloc) {
            __builtin_amdgcn_fence(__ATOMIC_RELEASE, "agent");
            asm volatile("s_waitcnt vmcnt(0)" ::: "memory");
            const unsigned og = xb_add(&bar[XB_TOP], 1u);
            const unsigned tg = og / nx;
            if (og + 1u == (tg + 1u) * nx) xb_add(&bar[XB_TOPGEN], 1u);
            else XB_SPIN(xb_ld(&bar[XB_TOPGEN]) == tg, bar);
            __builtin_amdgcn_fence(__ATOMIC_ACQUIRE, "agent");
            xb_add(&bar[XB_XGEN(b.x)], 1u);
            asm volatile("s_waitcnt vmcnt(0)" ::: "memory");
        } else {
            XB_SPIN(xb_ld(&bar[XB_XGEN(b.x)]) == gen, bar);
            __builtin_amdgcn_fence(__ATOMIC_ACQUIRE, "agent");
            asm volatile("s_waitcnt vmcnt(0)" ::: "memory");
        }
    }
    __syncthreads();
}

__global__ void __launch_bounds__(NTHREADS, 2) __attribute__((amdgpu_waves_per_eu(2, 2))) mega(Params p) {
    extern __shared__ __attribute__((aligned(16))) unsigned char lds[];
    Ctx c; c.in = p.in; c.out = p.out; c.ws = p.ws; c.lds = (LAS unsigned char*)lds;
    c.tid = threadIdx.x; c.lane = c.tid & 63; c.wave = __builtin_amdgcn_readfirstlane(c.tid >> 6); c.bid = blockIdx.x; c.nb = gridDim.x;
    const int lo = p.ph_lo, hi = p.ph_hi;
#if ONE_LAUNCH
    volatile LAS unsigned* bmisc = (volatile LAS unsigned*)(c.lds + LDS_BYTES - 64);
    if (c.tid < 16) bmisc[c.tid] = 0u;
    __syncthreads();
    const XcdBarrier bar = xcd_barrier_post((unsigned*)(p.ws + WS_CTL + CTL_BAR), bmisc);
#define SEAM(k) do { if ((k) + 1 < hi) xcd_barrier(bar, cc.tid == 0); } while (0)
#else
#define SEAM(k) do { } while (0)
#endif
#ifdef ONLY_PHASE
#define IN(k) ((k) == ONLY_PHASE)
#else
#define IN(k) (lo <= (k) && (k) < hi)
#endif
#ifndef REP_PH
#define REP_PH -1
#define REP_N 1
#endif
#define PHASE(k, call) do { if (IN(k)) for (int rep_ = 0; rep_ < (((k) == REP_PH) ? REP_N : 1); ++rep_) { Ctx cc = c; cc.ws = opaque_p(cc.ws); cc.out = opaque_p(cc.out); cc.wave = opaque_u(cc.wave); cc.lane = (int)__builtin_amdgcn_mbcnt_hi(~0u, __builtin_amdgcn_mbcnt_lo(~0u, 0u)); cc.tid = cc.wave * 64 + cc.lane; asm volatile("" : "+v"(cc.tid), "+v"(cc.lane)); cc.bid = opaque_u(cc.bid); cc.nb = opaque_u(cc.nb); call; SEAM(k); } } while (0)
    PHASE(0, phase_prep(cc));
    PHASE(1, phase_norm1(cc, 0));
#ifdef DUP_MODE
#define DUPX(k, call) PHASE(k, call)
#else
#define DUPX(k, call)
#endif
#ifndef DUP_PH
#define DUP_PH -1
#endif
#ifndef DUP_PART
#define DUP_PART 3
#endif
#define DUPQ(r, k, call) do { if (DUP_PH == (r)) PHASE(k, call); } while (0)
#define LAYER(l) do { constexpr int p0 = 2 + 10 * (l); \
        DUPQ(0, p0 + 0, phase_gemm_in(cc, l)); \
        PHASE(p0 + 0, phase_gemm_in(cc, l)); \
        DUPQ(1, p0 + 1, phase_post_conv<DUP_PART>(cc, l)); \
        PHASE(p0 + 1, phase_post_conv<3>(cc, l)); \
        DUPX(p0 + 2, phase_idx_attn<DUP_MODE>(cc, l)); \
        PHASE(p0 + 2, phase_idx_attn<0>(cc, l)); \
        DUPQ(3, p0 + 3, phase_gemm_d1(cc, l)); \
        PHASE(p0 + 3, phase_gemm_d1(cc, l)); \
        PHASE(p0 + 4, phase_gemm_d2(cc, l)); \
        DUPQ(53, p0 + 5, (void)0); \
        DUPQ(54, p0 + 5, (void)0); DUPQ(54, p0 + 5, (void)0); DUPQ(54, p0 + 5, (void)0); DUPQ(54, p0 + 5, (void)0); \
        DUPQ(52, p0 + 5, phase_valutest(cc)); \
        DUPQ(50, p0 + 5, phase_memtest<4>(cc)); \
        DUPQ(51, p0 + 5, phase_memtest<8>(cc)); \
        DUPQ(5, p0 + 5, phase_norm2_route<true>(cc, l)); \
        PHASE(p0 + 5, phase_norm2_route<false>(cc, l)); \
        DUPQ(7, p0 + 7, phase_moe1(cc, l)); \
        PHASE(p0 + 7, phase_moe1(cc, l)); \
        DUPQ(8, p0 + 8, phase_moe2(cc, l)); \
        PHASE(p0 + 8, phase_moe2(cc, l)); \
        DUPQ(9, p0 + 9, phase_combine<true>(cc, l)); \
        PHASE(p0 + 9, phase_combine<false>(cc, l)); } while (0)
    LAYER(0);
    LAYER(1);
#undef LAYER
#undef PHASE
#undef IN
#undef SEAM
}

extern "C" void kernel_launch(void* const* d_in, const int* in_sizes, int n_in, void* d_out, int out_size, void* d_ws, size_t ws_size, hipStream_t stream) {
    static int grid = 0;
    if (grid == 0) {
        if (n_in != 24 || out_size != T * D || ws_size < WS_END) { fprintf(stderr, "kernel_launch: unexpected shapes (n_in %d out %d ws %zu)\n", n_in, out_size, ws_size); grid = -1; return; }
        int dev = 0, cus = 0, per_cu = 0;
        hipGetDevice(&dev); hipDeviceGetAttribute(&cus, hipDeviceAttributeMultiprocessorCount, dev);
        if (hipFuncSetAttribute((const void*)mega, hipFuncAttributeMaxDynamicSharedMemorySize, LDS_BYTES) != hipSuccess) { fprintf(stderr, "kernel_launch: hipFuncSetAttribute failed\n"); grid = -1; return; }
        if (hipOccupancyMaxActiveBlocksPerMultiprocessor(&per_cu, (const void*)mega, NTHREADS, LDS_BYTES) != hipSuccess || per_cu < 1) { fprintf(stderr, "kernel_launch: occupancy query says %d\n", per_cu); per_cu = 1; }
        (void)hipGetLastError();
        grid = cus;
    }
    if (grid < 0) return;
    hipMemsetAsync((char*)d_ws + WS_CTL, 0, CTL_ZERO, stream);
    Params p{};
    for (int i = 0; i < 24; ++i) p.in[i] = (const float*)d_in[i];
    p.out = (float*)d_out; p.ws = (unsigned char*)d_ws;
#if ONE_LAUNCH
    p.ph_lo = 0; p.ph_hi = NPH;
    hipLaunchKernelGGL(mega, dim3(grid), dim3(NTHREADS), LDS_BYTES, stream, p);
#else
    for (int ph = 0; ph < NPH; ++ph) { p.ph_lo = ph; p.ph_hi = ph + 1; hipLaunchKernelGGL(mega, dim3(grid), dim3(NTHREADS), LDS_BYTES, stream, p); }
#endif
}
```

```cpp
#include <hip/hip_runtime.h>
#include <cstdio>
#include <cstdint>

#ifndef ONE_LAUNCH
#define ONE_LAUNCH 1
#endif

#define LAS __attribute__((address_space(3)))
typedef unsigned short bf16_t;
typedef short bf16x8 __attribute__((ext_vector_type(8)));
typedef float f32x4 __attribute__((ext_vector_type(4)));
typedef float f32x2 __attribute__((ext_vector_type(2)));
typedef unsigned u32x4 __attribute__((ext_vector_type(4)));
typedef unsigned u32x2 __attribute__((ext_vector_type(2)));
typedef int i32x4 __attribute__((ext_vector_type(4)));

constexpr int NB = 2, L = 8192, T = NB * L, D = 1024;
constexpr int NTHREADS = 512, NWAVES = 8;
constexpr int CONV_CH = 512, CONV_W = 31;
constexpr int NH = 8, HD = 64, AW = 512;
constexpr int IH = 8, IDIM = 32;
constexpr int TOPK = 256;
constexpr int NE = 32, EPG = 8, NG = 4, DE = 256;
constexpr int NIN = 4008, NINP = 4096;
constexpr float EPS = 1e-6f;
constexpr int MAXSLOT = T * 2 + NE * 256;
constexpr int NPH = 22;

constexpr size_t MiB = 1u << 20;
constexpr size_t WS_CTL = 0;
constexpr size_t CTL_ZERO = 256 * 1024;
constexpr size_t CTL_CNT = 4096;
constexpr size_t CTL_MOD = 65536;
constexpr size_t CTL_BAR = 16384;
constexpr size_t CTL_MFLAG = 32768;
constexpr size_t CTL_MAXIK = 8192;
constexpr size_t WS_TAB = 1 * MiB;
constexpr size_t WS_WIN = 4 * MiB;
constexpr size_t WS_WCA = 20 * MiB;
constexpr size_t WS_WO = 24 * MiB;
constexpr size_t WS_WGU = 28 * MiB;
constexpr size_t WS_WD = 60 * MiB;
constexpr size_t WS_H = 76 * MiB;
constexpr size_t WS_UGLU = 108 * MiB;
constexpr size_t WS_RAW = 124 * MiB;
constexpr size_t WS_RAWF = 156 * MiB;
constexpr size_t WS_GATES = 188 * MiB;
constexpr size_t WS_QN = 252 * MiB;
constexpr size_t WS_KN = 268 * MiB;
constexpr size_t WS_VB = 270 * MiB;
constexpr size_t WS_IQ = 272 * MiB;
constexpr size_t WS_IK = 280 * MiB;
constexpr size_t WS_IW = 281 * MiB;
constexpr size_t WS_YO = 282 * MiB;
constexpr size_t WS_PR = 315 * MiB;
constexpr size_t WS_ROUTE = 314 * MiB;
constexpr size_t WS_INV = 316 * MiB;
constexpr size_t WS_END = 318 * MiB;
constexpr size_t WS_XS = 144 * MiB;
constexpr size_t WS_H2 = 108 * MiB;
constexpr size_t WS_ROWL = 315 * MiB + 128 * 1024;
constexpr size_t WS_HID = 76 * MiB;
constexpr size_t WS_X1 = 156 * MiB;
constexpr size_t WS_YS = 188 * MiB;

constexpr int LDS_BYTES = 160 * 1024;

__device__ __forceinline__ unsigned f2bf(float f) { unsigned u = __float_as_uint(f); return (u + 0x7fffu + ((u >> 16) & 1u)) >> 16; }
typedef __bf16 hwbf16x2 __attribute__((ext_vector_type(2)));
__device__ __forceinline__ unsigned pk2(float lo, float hi) { const f32x2 v = {lo, hi}; return __builtin_bit_cast(unsigned, __builtin_convertvector(v, hwbf16x2)); }
__device__ __forceinline__ float bflo(unsigned w) { return __uint_as_float(w << 16); }
__device__ __forceinline__ float bfhi(unsigned w) { return __uint_as_float(w & 0xffff0000u); }
__device__ __forceinline__ float bf2f(bf16_t h) { return __uint_as_float((unsigned)h << 16); }
__device__ __forceinline__ float sigmoidf_(float x) { return __builtin_amdgcn_rcpf(1.f + __expf(-x)); }
__device__ __forceinline__ float siluf_(float x) { return x * __builtin_amdgcn_rcpf(1.f + __expf(-x)); }
__device__ __forceinline__ unsigned lds_add(LAS unsigned* p, unsigned v) { return __hip_atomic_fetch_add(p, v, __ATOMIC_RELAXED, __HIP_MEMORY_SCOPE_WORKGROUP); }
__device__ __forceinline__ int lds_addi(LAS int* p, int v) { return __hip_atomic_fetch_add(p, v, __ATOMIC_RELAXED, __HIP_MEMORY_SCOPE_WORKGROUP); }
template <int CTRL> __device__ __forceinline__ float dpp_f(float v) { return __int_as_float(__builtin_amdgcn_update_dpp(0, __float_as_int(v), CTRL, 0xf, 0xf, true)); }
__device__ __forceinline__ float row16_sum(float v) { v += dpp_f<0xB1>(v); v += dpp_f<0x4E>(v); v += dpp_f<0x141>(v); v += dpp_f<0x140>(v); return v; }
__device__ __forceinline__ float row16_max(float v) { v = fmaxf(v, dpp_f<0xB1>(v)); v = fmaxf(v, dpp_f<0x4E>(v)); v = fmaxf(v, dpp_f<0x141>(v)); v = fmaxf(v, dpp_f<0x140>(v)); return v; }
__device__ __forceinline__ float rl_f(float v, int l) { return __int_as_float(__builtin_amdgcn_readlane(__float_as_int(v), l)); }
__device__ __forceinline__ float wave_sum(float v) { v = row16_sum(v); return (rl_f(v, 0) + rl_f(v, 16)) + (rl_f(v, 32) + rl_f(v, 48)); }
__device__ __forceinline__ float wave_max(float v) { v = row16_max(v); return fmaxf(fmaxf(rl_f(v, 0), rl_f(v, 16)), fmaxf(rl_f(v, 32), rl_f(v, 48))); }
__device__ __forceinline__ unsigned wave_incl_scan(unsigned v) {
    v += (unsigned)__builtin_amdgcn_update_dpp(0, (int)v, 0x111, 0xf, 0xf, true);
    v += (unsigned)__builtin_amdgcn_update_dpp(0, (int)v, 0x112, 0xf, 0xf, true);
    v += (unsigned)__builtin_amdgcn_update_dpp(0, (int)v, 0x114, 0xf, 0xf, true);
    v += (unsigned)__builtin_amdgcn_update_dpp(0, (int)v, 0x118, 0xf, 0xf, true);
    v += (unsigned)__builtin_amdgcn_update_dpp(0, (int)v, 0x142, 0xa, 0xf, false);
    v += (unsigned)__builtin_amdgcn_update_dpp(0, (int)v, 0x143, 0xc, 0xf, false);
    return v;
}
__device__ __forceinline__ float xor16_f(float v) { return __int_as_float(__builtin_amdgcn_ds_swizzle(__float_as_int(v), (16 << 10) | 0x1f)); }
__device__ __forceinline__ float max_x32(float v) { const auto r = __builtin_amdgcn_permlane32_swap(__float_as_uint(v), __float_as_uint(v), false, false); return fmaxf(__uint_as_float(r[0]), __uint_as_float(r[1])); }
__device__ __forceinline__ float sum_x32(float v) { const auto r = __builtin_amdgcn_permlane32_swap(__float_as_uint(v), __float_as_uint(v), false, false); return __uint_as_float(r[0]) + __uint_as_float(r[1]); }
__device__ __forceinline__ float oct_sum(float v) { v += dpp_f<0xB1>(v); v += dpp_f<0x4E>(v); v += dpp_f<0x141>(v); return v; }
__device__ __forceinline__ int opaque_u(int x) { asm volatile("" : "+v"(x)); return __builtin_amdgcn_readfirstlane(x); }
template <class P> __device__ __forceinline__ P* opaque_p(P* p) { const unsigned long long v = (unsigned long long)p; unsigned lo = (unsigned)v, hi = (unsigned)(v >> 32); asm volatile("" : "+v"(lo), "+v"(hi));
    lo = __builtin_amdgcn_readfirstlane(lo); hi = __builtin_amdgcn_readfirstlane(hi);
    return (P*)(__attribute__((address_space(1))) P*)(((unsigned long long)hi << 32) | lo); }
struct Params { const float* in[24]; float* out; unsigned char* ws; int ph_lo, ph_hi; };

struct Ctx {
    const float* const* in; float* out; unsigned char* ws;
    LAS unsigned char* lds;
    int tid, lane, wave, bid, nb;
};

struct TItem { const float* src; bf16_t* dst; int ldw, ldt, ncol; };
__device__ __forceinline__ void titem_load(const TItem& t, float (&v)[32], int lane) {
    const int j = lane & 31, kh = lane >> 5;
#pragma unroll
    for (int i = 0; i < 32; ++i) v[i] = (j < t.ncol) ? t.src[(size_t)(2 * i + kh) * t.ldw + j] : 0.f;
}
__device__ __forceinline__ void titem_store(const TItem& t, const float (&v)[32], LAS float* scr, int lane) {
    const int j = lane & 31, kh = lane >> 5;
#pragma unroll
    for (int i = 0; i < 32; ++i) scr[(2 * i + kh) * 33 + j] = v[i];
    asm volatile("s_waitcnt lgkmcnt(0)" ::: "memory");
    const int c = lane & 7;
#pragma unroll
    for (int jj = 0; jj < 4; ++jj) { const int n = (lane >> 3) + 8 * jj; const LAS float* s = scr + (8 * c) * 33 + n;
        u32x4 o; o.x = pk2(s[0 * 33], s[1 * 33]); o.y = pk2(s[2 * 33], s[3 * 33]); o.z = pk2(s[4 * 33], s[5 * 33]); o.w = pk2(s[6 * 33], s[7 * 33]);
        *(u32x4*)(t.dst + (size_t)n * t.ldt + 8 * c) = o; }
    asm volatile("s_waitcnt lgkmcnt(0)" ::: "memory");
}
__device__ __forceinline__ TItem titem(const float* W, int ldw, int k0, int c0, int ncol, bf16_t* WT, int ldt, int r0, int kdst0) {
    TItem t; t.src = W + (size_t)k0 * ldw + c0; t.dst = WT + (size_t)r0 * ldt + kdst0 + k0; t.ldw = ldw; t.ldt = ldt; t.ncol = ncol; return t; }

__device__ __forceinline__ void win_map(int db, int& c0, int& ncol) {
    ncol = 32;
    if (db < 32) { const int i = db >> 3, w = db & 7; c0 = (w < 4) ? (128 * i + 32 * w) : (512 + 128 * i + 32 * (w - 4)); }
    else if (db < 48) c0 = 1024 + 32 * (db - 32);
    else if (db < 56) { const int q = db - 48; if (q < 2) c0 = 1536 + 32 * q; else if (q < 4) c0 = 1600 + 32 * (q - 2); else if (q == 4) c0 = 1920; else if (q == 5) { c0 = 1952; ncol = 8; } else { c0 = 0; ncol = 0; } }
    else if (db < 64) c0 = 1664 + 32 * (db - 56);
    else c0 = 1960 + 32 * (db - 64);
}
constexpr int IT_WIN = 16 * 128, IT_WC = 8 * 32, IT_WA = 8 * 32, IT_WO = 16 * 32, IT_MIX = IT_WIN + IT_WC + IT_WA + IT_WO;
constexpr int IT_GU = 32 * 16 * 16, IT_DN = 32 * 4 * 32, IT_MOE = IT_GU + IT_DN;
__device__ __forceinline__ TItem mixer_item(const Ctx& c, int l, int it) {
    bf16_t* WinT = (bf16_t*)(c.ws + WS_WIN) + (size_t)l * NINP * D;
    bf16_t* WcaT = (bf16_t*)(c.ws + WS_WCA) + (size_t)l * D * D;
    bf16_t* WoT = (bf16_t*)(c.ws + WS_WO) + (size_t)l * D * D;
    if (it < IT_WIN) { const int kb = it / 128, db = it % 128; int c0, nc; win_map(db, c0, nc); return titem(c.in[5] + (size_t)l * D * NIN, NIN, 64 * kb, c0, nc, WinT, D, 32 * db, 0); }
    it -= IT_WIN;
    if (it < IT_WC) { const int kb = it / 32, db = it % 32; return titem(c.in[12] + (size_t)l * CONV_CH * D, D, 64 * kb, 32 * db, 32, WcaT, D, 32 * db, 0); }
    it -= IT_WC;
    if (it < IT_WA) { const int kb = it / 32, db = it % 32; return titem(c.in[14] + (size_t)l * AW * D, D, 64 * kb, 32 * db, 32, WcaT, D, 32 * db, 512); }
    it -= IT_WA;
    { const int kb = it / 32, db = it % 32; return titem(c.in[15] + (size_t)l * D * D, D, 64 * kb, 32 * db, 32, WoT, D, 32 * db, 0); }
}
__device__ __forceinline__ TItem moe_item(const Ctx& c, int l, int it) {
    bf16_t* WguT = (bf16_t*)(c.ws + WS_WGU);
    bf16_t* WdT = (bf16_t*)(c.ws + WS_WD);
    if (it < IT_GU) { const int e = it / 256, r = it % 256, kb = r / 16, db = r % 16, j = db >> 3, w = db & 7;
        const float* src = (w < 4 ? c.in[21] : c.in[22]) + ((size_t)l * NE + e) * D * DE;
        return titem(src, DE, 64 * kb, 128 * j + 32 * (w & 3), 32, WguT + (size_t)e * 512 * D, D, 32 * db, 0); }
    it -= IT_GU;
    { const int e = it / 128, r = it % 128, kb = r / 32, db = r % 32;
        return titem(c.in[23] + ((size_t)l * NE + e) * DE * D, D, 64 * kb, 32 * db, 32, WdT + (size_t)e * D * DE, DE, 32 * db, 0); }
}
template <int KIND>
__device__ __forceinline__ void convert_items(const Ctx& c, int l, int first, int step, int nitems, LAS float* scr) {
    if (first >= nitems) return;
    auto get = [&](int it) { return KIND == 0 ? mixer_item(c, it / IT_MIX, it % IT_MIX) : moe_item(c, l, it); };
    TItem cur = get(first); float v[32]; titem_load(cur, v, c.lane);
    for (int it = first; it < nitems; it += step) {
        const int nx = it + step; TItem nt = cur; float nv[32];
        if (nx < nitems) { nt = get(nx); titem_load(nt, nv, c.lane); }
        titem_store(cur, v, scr, c.lane);
        if (nx < nitems) { cur = nt;
#pragma unroll
            for (int i = 0; i < 32; ++i) v[i] = nv[i]; }
    }
}

__device__ __forceinline__ void phase_prep(const Ctx& c) {
    LAS float* scr = (LAS float*)(c.lds + c.wave * 8704);
    const int gw = c.bid * NWAVES + c.wave, NGW = c.nb * NWAVES;
    float* cosH = (float*)(c.ws + WS_TAB); float* sinH = cosH + L * 32; float* cosI = sinH + L * 32; float* sinI = cosI + L * 16;
    for (int it = gw; it < (L * 32 + L * 16) / 64; it += NGW) {
        const bool hd = it < (L * 32) / 64; const int e = (hd ? it : it - (L * 32) / 64) * 64 + c.lane;
        const int pos = hd ? (e >> 5) : (e >> 4), i = hd ? (e & 31) : (e & 15);
        const float inv = powf(10000.f, -(float)(2 * i) / (hd ? 64.f : 32.f)); const float ang = (float)pos * inv;
        const float n = rintf(ang * 0.15915494309189535f); float r = fmaf(-n, 6.2831854820251465f, ang); r = fmaf(-n, -1.7484555314695172e-07f, r);
        const float cv_ = cosf(r), sv_ = sinf(r);
        if (hd) { cosH[e] = cv_; sinH[e] = sv_; } else { cosI[e] = cv_; sinI[e] = sv_; }
    }
    float* mod = (float*)(c.ws + WS_CTL + CTL_MOD);
    for (int it = c.bid; it < 2 * 96; it += c.nb) {
        const int l = it / 96, cc = it % 96, cg = c.lane & 15, ks = c.lane >> 4, col = 64 * cc + 4 * cg;
        const float* W = c.in[2] + (size_t)l * D * 6144; const float* cv = c.in[1];
        f32x4 a0 = {0.f, 0.f, 0.f, 0.f}, a1 = a0;
#pragma unroll 8
        for (int kk = 0; kk < 32; ++kk) { const int k = 128 * c.wave + 4 * kk + ks; const f32x4 w = *(const f32x4*)(W + (size_t)k * 6144 + col); const float s0 = siluf_(cv[k]), s1 = siluf_(cv[D + k]); a0 += w * s0; a1 += w * s1; }
#pragma unroll
        for (int i = 0; i < 4; ++i) { a0[i] += xor16_f(a0[i]); a0[i] = sum_x32(a0[i]); a1[i] += xor16_f(a1[i]); a1[i] = sum_x32(a1[i]); }
        LAS f32x4* red = (LAS f32x4*)(c.lds + 8 * 8704);
        __syncthreads();
        if (ks == 0) { red[(c.wave * 2 + 0) * 16 + cg] = a0; red[(c.wave * 2 + 1) * 16 + cg] = a1; }
        __syncthreads();
        if (c.tid < 32) { const int b = c.tid >> 4; f32x4 t = *(const f32x4*)(c.in[3] + l * 6144 + col);
#pragma unroll
            for (int w = 0; w < 8; ++w) t += red[(w * 2 + b) * 16 + cg];
            *(f32x4*)(mod + (l * 2 + b) * 6144 + col) = t; }
    }
    convert_items<0>(c, 0, gw, NGW, 2 * IT_MIX, scr);
    convert_items<1>(c, 0, gw, NGW, IT_MOE, scr);
}

__device__ __forceinline__ void norm_row_store(const f32x4 (&v)[4], const float* g, const float* shift, const float* scale, bf16_t* orow, int lane) {
    float s = 0.f;
#pragma unroll
    for (int j = 0; j < 4; ++j) s += (v[j].x * v[j].x + v[j].y * v[j].y) + (v[j].z * v[j].z + v[j].w * v[j].w);
    const float rstd = __builtin_amdgcn_rsqf(wave_sum(s) * (1.f / D) + EPS);
#pragma unroll
    for (int j = 0; j < 4; ++j) { const int col = 4 * lane + 256 * j; const f32x4 gv = *(const f32x4*)(g + col), sh = *(const f32x4*)(shift + col), sc = *(const f32x4*)(scale + col);
        const f32x4 o = v[j] * rstd * gv * (sc + 1.f) + sh;
        u32x2 w; w.x = pk2(o.x, o.y); w.y = pk2(o.z, o.w); *(u32x2*)(orow + col) = w; }
}
__device__ __forceinline__ void phase_norm1(const Ctx& c, int l) {
    const int gw = c.bid * NWAVES + c.wave, NGW = c.nb * NWAVES;
    const float* xin = (l == 0) ? c.in[0] : c.out; const float* mod = (const float*)(c.ws + WS_CTL + CTL_MOD);
    bf16_t* H = (bf16_t*)(c.ws + WS_H);
    for (int m0 = gw; m0 < T; m0 += 4 * NGW) {
        f32x4 v[4][4];
#pragma unroll
        for (int i = 0; i < 4; ++i) { const int m = (m0 + i * NGW < T) ? m0 + i * NGW : m0;
#pragma unroll
            for (int j = 0; j < 4; ++j) v[i][j] = *(const f32x4*)(xin + (size_t)m * D + 4 * c.lane + 256 * j); }
#pragma unroll
        for (int i = 0; i < 4; ++i) { const int m = m0 + i * NGW; if (m < T) { const float* mb = mod + (l * 2 + m / L) * 6144; norm_row_store(v[i], c.in[4] + l * D, mb, mb + D, H + (size_t)m * D, c.lane); } }
    }
}

namespace pg8 {
#define PG8_LAS __attribute__((address_space(3)))
constexpr int BM = 256, BK = 64, HALF = 128, HTB = HALF * BK * 2  , STAGE_BYTES = 8 * HTB, NXCD = 8, WGM = 8;
__host__ __device__ __forceinline__ int lds_byte(int r, int c) { const int st = (r >> 4) * 2 + (c >> 5), rr = r & 15, cc = c & 31, ob = rr * 64 + cc * 2; return st * 1024 + (ob ^ (((ob >> 9) & 1) << 5)); }
__host__ __device__ __forceinline__ void stage_rc(int b, int& R, int& C) { const int st = b / 1024, sb = b % 1024, swz = sb ^ (((sb >> 9) & 1) << 5); R = (st >> 1) * 16 + swz / 64; C = (st & 1) * 32 + (swz % 64) / 2; }
__host__ __device__ __forceinline__ int perm32(int rho) { const int n = rho >> 4, i = rho & 15; return 8 * (i >> 2) + 4 * n + (i & 3); }
struct GUnit { const char* A; const char* B; const int* rows; int pm, pn, aux, row0; };
struct Gemm { int lda, ldb, K, M; };
__device__ __forceinline__ void tile_order(int L, int nM, int nN, int& pm, int& pn) {
    const int nwg = nM * nN; int wgid = L; { const int q = nwg / NXCD, r = nwg % NXCD, xcd = wgid % NXCD, off = wgid / NXCD; wgid = (xcd < r ? xcd * (q + 1) : r * (q + 1) + (xcd - r) * q) + off; }
    const int nig = WGM * nN, gid = wgid / nig, fm = gid * WGM, gsz = (nM - fm) < WGM ? (nM - fm) : WGM;
    pm = fm + ((wgid % nig) % gsz); pn = (wgid % nig) / gsz;
}
template <class Epi, class Sched, bool ALIGN_EPI = false, bool SP2 = false, bool GATHER = false>
__device__ __forceinline__ void gemm_phase(PG8_LAS unsigned char* lds, const Gemm g, const Sched& S, const Epi& E, const int tid_in) {
    const int tid = tid_in, wid = __builtin_amdgcn_readfirstlane(tid >> 6), lane = tid & 63, wr = wid >> 2, wc = wid & 3, fr = lane & 15, fq = lane >> 4;
    const int K = g.K, nt = K / BK;
    unsigned voffA[2], voffB[2];
#pragma unroll
    for (int i = 0; i < 2; ++i) { int R, C; stage_rc(tid * 16 + i * 8192, R, C); const int Rb = Epi::PERM ? ((R & ~31) + perm32(R & 31)) : R;
        voffA[i] = (unsigned)(R * g.lda + C) * 2u; voffB[i] = (unsigned)(Rb * g.ldb + C) * 2u; }
    const size_t kstep = (size_t)(BK * 2);
    const size_t hstepA = (size_t)HALF * g.lda * 2, hstepB = (size_t)HALF * g.ldb * 2;
    const unsigned ldsw = (unsigned)wid * 1024u;
    const int aoff = lds_byte(wr * 64 + fr, fq * 8), boff = lds_byte(wc * 32 + fr, fq * 8);
#define PG8_SA(b, h) (((b) * 2 + (h)) * HTB)
#define PG8_SB(b, h) ((4 + (b) * 2 + (h)) * HTB)
#define PG8_STAGE(bufoff, gbase, voff) do { _Pragma("unroll") for (int _i = 0; _i < 2; ++_i) \
        __builtin_amdgcn_global_load_lds((const unsigned*)((const char*)(gbase) + (voff)[_i]), (PG8_LAS unsigned*)(lds + (bufoff) + ldsw + _i * 8192), 16, 0, 0); } while (0)
#define PG8_STAGE_A(bufoff, gbase, off2) do { _Pragma("unroll") for (int _i = 0; _i < 2; ++_i) \
        __builtin_amdgcn_global_load_lds((const unsigned*)((const char*)(gbase) + (off2)[_i]), (PG8_LAS unsigned*)(lds + (bufoff) + ldsw + _i * 8192), 16, 0, Sched::A_AUX); } while (0)
#define PG8_LDA(dst, b, h) do { _Pragma("unroll") for (int m = 0; m < 4; ++m) _Pragma("unroll") for (int k = 0; k < 2; ++k) dst[m][k] = *(const PG8_LAS bf16x8*)(lds + PG8_SA(b, h) + aoff + m * 2048 + k * 1024); } while (0)
#define PG8_LDB(dst, b, h) do { _Pragma("unroll") for (int n = 0; n < 2; ++n) _Pragma("unroll") for (int k = 0; k < 2; ++k) dst[n][k] = *(const PG8_LAS bf16x8*)(lds + PG8_SB(b, h) + boff + n * 2048 + k * 1024); } while (0)
#define PG8_MMA(ai, bj, At, Bt) do { __builtin_amdgcn_s_setprio(1); _Pragma("unroll") for (int m = 0; m < 4; ++m) _Pragma("unroll") for (int n = 0; n < 2; ++n) _Pragma("unroll") for (int k = 0; k < 2; ++k) \
        acc[ai][bj][m][n] = __builtin_amdgcn_mfma_f32_16x16x32_bf16(Bt[n][k], At[m][k], acc[ai][bj][m][n], 0, 0, 0); __builtin_amdgcn_s_setprio(0); } while (0)
#define PG8_WAIT_V(n) asm volatile("s_waitcnt vmcnt(" #n ")" ::: "memory")
#define PG8_WAIT_L(n) asm volatile("s_waitcnt lgkmcnt(" #n ")" ::: "memory")
#define PG8_BAR __builtin_amdgcn_s_barrier()
#define PG8_SCHED __builtin_amdgcn_sched_barrier(0)
    GUnit cur, nxt; int ui = 0;
    if (!S.next(0, cur)) return;
    f32x4 acc[2][2][4][2];
#pragma unroll
    for (int a = 0; a < 2; ++a)
#pragma unroll
        for (int b = 0; b < 2; ++b)
#pragma unroll
            for (int m = 0; m < 4; ++m)
#pragma unroll
                for (int n = 0; n < 2; ++n) acc[a][b][m][n] = (f32x4){0.f, 0.f, 0.f, 0.f};
    bf16x8 At[4][2], B0[2][2], B1[2][2];
    const char* cA = cur.A; const char* cB = cur.B;
    int stR[2], stC[2];
#pragma unroll
    for (int i = 0; i < 2; ++i) stage_rc(tid * 16 + i * 8192, stR[i], stC[i]);
    unsigned coff[2][2], noff[2][2];
#pragma unroll
    for (int h = 0; h < 2; ++h)
#pragma unroll
        for (int i = 0; i < 2; ++i) { if (GATHER) { int r = cur.rows[128 * h + stR[i]]; r = (unsigned)r < (unsigned)g.M ? r : 0; coff[h][i] = ((unsigned)r * (unsigned)g.lda + (unsigned)stC[i]) * 2u; } else coff[h][i] = voffA[i] + (unsigned)(h * hstepA); noff[h][i] = coff[h][i]; }
    S.a_ready(cur);
    if constexpr (SP2) {
        PG8_STAGE(PG8_SB(0, 0), cB, voffB); PG8_STAGE(PG8_SB(0, 1), cB + hstepB, voffB); PG8_STAGE_A(PG8_SA(0, 0), cA, coff[0]); PG8_STAGE_A(PG8_SA(0, 1), cA, coff[1]);
        if (wr == 1) PG8_BAR;
        PG8_WAIT_V(2); PG8_BAR;
        PG8_STAGE(PG8_SB(1, 0), cB + kstep, voffB); PG8_STAGE_A(PG8_SA(1, 0), cA + kstep, coff[0]); PG8_STAGE(PG8_SB(1, 1), cB + hstepB + kstep, voffB);
        PG8_WAIT_V(6); PG8_BAR;
    } else {
        PG8_STAGE(PG8_SB(0, 0), cB, voffB); PG8_STAGE_A(PG8_SA(0, 0), cA, coff[0]); PG8_STAGE(PG8_SB(0, 1), cB + hstepB, voffB); PG8_STAGE_A(PG8_SA(0, 1), cA, coff[1]);
        if (wr == 1) PG8_BAR;
        PG8_WAIT_V(4); PG8_BAR;
        PG8_STAGE(PG8_SB(1, 0), cB + kstep, voffB); PG8_STAGE_A(PG8_SA(1, 0), cA + kstep, coff[0]); PG8_STAGE(PG8_SB(1, 1), cB + hstepB + kstep, voffB);
        PG8_WAIT_V(6); PG8_BAR;
    }
    for (;;) {
        const bool has_next = S.next(ui + 1, nxt);
        const char* nA = has_next ? nxt.A : cA; const char* nB = has_next ? nxt.B : cB;
        if (GATHER) {
#pragma unroll
            for (int h = 0; h < 2; ++h)
#pragma unroll
                for (int i = 0; i < 2; ++i) { if (has_next) { int r = nxt.rows[128 * h + stR[i]]; r = (unsigned)r < (unsigned)g.M ? r : 0; noff[h][i] = ((unsigned)r * (unsigned)g.lda + (unsigned)stC[i]) * 2u; } else noff[h][i] = coff[h][i]; } }
        for (int t = 0; t < nt; t += 2) {
            const bool last = (t == nt - 2);
            const char* a1 = cA + (size_t)(t + 1) * kstep;
            const char* a2 = last ? nA : cA + (size_t)(t + 2) * kstep; const char* b2 = last ? nB : cB + (size_t)(t + 2) * kstep;
            const char* a3 = a2 + kstep; const char* b3 = b2 + kstep;
            unsigned xoff[2][2];
#pragma unroll
            for (int h = 0; h < 2; ++h)
#pragma unroll
                for (int i = 0; i < 2; ++i) xoff[h][i] = (GATHER && last) ? noff[h][i] : coff[h][i];
            if (last && has_next) S.a_ready(nxt);
            if constexpr (SP2) {
            PG8_LDB(B0, 0, 0); PG8_LDB(B1, 0, 1); PG8_SCHED; PG8_LDA(At, 0, 0); PG8_STAGE_A(PG8_SA(1, 1), a1, coff[1]);
            PG8_WAIT_V(8); PG8_WAIT_L(0); PG8_BAR; PG8_MMA(0, 0, At, B0); PG8_MMA(0, 1, At, B1); PG8_BAR; PG8_SCHED;
            PG8_LDA(At, 0, 1); PG8_STAGE(PG8_SB(0, 0), b2, voffB); PG8_STAGE(PG8_SB(0, 1), b2 + hstepB, voffB); PG8_STAGE_A(PG8_SA(0, 0), a2, xoff[0]);
            PG8_WAIT_V(8); PG8_WAIT_L(0); PG8_BAR; PG8_MMA(1, 0, At, B0); PG8_MMA(1, 1, At, B1); PG8_BAR; PG8_SCHED;
            PG8_LDB(B0, 1, 0); PG8_LDB(B1, 1, 1); PG8_SCHED; PG8_LDA(At, 1, 0); PG8_STAGE_A(PG8_SA(0, 1), a2, xoff[1]);
            PG8_WAIT_V(8); PG8_WAIT_L(0); PG8_BAR; PG8_MMA(0, 0, At, B0); PG8_MMA(0, 1, At, B1); PG8_BAR; PG8_SCHED;
            PG8_LDA(At, 1, 1); PG8_STAGE(PG8_SB(1, 0), b3, voffB); PG8_STAGE(PG8_SB(1, 1), b3 + hstepB, voffB); PG8_STAGE_A(PG8_SA(1, 0), a3, xoff[0]);
            PG8_WAIT_V(8); PG8_WAIT_L(0); PG8_BAR; PG8_MMA(1, 0, At, B0); PG8_MMA(1, 1, At, B1); PG8_BAR; PG8_SCHED;
            } else {
            PG8_LDB(B0, 0, 0); PG8_SCHED; PG8_LDA(At, 0, 0); PG8_STAGE_A(PG8_SA(1, 1), a1, coff[1]);
            PG8_WAIT_L(8); PG8_BAR; PG8_WAIT_L(0); PG8_MMA(0, 0, At, B0); PG8_BAR; PG8_SCHED;
            PG8_LDB(B1, 0, 1); PG8_STAGE(PG8_SB(0, 0), b2, voffB);
            PG8_BAR; PG8_WAIT_L(0); PG8_MMA(0, 1, At, B1); PG8_BAR;
            PG8_LDA(At, 0, 1); PG8_STAGE_A(PG8_SA(0, 0), a2, xoff[0]);
            PG8_BAR; PG8_WAIT_L(0); PG8_MMA(1, 0, At, B0); PG8_BAR; PG8_SCHED;
            PG8_STAGE(PG8_SB(0, 1), b2 + hstepB, voffB);
            PG8_WAIT_V(6); PG8_BAR; PG8_MMA(1, 1, At, B1); PG8_BAR;
            PG8_LDB(B0, 1, 0); PG8_SCHED; PG8_LDA(At, 1, 0); PG8_STAGE_A(PG8_SA(0, 1), a2, xoff[1]);
            PG8_WAIT_L(8); PG8_BAR; PG8_WAIT_L(0); PG8_MMA(0, 0, At, B0); PG8_BAR; PG8_SCHED;
            PG8_LDB(B1, 1, 1); PG8_STAGE(PG8_SB(1, 0), b3, voffB);
            PG8_BAR; PG8_WAIT_L(0); PG8_MMA(0, 1, At, B1); PG8_BAR;
            PG8_LDA(At, 1, 1); PG8_STAGE_A(PG8_SA(1, 0), a3, xoff[0]);
            PG8_BAR; PG8_WAIT_L(0); PG8_MMA(1, 0, At, B0); PG8_BAR; PG8_SCHED;
            PG8_STAGE(PG8_SB(1, 1), b3 + hstepB, voffB);
            PG8_WAIT_V(6); PG8_BAR; PG8_MMA(1, 1, At, B1); PG8_BAR;
            }
        }
        if constexpr (ALIGN_EPI) { if (wr == 0) PG8_BAR; }
        if constexpr (!Epi::AFTER_DRAIN) { E(acc, cur, wr, wc, fr, fq); S.done(cur); }
        if (!has_next) break;
#pragma unroll
        for (int a = 0; a < 2; ++a)
#pragma unroll
            for (int b = 0; b < 2; ++b)
#pragma unroll
                for (int m = 0; m < 4; ++m)
#pragma unroll
                    for (int n = 0; n < 2; ++n) acc[a][b][m][n] = (f32x4){0.f, 0.f, 0.f, 0.f};
        cur = nxt; cA = nA; cB = nB; ++ui;
        if (GATHER) {
#pragma unroll
            for (int h = 0; h < 2; ++h)
#pragma unroll
                for (int i = 0; i < 2; ++i) coff[h][i] = noff[h][i]; }
        if constexpr (ALIGN_EPI) { if (wr == 1) PG8_BAR; }
    }
    PG8_WAIT_V(0);
    if constexpr (!ALIGN_EPI) { if (wr == 0) PG8_BAR; }
    PG8_BAR;
    if constexpr (Epi::AFTER_DRAIN) { E.fused(acc, cur, wr, wc, fr, fq, lds, wid, lane); S.done(cur); }
#undef PG8_SA
#undef PG8_SB
#undef PG8_STAGE
#undef PG8_STAGE_A
#undef PG8_LDA
#undef PG8_LDB
#undef PG8_MMA
#undef PG8_WAIT_V
#undef PG8_WAIT_L
#undef PG8_BAR
#undef PG8_SCHED
}
}
using pg8::GUnit;
#define EPI_COMMON_P static constexpr bool PERM = true, AFTER_DRAIN = false; \
    __device__ __forceinline__ void operator()(const f32x4 (&acc)[2][2][4][2], const GUnit& u, int wr, int wc, int fr, int fq) const { half(acc[0], 0, u, wr, wc, fr, fq); half(acc[1], 1, u, wr, wc, fr, fq); }
#define EPI_COMMON static constexpr bool PERM = false, AFTER_DRAIN = false; \
    __device__ __forceinline__ void operator()(const f32x4 (&acc)[2][2][4][2], const GUnit& u, int wr, int wc, int fr, int fq) const { half(acc[0], 0, u, wr, wc, fr, fq); half(acc[1], 1, u, wr, wc, fr, fq); }

__device__ __forceinline__ u32x2 pack4(const f32x4 v) { u32x2 w; w.x = pk2(v.x, v.y); w.y = pk2(v.z, v.w); return w; }
__device__ __forceinline__ u32x4 pack8(const f32x4 a, const f32x4 b) { return (u32x4){pk2(a.x, a.y), pk2(a.z, a.w), pk2(b.x, b.y), pk2(b.z, b.w)}; }
typedef unsigned v4u_ __attribute__((vector_size(16)));
__device__ __forceinline__ void st16_wt(const void* base, unsigned off, const u32x4 v) {
    __builtin_amdgcn_raw_buffer_store_b128(__builtin_bit_cast(v4u_, v), __builtin_amdgcn_make_buffer_rsrc(const_cast<void*>(base), 0, 0x7FFFFFFF, 0x00020000), (int)off, 0, 16);
}
__device__ __forceinline__ f32x4 unpack4(const u32x2 w) { return (f32x4){bflo(w.x), bfhi(w.x), bflo(w.y), bfhi(w.y)}; }

struct EpiIn {
    EPI_COMMON_P
    bf16_t* uglu; bf16_t* rawb; float* rawf; bf16_t* gates;
    __device__ __forceinline__ void half(const f32x4 (&acc)[2][4][2], int ai, const GUnit& u, int wr, int wc, int fr, int fq) const {
        const int pn = u.pn, c8 = 32 * wc + 8 * fq;
#pragma unroll
        for (int m = 0; m < 4; ++m) { const size_t row = (size_t)u.row0 + 128 * ai + 64 * wr + 16 * m + fr;
            if (pn < 4) { f32x4 o[2];
#pragma unroll
                for (int n = 0; n < 2; ++n)
#pragma unroll
                    for (int i = 0; i < 4; ++i) o[n][i] = acc[0][m][n][i] * sigmoidf_(acc[1][m][n][i]);
                *(u32x4*)(uglu + row * 512 + 128 * pn + c8) = pack8(o[0], o[1]);
            } else if (pn == 6) {
#pragma unroll
                for (int bj = 0; bj < 2; ++bj)
#pragma unroll
                    for (int n = 0; n < 2; ++n) *(f32x4*)(rawf + row * 256 + 128 * bj + c8 + 4 * n) = acc[bj][m][n];
            } else if (pn < 8) { const int cb0 = (pn == 7) ? 512 : 256 * (pn - 4);
#pragma unroll
                for (int bj = 0; bj < 2; ++bj) *(u32x4*)(rawb + row * 768 + cb0 + 128 * bj + c8) = pack8(acc[bj][m][0], acc[bj][m][1]);
            } else {
#pragma unroll
                for (int bj = 0; bj < 2; ++bj) { f32x4 o[2];
#pragma unroll
                    for (int n = 0; n < 2; ++n)
#pragma unroll
                        for (int i = 0; i < 4; ++i) o[n][i] = sigmoidf_(acc[bj][m][n][i]);
                    *(u32x4*)(gates + row * 2048 + 256 * (pn - 8) + 128 * bj + c8) = pack8(o[0], o[1]); }
            } }
    }
};
struct SchedIn { static constexpr int A_AUX = 0; const char* A; const char* B; int G, c;
    __device__ __forceinline__ bool next(int i, GUnit& u) const { const int Lq = i * G + c; if (Lq >= 64 * 16) return false; int pm, pn; pg8::tile_order(Lq, 64, 16, pm, pn);
        u.pm = pm; u.pn = pn; u.aux = 0; u.row0 = pm * 256; u.rows = nullptr; u.A = A + (size_t)pm * 256 * D * 2; u.B = B + (size_t)pn * 256 * D * 2; return true; }
    __device__ __forceinline__ void a_ready(const GUnit&) const {}
    __device__ __forceinline__ void done(const GUnit&) const {}
};
__device__ __forceinline__ void phase_gemm_in(const Ctx& c, int l) {
    SchedIn S{(const char*)(c.ws + WS_H), (const char*)(c.ws + WS_WIN) + (size_t)l * NINP * D * 2, c.nb, c.bid};
    EpiIn E{(bf16_t*)(c.ws + WS_UGLU), (bf16_t*)(c.ws + WS_RAW), (float*)(c.ws + WS_RAWF), (bf16_t*)(c.ws + WS_GATES)};
    pg8::gemm_phase<EpiIn, SchedIn, true, true>(c.lds, pg8::Gemm{D, D, opaque_u(D), T}, S, E, c.tid);
}

template <int PART>
__device__ __forceinline__ void phase_post_conv(const Ctx& c, int l) {
    const int gw = c.bid * NWAVES + c.wave, NGW = c.nb * NWAVES, lane = c.lane;
    const bf16_t* RAWB = (const bf16_t*)(c.ws + WS_RAW); const float* RAWF = (const float*)(c.ws + WS_RAWF);
    const float* cosH = (const float*)(c.ws + WS_TAB); const float* sinH = cosH + L * 32; const float* cosI = sinH + L * 32; const float* sinI = cosI + L * 16;
    bf16_t* QN = (bf16_t*)(c.ws + WS_QN); bf16_t* KN = (bf16_t*)(c.ws + WS_KN); bf16_t* VB = (bf16_t*)(c.ws + WS_VB);
    bf16_t* IQ = (bf16_t*)(c.ws + WS_IQ); bf16_t* IK = (bf16_t*)(c.ws + WS_IK); float* IW = (float*)(c.ws + WS_IW);
    const float* qg = c.in[6] + l * HD; const float* kg = c.in[7] + l * HD; float* PRo = (float*)(c.ws + WS_PR);
    float mxk0 = 0.f, mxk1 = 0.f;
    struct PostIn { f32x4 q0, q1, kv0, kv1, iq, ik, ch0, ch1, sh0, sh1, ci, si; float iw; };
    const int cc = lane & 7, c4 = cc & 3; const bool hi = cc >= 4;
    auto load_in = [&](int m) { PostIn p; const int t = m % L; const bf16_t* rb_ = RAWB + (size_t)m * 768; const float* r = RAWF + (size_t)m * 256;
        { const u32x4 wq = *(const u32x4*)(rb_ + 8 * lane); p.q0 = (f32x4){bflo(wq.x), bfhi(wq.x), bflo(wq.y), bfhi(wq.y)}; p.q1 = (f32x4){bflo(wq.z), bfhi(wq.z), bflo(wq.w), bfhi(wq.w)}; }
        const int off = (lane < 8) ? (8 * lane) : (64 + 8 * (lane & 7)); p.kv0 = *(const f32x4*)(r + off); p.kv1 = *(const f32x4*)(r + off + 4);
        { const u32x2 wi = *(const u32x2*)(rb_ + 512 + 4 * lane); p.iq = (f32x4){bflo(wi.x), bfhi(wi.x), bflo(wi.y), bfhi(wi.y)}; }
        p.ik = *(const f32x4*)(r + 128 + 4 * (lane & 7)); p.iw = r[160 + (lane & 7)];
        p.ch0 = *(const f32x4*)(cosH + t * 32 + 8 * c4); p.ch1 = *(const f32x4*)(cosH + t * 32 + 8 * c4 + 4); p.sh0 = *(const f32x4*)(sinH + t * 32 + 8 * c4); p.sh1 = *(const f32x4*)(sinH + t * 32 + 8 * c4 + 4);
        p.ci = *(const f32x4*)(cosI + t * 16 + 4 * c4); p.si = *(const f32x4*)(sinI + t * 16 + 4 * c4); return p; };
    float qgr[8], kgr[8];
    { const f32x4 a = *(const f32x4*)(qg + 8 * cc), b = *(const f32x4*)(qg + 8 * cc + 4), d = *(const f32x4*)(kg + 8 * cc), e = *(const f32x4*)(kg + 8 * cc + 4);
        qgr[0] = a.x; qgr[1] = a.y; qgr[2] = a.z; qgr[3] = a.w; qgr[4] = b.x; qgr[5] = b.y; qgr[6] = b.z; qgr[7] = b.w;
        kgr[0] = d.x; kgr[1] = d.y; kgr[2] = d.z; kgr[3] = d.w; kgr[4] = e.x; kgr[5] = e.y; kgr[6] = e.z; kgr[7] = e.w; }
    LAS unsigned* mxl = (LAS unsigned*)(c.lds + 64512);
    if (c.tid < 2) mxl[c.tid] = 0u;
    __syncthreads();
    PostIn nx = load_in(gw < T ? gw : 0);
    for (int m = gw; m < ((PART & 1) ? T : 0); m += NGW) {
        const PostIn p = nx; { const int mn = m + NGW; nx = load_in(mn < T ? mn : m); }
        const float csq[8] = {p.ch0.x, p.ch0.y, p.ch0.z, p.ch0.w, p.ch1.x, p.ch1.y, p.ch1.z, p.ch1.w}, snq[8] = {p.sh0.x, p.sh0.y, p.sh0.z, p.sh0.w, p.sh1.x, p.sh1.y, p.sh1.z, p.sh1.w};
        {
            float x[8] = {p.q0.x, p.q0.y, p.q0.z, p.q0.w, p.q1.x, p.q1.y, p.q1.z, p.q1.w}; float s = 0.f;
#pragma unroll
            for (int i = 0; i < 8; ++i) s += x[i] * x[i];
            s = oct_sum(s);
            const float rstd = __builtin_amdgcn_rsqf(s * (1.f / 64.f) + EPS); float o[8];
#pragma unroll
            for (int i = 0; i < 8; ++i) x[i] = x[i] * rstd * qgr[i];
#pragma unroll
            for (int i = 0; i < 8; ++i) { const float other = __shfl_xor(x[i], 4); o[i] = (hi ? (x[i] * csq[i] + other * snq[i]) : (x[i] * csq[i] - other * snq[i])) * 0.125f; }
            u32x4 w; w.x = pk2(o[0], o[1]); w.y = pk2(o[2], o[3]); w.z = pk2(o[4], o[5]); w.w = pk2(o[6], o[7]);
            *(u32x4*)(QN + (size_t)m * 512 + 8 * lane) = w;
        }
        {
            float x[8] = {p.kv0.x, p.kv0.y, p.kv0.z, p.kv0.w, p.kv1.x, p.kv1.y, p.kv1.z, p.kv1.w}; float s = 0.f;
#pragma unroll
            for (int i = 0; i < 8; ++i) s += x[i] * x[i];
            s = oct_sum(s);
            const float rstd = __builtin_amdgcn_rsqf(s * (1.f / 64.f) + EPS); float xn[8], o[8];
#pragma unroll
            for (int i = 0; i < 8; ++i) xn[i] = x[i] * rstd * kgr[i];
#pragma unroll
            for (int i = 0; i < 8; ++i) { const float other = __shfl_xor(xn[i], 4); o[i] = hi ? (xn[i] * csq[i] + other * snq[i]) : (xn[i] * csq[i] - other * snq[i]); }
            if (lane < 8) { u32x4 w; w.x = pk2(o[0], o[1]); w.y = pk2(o[2], o[3]); w.z = pk2(o[4], o[5]); w.w = pk2(o[6], o[7]); *(u32x4*)(KN + (size_t)m * 64 + 8 * lane) = w; }
            else if (lane < 16) { u32x4 w; w.x = pk2(x[0], x[1]); w.y = pk2(x[2], x[3]); w.z = pk2(x[4], x[5]); w.w = pk2(x[6], x[7]); *(u32x4*)(VB + (size_t)m * 64 + 8 * (lane & 7)) = w; }
        }
        const float csi[4] = {p.ci.x, p.ci.y, p.ci.z, p.ci.w}, sni[4] = {p.si.x, p.si.y, p.si.z, p.si.w};
        {
            const f32x4 a = p.iq; float o[4];
#pragma unroll
            for (int i = 0; i < 4; ++i) { const float other = __shfl_xor(a[i], 4); o[i] = hi ? (a[i] * csi[i] + other * sni[i]) : (a[i] * csi[i] - other * sni[i]); }
            u32x2 w; w.x = pk2(o[0], o[1]); w.y = pk2(o[2], o[3]); *(u32x2*)(IQ + (size_t)m * 256 + 4 * lane) = w;
            float n2 = bflo(w.x) * bflo(w.x) + bfhi(w.x) * bfhi(w.x) + bflo(w.y) * bflo(w.y) + bfhi(w.y) * bfhi(w.y);
            n2 = oct_sum(n2);
            const float wh = __shfl(p.iw, lane >> 3);
            const float prs = wave_sum((lane & 7) == 0 ? fabsf(wh) * sqrtf(n2) : 0.f);
            if (lane == 0) PRo[m] = prs;
        }
        {
            const f32x4 a = p.ik; float o[4];
#pragma unroll
            for (int i = 0; i < 4; ++i) { const float other = __shfl_xor(a[i], 4); o[i] = hi ? (a[i] * csi[i] + other * sni[i]) : (a[i] * csi[i] - other * sni[i]); }
            u32x2 w; w.x = pk2(o[0], o[1]); w.y = pk2(o[2], o[3]);
            if (lane < 8) *(u32x2*)(IK + (size_t)m * 32 + 4 * lane) = w;
            else if (lane < 16) IW[(size_t)m * 8 + (lane & 7)] = p.iw;
            float n2 = bflo(w.x) * bflo(w.x) + bfhi(w.x) * bfhi(w.x) + bflo(w.y) * bflo(w.y) + bfhi(w.y) * bfhi(w.y);
            n2 = oct_sum(n2);
            if (m < L) mxk0 = fmaxf(mxk0, n2); else mxk1 = fmaxf(mxk1, n2);
        }
    }
    if (lane == 0) { __hip_atomic_fetch_max(mxl, __float_as_uint(mxk0), __ATOMIC_RELAXED, __HIP_MEMORY_SCOPE_WORKGROUP); __hip_atomic_fetch_max(mxl + 1, __float_as_uint(mxk1), __ATOMIC_RELAXED, __HIP_MEMORY_SCOPE_WORKGROUP); }
    const bf16_t* UG = (const bf16_t*)(c.ws + WS_UGLU); bf16_t* YO = (bf16_t*)(c.ws + WS_YO);
    const float* cw = c.in[8] + (size_t)l * CONV_W * CONV_CH; const float* cb = c.in[9] + l * CONV_CH; const float* lg = c.in[10] + l * CONV_CH; const float* lb = c.in[11] + l * CONV_CH;
    LAS unsigned char* ut = c.lds; LAS float* st = (LAS float*)(c.lds + 63488); LAS f32x2* ys = (LAS f32x2*)(c.lds + 65536) + c.wave * 1024;
    const int half = c.wave >> 2, wq = c.wave & 3, ch = 128 * wq + 2 * lane;
    f32x2 w2[CONV_W];
#pragma unroll
    for (int j = 0; j < CONV_W; ++j) w2[j] = *(const f32x2*)(cw + j * CONV_CH + ch);
    const f32x2 bv = *(const f32x2*)(cb + ch), gv = *(const f32x2*)(lg + ch), lv = *(const f32x2*)(lb + ch);
    for (int tile = c.bid; tile < ((PART & 2) ? T / 32 : 0); tile += c.nb) {
        const int m0 = tile * 32, tl0 = m0 % L;
        __syncthreads();
        { u32x4 sv[8];
#pragma unroll
            for (int k = 0; k < 8; ++k) { const int i = c.tid + NTHREADS * k, row = i >> 6, pc = i & 63; sv[k] = (u32x4){0u, 0u, 0u, 0u};
                if (row < 62 && tl0 - 30 + row >= 0) sv[k] = *(const u32x4*)(UG + (size_t)(m0 - 30 + row) * 512 + 8 * pc); }
#pragma unroll
            for (int k = 0; k < 8; ++k) { const int i = c.tid + NTHREADS * k, row = i >> 6, pc = i & 63; if (row < 62) *(LAS u32x4*)(ut + row * 1024 + 16 * pc) = sv[k]; } }
        __syncthreads();
        {
            f32x2 y16[16];
#pragma unroll
            for (int tk = 0; tk < 16; ++tk) y16[tk] = bv;
            const LAS unsigned char* ub = ut + (16 * half) * 1024 + ch * 2;
#pragma unroll
            for (int i = 0; i < 46; ++i) { const unsigned uu = *(const LAS unsigned*)(ub + i * 1024); const f32x2 u2 = {bflo(uu), bfhi(uu)};
#pragma unroll
                for (int tk = 0; tk < 16; ++tk) if (i - tk >= 0 && i - tk < CONV_W) y16[tk] = __builtin_elementwise_fma(u2, w2[i - tk], y16[tk]); }
#pragma unroll
            for (int tk = 0; tk < 16; ++tk) { const int tr = 16 * half + tk; const f32x2 y2 = y16[tk];
                ys[tk * 64 + lane] = y2;
                const float s1 = wave_sum(y2.x + y2.y), s2 = wave_sum(y2.x * y2.x + y2.y * y2.y);
                if (lane == 0) { st[(tr * 4 + wq) * 2] = s1; st[(tr * 4 + wq) * 2 + 1] = s2; } } }
        __syncthreads();
#pragma unroll 1
        for (int tk = 0; tk < 16; ++tk) { const int tr = 16 * half + tk; const f32x2 y2 = ys[tk * 64 + lane];
            const f32x4 sa = *(const LAS f32x4*)(st + tr * 8), sb = *(const LAS f32x4*)(st + tr * 8 + 4);
            const float mu = ((sa.x + sa.z) + (sb.x + sb.z)) * (1.f / CONV_CH), ex2 = ((sa.y + sa.w) + (sb.y + sb.w)) * (1.f / CONV_CH);
            const float rstd = __builtin_amdgcn_rsqf(fmaxf(ex2 - mu * mu, 0.f) + EPS);
            const float o0 = siluf_((y2.x - mu) * rstd * gv.x + lv.x), o1 = siluf_((y2.y - mu) * rstd * gv.y + lv.y);
            *(unsigned*)(YO + (size_t)(m0 + tr) * 1024 + ch) = pk2(o0, o1); }
    }
    __syncthreads();
    if (c.tid < 2) atomicMax((unsigned*)(c.ws + WS_CTL + CTL_MAXIK) + l * 2 + c.tid, mxl[c.tid]);
}

typedef float f32x16 __attribute__((ext_vector_type(16)));
typedef short s16x4 __attribute__((ext_vector_type(4)));
constexpr int IDX_NB = 2048, IDX_QB = 16, IDX_G = 4;
#ifndef IDX_ZOOM
#define IDX_ZOOM 3
#endif
#ifndef IDX_CAP
#define IDX_CAP 256
#endif
constexpr int IL_HIST = 0;
constexpr int IL_FHIST = 32768;
constexpr int IL_VS = 32768;
constexpr int IL_MASK = 114688;
constexpr int IL_SEL = 131072;
constexpr int IL_QI = 139264;
constexpr int IL_FMISC = IL_QI + 512;
constexpr int IL_FIQ = IL_FMISC + 128;

__device__ __forceinline__ unsigned score_key(float s) { s += 0.f; const unsigned u = __float_as_uint(s); return (u & 0x80000000u) ? ~u : (u | 0x80000000u); }

template <int PASS, int MODE, bool EDGE>
__device__ __forceinline__ void idx_tile(LAS unsigned char* lds, const bf16x8 b0, const bf16x8 b1, int kt, const bf16x8 (&A)[IDX_G][2], const float (&w)[IDX_G][16], const float (&scq)[IDX_G][2], const float (&thr)[IDX_G][2], const float (&thr1)[IDX_G][2], const f32x16& zero16, int t0, int lane) {
    const int r32 = lane & 31, hi = lane >> 5, key = kt * 32 + r32;
    LAS unsigned* mask = (LAS unsigned*)(lds + IL_MASK); LAS int* qi = (LAS int*)(lds + IL_QI); LAS u32x2* cand = (LAS u32x2*)(lds + IL_HIST);
#pragma unroll
    for (int g = 0; g < IDX_G; ++g) {
        f32x16 acc = __builtin_amdgcn_mfma_f32_32x32x16_bf16(A[g][0], b0, zero16, 0, 0, 0);
        acc = __builtin_amdgcn_mfma_f32_32x32x16_bf16(A[g][1], b1, acc, 0, 0, 0);
#pragma unroll
        for (int j = 0; j < 2; ++j) {
            float sA = 0.f, sB = 0.f;
#pragma unroll
            for (int h = 0; h < 8; h += 2) { const float r0 = __builtin_amdgcn_fmed3f(acc[8 * j + h], 0.f, 3.0e38f), r1 = __builtin_amdgcn_fmed3f(acc[8 * j + h + 1], 0.f, 3.0e38f);
                sA = fmaf(r0, w[g][8 * j + h], sA); sB = fmaf(r1, w[g][8 * j + h + 1], sB); }
            asm volatile("" : "+v"(sA), "+v"(sB));
            const float sc = sA + sB;
            const int ql = 4 * g + 2 * hi + j;
            const bool valid = !EDGE || key <= t0 + ql;
            const float x = __builtin_amdgcn_fmed3f(fmaf(sc, scq[g][j], (float)(IDX_NB / 2)), 0.f, (float)IDX_NB - 0.5f);
            if (PASS == 1) { const unsigned bin = (unsigned)x;
                if (MODE & 4) { asm volatile("" :: "v"(bin), "v"((int)valid)); }
                else { const unsigned addr = ((bin & 0x7feu) << 1) + (unsigned)(IL_HIST + ql * 4096); unsigned val = 1u << ((bin << 4) & 31u); if (EDGE) val = valid ? val : 0u;
                    lds_add((LAS unsigned*)(lds + addr), val); }
            } else {
                const bool ge1 = x >= thr1[g][j], ge0 = x >= thr[g][j];
                const bool above = valid && ge1, cnd = valid && ge0 && !ge1;
                const unsigned long long bal = __ballot(above);
                if (r32 == 0) mask[ql * 256 + kt] = hi ? (unsigned)(bal >> 32) : (unsigned)bal;
                if (cnd) { const int pos = lds_addi(qi + ql * 8 + 3, 1); if (pos < IDX_CAP) cand[ql * 256 + pos] = (u32x2){__float_as_uint(sc + 0.f), (unsigned)key}; }
            }
        }
    }
}
constexpr int IDX_RING = 2;
__device__ __forceinline__ void idx_ring_fill(bf16x8 (&rb)[IDX_RING][2], const bf16_t* IKb, int NT, int wave, int lane) {
    const bf16_t* kp = IKb + (size_t)(lane & 31) * 32 + 8 * (lane >> 5);
#pragma unroll
    for (int d = 0; d < IDX_RING; ++d) { int k2 = wave + 8 * d; k2 = k2 < NT ? k2 : NT - 1; rb[d][0] = *(const bf16x8*)(kp + (size_t)k2 * 1024); rb[d][1] = *(const bf16x8*)(kp + (size_t)k2 * 1024 + 16); }
}
template <int PASS, int MODE>
__device__ __forceinline__ void idx_pass(LAS unsigned char* lds, const bf16_t* IKb, bf16x8 (&rb)[IDX_RING][2], const bf16x8 (&A)[IDX_G][2], const float (&w)[IDX_G][16], const float (&scq)[IDX_G][2], const float (&thr)[IDX_G][2], const float (&thr1)[IDX_G][2], int t0, int NT, int wave, int lane) {
    const int r32 = lane & 31, hi = lane >> 5;
    const bf16_t* kp = IKb + (size_t)r32 * 32 + 8 * hi;
    f32x16 zero16;
#pragma unroll
    for (int i = 0; i < 16; ++i) zero16[i] = 0.f;
    asm volatile("" : "+v"(zero16));
#pragma unroll 1
    for (int kt = wave; kt < NT; kt += IDX_RING * NWAVES) {
#pragma unroll
        for (int d = 0; d < IDX_RING; ++d) { const int ktd = kt + 8 * d;
            const bf16x8 c0 = rb[d][0], c1 = rb[d][1];
            { int k2 = ktd + IDX_RING * NWAVES; if (k2 >= NT) { k2 = wave + 8 * d; k2 = k2 < NT ? k2 : NT - 1; } rb[d][0] = *(const bf16x8*)(kp + (size_t)k2 * 1024); rb[d][1] = *(const bf16x8*)(kp + (size_t)k2 * 1024 + 16); }
            if (ktd < NT) { if (32 * ktd + 31 <= t0) idx_tile<PASS, MODE, false>(lds, c0, c1, ktd, A, w, scq, thr, thr1, zero16, t0, lane); else idx_tile<PASS, MODE, true>(lds, c0, c1, ktd, A, w, scq, thr, thr1, zero16, t0, lane); } }
    }
}

__device__ __forceinline__ void idx_fallback(const Ctx& c, const bf16_t* IQ, const bf16_t* IK, const float* IW, size_t kb, int t, int ql) {
    LAS unsigned* keys = (LAS unsigned*)(c.lds + IL_HIST); LAS unsigned* hist = (LAS unsigned*)(c.lds + IL_FHIST); LAS int* misc = (LAS int*)(c.lds + IL_FMISC);
    LAS float* iqs = (LAS float*)(c.lds + IL_FIQ); LAS float* iws = iqs + 256; LAS unsigned* mask = (LAS unsigned*)(c.lds + IL_MASK);
    const int tid = c.tid, lane = c.lane, wave = c.wave, n = t + 1; const size_t q = kb + t;
    if (tid < 256) iqs[tid] = bf2f(IQ[q * 256 + tid]);
    if (tid < 8) iws[tid] = IW[q * 8 + tid];
    if (tid == 0) { misc[0] = 0; misc[1] = TOPK; }
    __syncthreads();
#pragma unroll 1
    for (int s = tid; s < n; s += NTHREADS) {
        const u32x4* kr = (const u32x4*)(IK + (kb + s) * 32);
        float sc = 0.f;
#pragma unroll 1
        for (int h = 0; h < 8; ++h) { float d = 0.f;
#pragma unroll 1
            for (int i = 0; i < 4; ++i) { asm volatile("" ::: "memory"); const u32x4 w = kr[i]; const f32x4 q0 = *(const LAS f32x4*)(iqs + 32 * h + 8 * i), q1 = *(const LAS f32x4*)(iqs + 32 * h + 8 * i + 4);
                d += q0.x * bflo(w.x) + q0.y * bfhi(w.x) + q0.z * bflo(w.y) + q0.w * bfhi(w.y) + q1.x * bflo(w.z) + q1.y * bfhi(w.z) + q1.z * bflo(w.w) + q1.w * bfhi(w.w); }
            sc = fmaf(fmaxf(d, 0.f), iws[h], sc); }
        keys[s] = score_key(sc);
    }
    for (int rd = 0; rd < 4; ++rd) {
        const int shift = 24 - 8 * rd;
        if (tid < 256) hist[tid] = 0u;
        __syncthreads();
        const unsigned prefix = (unsigned)misc[0];
        for (int s = tid; s < n; s += NTHREADS) { const unsigned k = keys[s]; if (rd == 0 || (k >> (shift + 8)) == prefix) lds_add(&hist[(k >> shift) & 255u], 1u); }
        __syncthreads();
        if (wave == 0) {
            const int need = misc[1];
            unsigned cb[4]; unsigned sl = 0;
#pragma unroll
            for (int j = 0; j < 4; ++j) { cb[j] = hist[4 * lane + j]; sl += cb[j]; }
            const unsigned pre = wave_incl_scan(sl), totw = (unsigned)__builtin_amdgcn_readlane((int)pre, 63);
            const unsigned suf = totw - pre + sl;
            unsigned above = suf - sl;
            if (above < (unsigned)need && (unsigned)need <= suf) {
                bool done = false;
#pragma unroll
                for (int j = 3; j >= 0; --j) { if (!done) { if ((unsigned)need <= above + cb[j]) { misc[0] = (int)((prefix << 8) | (unsigned)(4 * lane + j)); misc[1] = need - (int)above; misc[2] = (int)cb[j]; done = true; } else above += cb[j]; } }
            }
        }
        __syncthreads();
    }
    const unsigned Tk = (unsigned)misc[0]; const int need_eq = misc[1];
    const int seg = (((n + 7) >> 3) + 63) & ~63, s_lo = wave * seg, s_hi = (s_lo + seg < n) ? (s_lo + seg) : n;
    int neq = 0;
    for (int s0 = s_lo; s0 < s_hi; s0 += 64) { const int s = s0 + lane; const bool eq = (s < s_hi) && keys[s] == Tk; neq += __popcll(__ballot(eq)); }
    if (lane == 0) misc[12 + wave] = neq;
    __syncthreads();
    int peq = 0;
    for (int w = 0; w < wave; ++w) peq += misc[12 + w];
    for (int s0 = s_lo; s0 < s_hi; s0 += 64) { const int s = s0 + lane; const unsigned k = (s < s_hi) ? keys[s] : 0u; const bool gt = (s < s_hi) && k > Tk, eq = (s < s_hi) && k == Tk;
        const unsigned long long be_ = __ballot(eq); const int myeq = peq + __popcll(be_ & ((1ull << lane) - 1ull));
        const unsigned long long bs = __ballot(gt || (eq && myeq < need_eq));
        if (lane == 0) { mask[ql * 256 + (s0 >> 5)] = (unsigned)bs; if ((s0 >> 5) + 1 < 256) mask[ql * 256 + (s0 >> 5) + 1] = (unsigned)(bs >> 32); }
        peq += __popcll(be_); }
    __syncthreads();
}

__device__ __forceinline__ void idx_attend(LAS unsigned char* lds, const bf16_t* QN, const bf16_t* KN, const bf16_t* VB, bf16_t* YO, size_t kb, int t, int ql, int NT, int wave, int lane) {
    LAS unsigned* mask = (LAS unsigned*)(lds + IL_MASK) + ql * 256; LAS int* sel = (LAS int*)(lds + IL_SEL) + wave * 256; LAS unsigned char* vs = lds + IL_VS + wave * 10240;
    const size_t tok = kb + t; const int fr = lane & 15, fq = lane >> 4;
    unsigned wd[4]; int cntl = 0;
#pragma unroll
    for (int i = 0; i < 4; ++i) { const int kt = 4 * lane + i; wd[i] = (kt < NT) ? mask[kt] : 0u; cntl += __popc(wd[i]); }
    const int incl = (int)wave_incl_scan((unsigned)cntl);
    const int nsel = __builtin_amdgcn_readlane(incl, 63); int pos = incl - cntl;
#pragma unroll
    for (int i = 0; i < 4; ++i) { unsigned wv = wd[i]; while (wv) { const int bpos = __builtin_ctz(wv); if (pos < 256) sel[pos] = (4 * lane + i) * 32 + bpos; ++pos; wv &= wv - 1u; } }
    for (int p = nsel + lane; p < 256; p += 64) sel[p] = 0;
    asm volatile("s_waitcnt lgkmcnt(0)" ::: "memory");
    const bf16_t* qrow = QN + tok * 512 + (fr & 7) * 64 + 8 * fq; const bf16x8 qb0 = *(const bf16x8*)qrow, qb1 = *(const bf16x8*)(qrow + 32);
    u32x4 vr[2][8];
#pragma unroll
    for (int c2 = 0; c2 < 2; ++c2)
#pragma unroll
        for (int i = 0; i < 8; ++i) { const int key = sel[64 * c2 + (lane >> 3) + 8 * i]; vr[c2][i] = *(const u32x4*)(VB + (kb + key) * 64 + 8 * (lane & 7)); }
    f32x4 sc[16];
#pragma unroll
    for (int hb = 0; hb < 2; ++hb) {
        bf16x8 kf[8][2];
#pragma unroll
        for (int k8 = 0; k8 < 8; ++k8) { const int key = sel[16 * (8 * hb + k8) + fr]; const bf16_t* kr = KN + (kb + key) * 64 + 8 * fq; kf[k8][0] = *(const bf16x8*)kr; kf[k8][1] = *(const bf16x8*)(kr + 32); }
        __builtin_amdgcn_sched_barrier(0);
#pragma unroll
        for (int k8 = 0; k8 < 8; ++k8) { f32x4 a = {0.f, 0.f, 0.f, 0.f}; a = __builtin_amdgcn_mfma_f32_16x16x32_bf16(kf[k8][0], qb0, a, 0, 0, 0); a = __builtin_amdgcn_mfma_f32_16x16x32_bf16(kf[k8][1], qb1, a, 0, 0, 0); sc[8 * hb + k8] = a; }
        __builtin_amdgcn_sched_barrier(0);
    }
    float mx = -INFINITY;
#pragma unroll
    for (int kt = 0; kt < 16; ++kt)
#pragma unroll
        for (int i = 0; i < 4; ++i) { if (16 * kt + 4 * fq + i >= nsel) sc[kt][i] = -INFINITY; mx = fmaxf(mx, sc[kt][i]); }
    mx = fmaxf(mx, xor16_f(mx)); mx = max_x32(mx);
    float sm = 0.f;
#pragma unroll
    for (int kt = 0; kt < 16; ++kt)
#pragma unroll
        for (int i = 0; i < 4; ++i) { sc[kt][i] = __expf(sc[kt][i] - mx); sm += sc[kt][i]; }
    sm += xor16_f(sm); sm = sum_x32(sm);
    const float inv = __builtin_amdgcn_rcpf(sm);
    bf16x8 pf[8];
#pragma unroll
    for (int s = 0; s < 8; ++s) { const u32x2 lo = pack4(sc[2 * s] * inv), hi2 = pack4(sc[2 * s + 1] * inv); const u32x4 w4 = {lo.x, lo.y, hi2.x, hi2.y}; pf[s] = __builtin_bit_cast(bf16x8, w4); }
    f32x4 o[4];
#pragma unroll
    for (int dt = 0; dt < 4; ++dt) o[dt] = (f32x4){0.f, 0.f, 0.f, 0.f};
#pragma unroll
    for (int ch = 0; ch < 4; ++ch) {
#pragma unroll
        for (int i = 0; i < 8; ++i) *(LAS u32x4*)(vs + ((lane >> 3) + 8 * i) * 160 + 16 * (lane & 7)) = vr[ch & 1][i];
        if (ch < 2) {
#pragma unroll
            for (int i = 0; i < 8; ++i) { const int key = sel[64 * (ch + 2) + (lane >> 3) + 8 * i]; vr[ch & 1][i] = *(const u32x4*)(VB + (kb + key) * 64 + 8 * (lane & 7)); } }
        __builtin_amdgcn_sched_barrier(0);
#pragma unroll
        for (int ls = 0; ls < 2; ++ls)
#pragma unroll
            for (int dt = 0; dt < 4; ++dt) {
                LAS unsigned char* ad = vs + (32 * ls + 4 * fq + (fr >> 2)) * 160 + (16 * dt + 4 * (lane & 3)) * 2;
                const s16x4 lo = __builtin_amdgcn_ds_read_tr16_b64_v4i16((LAS s16x4*)ad), hi2 = __builtin_amdgcn_ds_read_tr16_b64_v4i16((LAS s16x4*)(ad + 16 * 160));
                const bf16x8 vf = {lo[0], lo[1], lo[2], lo[3], hi2[0], hi2[1], hi2[2], hi2[3]};
                o[dt] = __builtin_amdgcn_mfma_f32_16x16x32_bf16(vf, pf[2 * ch + ls], o[dt], 0, 0, 0);
            }
        __builtin_amdgcn_sched_barrier(0);
    }
    if (fr < 8) {
#pragma unroll
        for (int dt = 0; dt < 4; ++dt) *(u32x2*)(YO + tok * 1024 + 512 + fr * 64 + 16 * dt + 4 * fq) = pack4(o[dt]);
    }
}

template <int MODE  >
__device__ __forceinline__ void phase_idx_attn(const Ctx& c, int l) {
    const int tid = c.tid, lane = c.lane, wave = c.wave;
    const bf16_t* QN = (const bf16_t*)(c.ws + WS_QN); const bf16_t* KN = (const bf16_t*)(c.ws + WS_KN); const bf16_t* VB = (const bf16_t*)(c.ws + WS_VB);
    const bf16_t* IQ = (const bf16_t*)(c.ws + WS_IQ); const bf16_t* IK = (const bf16_t*)(c.ws + WS_IK); const float* IW = (const float*)(c.ws + WS_IW);
    bf16_t* YO = (bf16_t*)(c.ws + WS_YO);
    LAS int* qi = (LAS int*)(c.lds + IL_QI);
    const unsigned* maxik = (const unsigned*)(c.ws + WS_CTL + CTL_MAXIK) + l * 2; const float* PR = (const float*)(c.ws + WS_PR);
    constexpr int UPB = L / IDX_QB;
    for (int o = c.bid; o < 2 * UPB; o += c.nb) {
        const int b = o / UPB, w_ = o % UPB, ub = (w_ < UPB / 2) ? w_ : (UPB + UPB / 2 - 1 - w_);
        const int t0 = ub * IDX_QB, NT = (t0 + IDX_QB + 31) >> 5; const size_t kb = (size_t)b * L;
        const bool need_select = (t0 + IDX_QB - 1 >= TOPK) && !(MODE & 2);
        __syncthreads();
        { LAS u32x4* h4 = (LAS u32x4*)(c.lds + IL_HIST);
#pragma unroll
            for (int i = 0; i < 8; ++i) h4[tid + NTHREADS * i] = (u32x4){0u, 0u, 0u, 0u}; }
        if (tid < IDX_QB) { qi[tid * 8 + 1] = -1; qi[tid * 8 + 2] = 0; qi[tid * 8 + 3] = 0; qi[tid * 8 + 4] = 0; }
        const int NTP = (MODE & 16) ? 8 : NT;
        if (need_select) {
            int lane1 = lane; asm volatile("" : "+v"(lane1));
            const int r32 = lane1 & 31, hi = lane1 >> 5;
            bf16x8 A[IDX_G][2]; float w[IDX_G][16]; float scq[IDX_G][2]; float thr[IDX_G][2], thr1[IDX_G][2]; bf16x8 rb[IDX_RING][2];
            const int qsel = 2 * ((r32 >> 2) & 1) + ((r32 >> 4) & 1), head = (r32 & 3) + 4 * ((r32 >> 3) & 1);
            const float mk = sqrtf(__uint_as_float(maxik[b])) * 1.001f;
#pragma unroll
            for (int g = 0; g < IDX_G; ++g) { const bf16_t* ar = IQ + (kb + t0 + 4 * g + qsel) * 256 + head * 32 + 8 * hi; A[g][0] = *(const bf16x8*)ar; A[g][1] = *(const bf16x8*)(ar + 16);
#pragma unroll
                for (int j = 0; j < 2; ++j) { const int ql = 4 * g + 2 * hi + j; const f32x4 w0 = *(const f32x4*)(IW + (kb + t0 + ql) * 8), w1 = *(const f32x4*)(IW + (kb + t0 + ql) * 8 + 4);
                    w[g][8 * j + 0] = w0.x; w[g][8 * j + 1] = w0.y; w[g][8 * j + 2] = w0.z; w[g][8 * j + 3] = w0.w; w[g][8 * j + 4] = w1.x; w[g][8 * j + 5] = w1.y; w[g][8 * j + 6] = w1.z; w[g][8 * j + 7] = w1.w;
                    scq[g][j] = (float)(IDX_ZOOM * (IDX_NB / 2)) / (PR[kb + t0 + ql] * mk + 1e-30f); thr[g][j] = -1.f; thr1[g][j] = 0.f; } }
            idx_ring_fill(rb, IK + kb * 32, NTP, wave, lane1);
            __syncthreads();
            idx_pass<1, MODE>(c.lds, IK + kb * 32, rb, A, w, scq, thr, thr1, t0, NTP, wave, lane1);
            __syncthreads();
#pragma unroll 1
            for (int qq = 0; qq < 2; ++qq) { const int ql = 2 * wave + qq;
                if (t0 + ql + 1 > TOPK) {
                    const LAS u32x4* hq = (const LAS u32x4*)(c.lds + IL_HIST + ql * 4096) + 4 * lane; unsigned wv[16]; unsigned tot = 0;
#pragma unroll
                    for (int i = 0; i < 4; ++i) { const u32x4 x = hq[i]; wv[4 * i] = x.x; wv[4 * i + 1] = x.y; wv[4 * i + 2] = x.z; wv[4 * i + 3] = x.w; }
#pragma unroll
                    for (int i = 0; i < 16; ++i) tot += (wv[i] & 0xffffu) + (wv[i] >> 16);
                    const unsigned pre = wave_incl_scan(tot), totw = (unsigned)__builtin_amdgcn_readlane((int)pre, 63);
                    const unsigned suf = totw - pre + tot;
                    unsigned above = suf - tot;
                    if (above < (unsigned)TOPK && (unsigned)TOPK <= suf) { bool done = false;
#pragma unroll
                        for (int i = 15; i >= 0; --i)
#pragma unroll
                            for (int hf = 1; hf >= 0; --hf) { const unsigned cn = hf ? (wv[i] >> 16) : (wv[i] & 0xffffu);
                                if (!done) { if ((unsigned)TOPK <= above + cn) { qi[ql * 8 + 1] = 2 * (16 * lane + i) + hf; qi[ql * 8 + 2] = TOPK - (int)above; done = true; } else above += cn; } } }
                } }
            __syncthreads();
#pragma unroll
            for (int g = 0; g < IDX_G; ++g)
#pragma unroll
                for (int j = 0; j < 2; ++j) { const float tf = (float)qi[(4 * g + 2 * hi + j) * 8 + 1]; thr[g][j] = tf; thr1[g][j] = tf + 1.f; }
            if (!(MODE & 8)) idx_pass<2, MODE>(c.lds, IK + kb * 32, rb, A, w, scq, thr, thr1, t0, NTP, wave, lane1);
            __syncthreads();
#pragma unroll 1
            for (int qq = 0; qq < 2; ++qq) { const int ql = 2 * wave + qq; const int cn = qi[ql * 8 + 3], need = qi[ql * 8 + 2];
                if (cn > IDX_CAP) { if (lane == 0) qi[ql * 8 + 4] = 1; }
                else { const LAS u32x2* cd = (const LAS u32x2*)(c.lds + IL_HIST) + ql * 256; LAS unsigned* mq = (LAS unsigned*)(c.lds + IL_MASK) + ql * 256;
                    for (int i0 = 0; i0 < cn; i0 += 64) { const int i = i0 + lane; const u32x2 me = cd[i < cn ? i : 0]; const float ms = __uint_as_float(me.x); int rank = 0;
                        for (int j = 0; j < cn; ++j) { const u32x2 ot = cd[j]; const float os = __uint_as_float(ot.x); rank += (os > ms || (os == ms && ot.y < me.y)) ? 1 : 0; }
                        if (i < cn && rank < need) __hip_atomic_fetch_or(mq + (me.y >> 5), 1u << (me.y & 31u), __ATOMIC_RELAXED, __HIP_MEMORY_SCOPE_WORKGROUP); } } }
            __syncthreads();
#pragma unroll 1
            for (int ql = 0; ql < IDX_QB; ++ql) if (qi[ql * 8 + 4] != 0) idx_fallback(c, IQ, IK, IW, kb, t0 + ql, ql);
        } else {
            __syncthreads();
            LAS unsigned* mask = (LAS unsigned*)(c.lds + IL_MASK);
            for (int i = tid; i < IDX_QB * NT; i += NTHREADS) { const int ql = i / NT, kt = i % NT; const int hi_key = t0 + ql - 32 * kt;
                mask[ql * 256 + kt] = hi_key < 0 ? 0u : (hi_key >= 31 ? 0xffffffffu : ((2u << hi_key) - 1u)); }
            __syncthreads();
        }
        if (!(MODE & 1)) {
#pragma unroll 1
            for (int qq = 0; qq < 2; ++qq) { int lane2 = lane; asm volatile("" : "+v"(lane2)); idx_attend(c.lds, QN, KN, VB, YO, kb, t0 + 2 * wave + qq, 2 * wave + qq, NT, wave, lane2); } }
    }
}

struct EpiD1 {
    EPI_COMMON_P
    const bf16_t* gates; const float* bc; bf16_t* Mo;
    __device__ __forceinline__ void half(const f32x4 (&acc)[2][4][2], int ai, const GUnit& u, int wr, int wc, int fr, int fq) const {
        const int which = u.aux;
#pragma unroll
        for (int m = 0; m < 4; ++m) { const size_t row = (size_t)u.row0 + 128 * ai + 64 * wr + 16 * m + fr;
#pragma unroll
            for (int bj = 0; bj < 2; ++bj) { const int col = 256 * u.pn + 128 * bj + 32 * wc + 8 * fq;
                const u32x4 gw = *(const u32x4*)(gates + row * 2048 + which * 1024 + col);
                const f32x4 g0 = {bflo(gw.x), bfhi(gw.x), bflo(gw.y), bfhi(gw.y)}, g1 = {bflo(gw.z), bfhi(gw.z), bflo(gw.w), bfhi(gw.w)}; f32x4 o0, o1;
                if (which == 0) { o0 = g0 * (acc[bj][m][0] + *(const f32x4*)(bc + col)); o1 = g1 * (acc[bj][m][1] + *(const f32x4*)(bc + col + 4)); }
                else { const u32x4 pw = *(const u32x4*)(Mo + row * 1024 + col);
                    o0 = (f32x4){bflo(pw.x), bfhi(pw.x), bflo(pw.y), bfhi(pw.y)} + g0 * acc[bj][m][0]; o1 = (f32x4){bflo(pw.z), bfhi(pw.z), bflo(pw.w), bfhi(pw.w)} + g1 * acc[bj][m][1]; }
                *(u32x4*)(Mo + row * 1024 + col) = pack8(o0, o1); } }
    }
};
struct SchedD1 { static constexpr int A_AUX = 0; const char* A; const char* B; int G, c;
    __device__ __forceinline__ bool next(int i, GUnit& u) const { const int Lq = (i >> 1) * G + c, which = i & 1; if (Lq >= 64 * 4) return false; int pm, pn; pg8::tile_order(Lq, 64, 4, pm, pn);
        u.pm = pm; u.pn = pn; u.aux = which; u.row0 = pm * 256; u.rows = nullptr; u.A = A + ((size_t)pm * 256 * 1024 + which * 512) * 2; u.B = B + ((size_t)pn * 256 * 1024 + which * 512) * 2; return true; }
    __device__ __forceinline__ void a_ready(const GUnit&) const {}
    __device__ __forceinline__ void done(const GUnit&) const {}
};
__device__ __forceinline__ void phase_gemm_d1(const Ctx& c, int l) {
    SchedD1 S{(const char*)(c.ws + WS_YO), (const char*)(c.ws + WS_WCA) + (size_t)l * D * D * 2, c.nb, c.bid};
    EpiD1 E{(const bf16_t*)(c.ws + WS_GATES), c.in[13] + l * D, (bf16_t*)(c.ws + WS_H)};
    pg8::gemm_phase<EpiD1, SchedD1, true, true>(c.lds, pg8::Gemm{1024, 1024, opaque_u(512), T}, S, E, c.tid);
}
template <bool XBF>
struct EpiD2 {
    EPI_COMMON_P
    const void* xin; bf16_t* xout; const float* gate;
    __device__ __forceinline__ void half(const f32x4 (&acc)[2][4][2], int ai, const GUnit& u, int wr, int wc, int fr, int fq) const {
        const float* gb = gate + (u.row0 / L) * 6144;
#pragma unroll
        for (int m = 0; m < 4; ++m) { const size_t row = (size_t)u.row0 + 128 * ai + 64 * wr + 16 * m + fr;
#pragma unroll
            for (int bj = 0; bj < 2; ++bj) { const int col = 256 * u.pn + 128 * bj + 32 * wc + 8 * fq; f32x4 x0, x1;
                if (XBF) { const u32x4 xw = *(const u32x4*)((const bf16_t*)xin + row * D + col); x0 = (f32x4){bflo(xw.x), bfhi(xw.x), bflo(xw.y), bfhi(xw.y)}; x1 = (f32x4){bflo(xw.z), bfhi(xw.z), bflo(xw.w), bfhi(xw.w)}; }
                else { x0 = *(const f32x4*)((const float*)xin + row * D + col); x1 = *(const f32x4*)((const float*)xin + row * D + col + 4); }
                const f32x4 g0 = *(const f32x4*)(gb + col), g1 = *(const f32x4*)(gb + col + 4);
                *(u32x4*)(xout + row * D + col) = pack8(x0 + g0 * acc[bj][m][0], x1 + g1 * acc[bj][m][1]); } }
    }
};
struct SchedD2 { static constexpr int A_AUX = 0; const char* A; const char* B; int G, c;
    __device__ __forceinline__ bool next(int i, GUnit& u) const { const int Lq = i * G + c; if (Lq >= 64 * 4) return false; int pm, pn; pg8::tile_order(Lq, 64, 4, pm, pn);
        u.pm = pm; u.pn = pn; u.aux = 0; u.row0 = pm * 256; u.rows = nullptr; u.A = A + (size_t)pm * 256 * D * 2; u.B = B + (size_t)pn * 256 * D * 2; return true; }
    __device__ __forceinline__ void a_ready(const GUnit&) const {}
    __device__ __forceinline__ void done(const GUnit&) const {}
};
__device__ __forceinline__ void phase_gemm_d2(const Ctx& c, int l) {
    SchedD2 S{(const char*)(c.ws + WS_H), (const char*)(c.ws + WS_WO) + (size_t)l * D * D * 2, c.nb, c.bid};
    const float* gate = (const float*)(c.ws + WS_CTL + CTL_MOD) + (l * 2) * 6144 + 2 * D; bf16_t* X1 = (bf16_t*)(c.ws + WS_X1);
    if (l == 0) { EpiD2<false> E{c.in[0], X1, gate}; pg8::gemm_phase<EpiD2<false>, SchedD2, true, true>(c.lds, pg8::Gemm{D, D, opaque_u(D), T}, S, E, c.tid); }
    else { EpiD2<true> E{c.out, X1, gate}; pg8::gemm_phase<EpiD2<true>, SchedD2, true, true>(c.lds, pg8::Gemm{D, D, opaque_u(D), T}, S, E, c.tid); }
}

constexpr int RT_ROWE = 1032, RT_WLO = 36 * RT_ROWE * 2, RT_LG = 2 * RT_WLO;
template <bool DRY>
__device__ __forceinline__ void phase_norm2_route(const Ctx& c, int l) {
    const float* wg = c.in[17] + (size_t)l * D * NG; const float* wrt = c.in[19] + (size_t)l * D * NE;
    LAS bf16_t* Whi = (LAS bf16_t*)c.lds; LAS bf16_t* Wlo = (LAS bf16_t*)(c.lds + RT_WLO);
    for (int i = c.tid; i < D * NG; i += NTHREADS) { const float w = wg[i]; const unsigned h = f2bf(w); Whi[(i % NG) * RT_ROWE + i / NG] = (bf16_t)h; Wlo[(i % NG) * RT_ROWE + i / NG] = (bf16_t)f2bf(w - __uint_as_float(h << 16)); }
    for (int i = c.tid; i < D * NE; i += NTHREADS) { const float w = wrt[i]; const unsigned h = f2bf(w); Whi[(4 + i % NE) * RT_ROWE + i / NE] = (bf16_t)h; Wlo[(4 + i % NE) * RT_ROWE + i / NE] = (bf16_t)f2bf(w - __uint_as_float(h << 16)); }
    LAS int* lcnt = (LAS int*)(c.lds + RT_LG + 12288 + 128); LAS int* gbase = lcnt + 64;
    if (c.tid < NE) lcnt[c.tid] = 0;
    __syncthreads();
    const int lane = c.lane, wave = c.wave, tk = lane & 7, fr = lane & 15, fq = lane >> 4;
    const float* mod = (const float*)(c.ws + WS_CTL + CTL_MOD); const float* g2 = c.in[16] + l * D;
    int* cnt = (int*)(c.ws + WS_CTL + CTL_CNT) + l * NE; bf16_t* H2 = (bf16_t*)(c.ws + WS_H2);
    i32x4* rt = (i32x4*)(c.ws + WS_ROUTE); f32x2* rw = (f32x2*)(c.ws + WS_ROUTE + 512 * 1024); int* inv = (int*)(c.ws + WS_INV);
    const float* bg = c.in[18] + l * NG; const float* br = c.in[20] + l * NE;
    LAS float* LG = (LAS float*)(c.lds + RT_LG) + wave * (8 * 48);
    for (int m0 = c.bid * 64; m0 < T; m0 += c.nb * 64) {
        const int m = m0 + 8 * wave + tk; const float* mb = mod + (l * 2 + m0 / L) * 6144; const bf16_t* xr = (const bf16_t*)(c.ws + WS_X1) + (size_t)m * D + 8 * fq;
        float ssq = 0.f;
#pragma unroll
        for (int ch = 0; ch < 2; ++ch) { u32x4 xw[16];
#pragma unroll
            for (int s8 = 0; s8 < 16; ++s8) xw[s8] = *(const u32x4*)(xr + 32 * (16 * ch + s8));
#pragma unroll
            for (int s8 = 0; s8 < 16; ++s8) { const f32x4 xa = {bflo(xw[s8].x), bfhi(xw[s8].x), bflo(xw[s8].y), bfhi(xw[s8].y)}, xb = {bflo(xw[s8].z), bfhi(xw[s8].z), bflo(xw[s8].w), bfhi(xw[s8].w)};
                ssq += (xa.x * xa.x + xa.y * xa.y) + (xa.z * xa.z + xa.w * xa.w) + (xb.x * xb.x + xb.y * xb.y) + (xb.z * xb.z + xb.w * xb.w); } }
        ssq += xor16_f(ssq); ssq = sum_x32(ssq);
        const float rstd = __builtin_amdgcn_rsqf(ssq * (1.f / D) + EPS);
        f32x4 acc[3];
#pragma unroll
        for (int n = 0; n < 3; ++n) acc[n] = (f32x4){0.f, 0.f, 0.f, 0.f};
        const int wrow[3] = {fr, 16 + fr, (32 + fr) < 36 ? 32 + fr : 35};
#pragma unroll 2
        for (int s = 0; s < 32; ++s) { const int k0 = 32 * s + 8 * fq;
            const u32x4 xw = *(const u32x4*)(xr + 32 * s); const f32x4 x0 = {bflo(xw.x), bfhi(xw.x), bflo(xw.y), bfhi(xw.y)}, x1 = {bflo(xw.z), bfhi(xw.z), bflo(xw.w), bfhi(xw.w)};
            const f32x4 ga = *(const f32x4*)(g2 + k0), gb = *(const f32x4*)(g2 + k0 + 4), sa = *(const f32x4*)(mb + 4 * D + k0), sb = *(const f32x4*)(mb + 4 * D + k0 + 4), ha = *(const f32x4*)(mb + 3 * D + k0), hb = *(const f32x4*)(mb + 3 * D + k0 + 4);
            const f32x4 h0 = x0 * rstd * ga * (sa + 1.f) + ha, h1 = x1 * rstd * gb * (sb + 1.f) + hb;
            const u32x4 hi4 = {pk2(h0.x, h0.y), pk2(h0.z, h0.w), pk2(h1.x, h1.y), pk2(h1.z, h1.w)};
            const f32x4 l0 = h0 - (f32x4){bflo(hi4.x), bfhi(hi4.x), bflo(hi4.y), bfhi(hi4.y)}, l1 = h1 - (f32x4){bflo(hi4.z), bfhi(hi4.z), bflo(hi4.w), bfhi(hi4.w)};
            const u32x4 lo4 = {pk2(l0.x, l0.y), pk2(l0.z, l0.w), pk2(l1.x, l1.y), pk2(l1.z, l1.w)};
            if (!DRY && fr < 8) *(u32x4*)(H2 + (size_t)m * D + k0) = hi4;
            const bf16x8 ahi = __builtin_bit_cast(bf16x8, hi4), alo = __builtin_bit_cast(bf16x8, lo4);
#pragma unroll
            for (int n = 0; n < 3; ++n) { const bf16x8 bhi = *(const LAS bf16x8*)(Whi + wrow[n] * RT_ROWE + k0), blo = *(const LAS bf16x8*)(Wlo + wrow[n] * RT_ROWE + k0);
                acc[n] = __builtin_amdgcn_mfma_f32_16x16x32_bf16(ahi, bhi, acc[n], 0, 0, 0);
                acc[n] = __builtin_amdgcn_mfma_f32_16x16x32_bf16(ahi, blo, acc[n], 0, 0, 0);
                acc[n] = __builtin_amdgcn_mfma_f32_16x16x32_bf16(alo, bhi, acc[n], 0, 0, 0); } }
        if (fq < 2) {
#pragma unroll
            for (int n = 0; n < 3; ++n)
#pragma unroll
                for (int i = 0; i < 4; ++i) LG[(4 * fq + i) * 48 + 16 * n + fr] = acc[n][i]; }
        asm volatile("s_waitcnt lgkmcnt(0)" ::: "memory");
        int ea = 0, eb = 0, la = 0, lb = 0; float wa = 0.f, wb = 0.f;
        if (lane < 8) { const LAS f32x4* lg4 = (const LAS f32x4*)(LG + lane * 48);
            const f32x4 g4 = lg4[0];
            float gl[4] = {g4.x + bg[0], g4.y + bg[1], g4.z + bg[2], g4.w + bg[3]}; int gs = 0; float gm = gl[0];
#pragma unroll
            for (int g = 1; g < 4; ++g) if (gl[g] > gm) { gm = gl[g]; gs = g; }
            float gsum = 0.f;
#pragma unroll
            for (int g = 0; g < 4; ++g) gsum += __expf(gl[g] - gm);
            const float pg = __builtin_amdgcn_rcpf(gsum);
            const f32x4 ea4 = lg4[1 + 2 * gs], eb4 = lg4[2 + 2 * gs]; const f32x4 ba4 = *(const f32x4*)(br + 8 * gs), bb4 = *(const f32x4*)(br + 8 * gs + 4);
            const float ev[8] = {ea4.x + ba4.x, ea4.y + ba4.y, ea4.z + ba4.z, ea4.w + ba4.w, eb4.x + bb4.x, eb4.y + bb4.y, eb4.z + bb4.z, eb4.w + bb4.w};
            int i1 = 0; float v1 = ev[0];
#pragma unroll
            for (int e = 1; e < 8; ++e) if (ev[e] > v1) { v1 = ev[e]; i1 = e; }
            int i2 = -1; float v2 = -INFINITY;
#pragma unroll
            for (int e = 0; e < 8; ++e) { if (e != i1 && (i2 < 0 || ev[e] > v2)) { i2 = e; v2 = ev[e]; } }
            const float e2 = __expf(v2 - v1), p1 = __builtin_amdgcn_rcpf(1.f + e2), p2 = e2 * p1;
            if (DRY) { asm volatile("" :: "v"(pg * p1), "v"(pg * p2), "v"(gs * 8 + i1), "v"(gs * 8 + i2)); }
            else { ea = gs * 8 + i1; eb = gs * 8 + i2; wa = pg * p1; wb = pg * p2; la = lds_addi(lcnt + ea, 1); lb = lds_addi(lcnt + eb, 1); } }
        if (!DRY) {
            __syncthreads();
            if (c.tid < NE) { const int n = lcnt[c.tid]; gbase[c.tid] = n ? atomicAdd(cnt + c.tid, n) : 0; }
            __syncthreads();
            if (lane < 8) { const int mt = m0 + 8 * wave + lane; const int ra = gbase[ea] + la, rb = gbase[eb] + lb;
                rt[mt] = (i32x4){ea, ra, eb, rb}; rw[mt] = (f32x2){wa, wb}; inv[(size_t)ea * T + ra] = mt; inv[(size_t)eb * T + rb] = mt; }
            __syncthreads();
            if (c.tid < NE) lcnt[c.tid] = 0;
            __syncthreads();
        }
    }
}
__device__ __forceinline__ void expert_bases(const int* cnt, LAS int* base  , int tid) {
    if (tid < 64) {
        const int n = (tid < NE) ? cnt[tid] : 0, nt_ = (n + 255) >> 8; const int incl = (int)wave_incl_scan((unsigned)nt_), start = incl - nt_;
        if (tid < NE) { base[tid] = start << 8; for (int i = 0; i < nt_; ++i) base[40 + start + i] = tid; }
        if (tid == NE - 1) base[NE] = incl << 8; }
    __syncthreads();
}
__device__ __forceinline__ void phase_scatter(const Ctx& c, int l) {
    LAS int* base = (LAS int*)(c.lds + 131072); const int* cnt = (const int*)(c.ws + WS_CTL + CTL_CNT) + l * NE;
    expert_bases(cnt, base, c.tid);
    const i32x4* rt = (const i32x4*)(c.ws + WS_ROUTE); int* slots = (int*)(c.ws + WS_ROUTE + 768 * 1024); int* rowl = (int*)(c.ws + WS_ROWL);
    for (int m = c.bid * NTHREADS + c.tid; m < T; m += c.nb * NTHREADS) { const i32x4 r = rt[m]; const int s1 = base[r.x] + r.y, s2 = base[r.z] + r.w;
        slots[2 * m] = s1; slots[2 * m + 1] = s2; rowl[s1] = m; rowl[s2] = m; }
    for (int e = c.bid; e < NE; e += c.nb) for (int sidx = base[e] + cnt[e] + c.tid; sidx < base[e + 1]; sidx += NTHREADS) rowl[sidx] = -1;
}
struct EpiMoe1 {
    EPI_COMMON_P
    bf16_t* hid;
    __device__ __forceinline__ void half(const f32x4 (&acc)[2][4][2], int ai, const GUnit& u, int wr, int wc, int fr, int fq) const {
#pragma unroll
        for (int m = 0; m < 4; ++m) { const size_t row = (size_t)u.row0 + 128 * ai + 64 * wr + 16 * m + fr; f32x4 o[2];
#pragma unroll
            for (int n = 0; n < 2; ++n)
#pragma unroll
                for (int i = 0; i < 4; ++i) o[n][i] = siluf_(acc[0][m][n][i]) * acc[1][m][n][i];
            st16_wt(hid, (unsigned)(row * DE + 128 * u.pn + 32 * wc + 8 * fq) * 2u, pack8(o[0], o[1])); }
    }
};
struct EpiMoe2 {
    EPI_COMMON_P
    bf16_t* ys;
    __device__ __forceinline__ void half(const f32x4 (&acc)[2][4][2], int ai, const GUnit& u, int wr, int wc, int fr, int fq) const {
#pragma unroll
        for (int m = 0; m < 4; ++m) { const size_t row = (size_t)u.row0 + 128 * ai + 64 * wr + 16 * m + fr;
#pragma unroll
            for (int bj = 0; bj < 2; ++bj) *(u32x4*)(ys + row * D + 256 * u.pn + 128 * bj + 32 * wc + 8 * fq) = pack8(acc[bj][m][0], acc[bj][m][1]); }
    }
};
__device__ __forceinline__ int tile_expert(const LAS int* base, int rt) { return __builtin_amdgcn_readfirstlane(base[40 + rt]); }
__device__ __forceinline__ void seam_wait(unsigned* f, unsigned target) {
    unsigned sp = 0;
    while (__hip_atomic_load(f, __ATOMIC_RELAXED, __HIP_MEMORY_SCOPE_AGENT) < target) { __builtin_amdgcn_s_sleep(2); if (++sp > (1u << 20)) break; }
    asm volatile("" ::: "memory");
}
struct SchedMoe1 { static constexpr int A_AUX = 0; const char* A; const char* B; const int* rowl; const LAS int* base; unsigned* flag; int nunit, G, c;
    __device__ __forceinline__ bool next(int i, GUnit& u) const { const int Lq = i * G + c; if (Lq >= nunit) return false; const int rt = Lq >> 1, j = Lq & 1, e = tile_expert(base, rt);
        u.pm = rt; u.pn = j; u.aux = e; u.row0 = rt * 256; u.rows = rowl + (size_t)e * T + (rt * 256 - __builtin_amdgcn_readfirstlane(base[e])); u.A = A; u.B = B + ((size_t)e * 512 + 256 * j) * D * 2; return true; }
    __device__ __forceinline__ void a_ready(const GUnit&) const {}
    __device__ __forceinline__ void done(const GUnit& u) const {
        asm volatile("s_waitcnt vmcnt(0)" ::: "memory");
        if ((threadIdx.x & 63) == 0) __hip_atomic_fetch_add(flag + u.pm * 16, 1u, __ATOMIC_RELAXED, __HIP_MEMORY_SCOPE_AGENT); }
};
struct SchedMoe2 { static constexpr int A_AUX = 16; const char* A; const char* B; const LAS int* base; unsigned* flag; int nunit, G, c, heavy;
    __device__ __forceinline__ bool next(int i, GUnit& u) const { if (c < heavy) return false; const int Lq = i * (G - heavy) + (c - heavy); if (Lq >= nunit) return false; const int rt = Lq >> 2, pn = Lq & 3, e = tile_expert(base, rt);
        u.pm = rt; u.pn = pn; u.aux = e; u.row0 = rt * 256; u.rows = nullptr; u.A = A + (size_t)rt * 256 * DE * 2; u.B = B + ((size_t)e * D + 256 * pn) * DE * 2; return true; }
    __device__ __forceinline__ void a_ready(const GUnit& u) const { seam_wait(flag + u.pm * 16, 16u); }
    __device__ __forceinline__ void done(const GUnit&) const {}
};
__device__ __forceinline__ void phase_moe(const Ctx& c, int l) {
    LAS int* base = (LAS int*)(c.lds + 131072); const int* cnt = (const int*)(c.ws + WS_CTL + CTL_CNT) + l * NE;
    expert_bases(cnt, base, c.tid);
    unsigned* flag = (unsigned*)(c.ws + WS_CTL + CTL_MFLAG) + l * 4096;
    const int ntile = __builtin_amdgcn_readfirstlane(base[NE] / 256), n1 = 2 * ntile, heavy = (n1 > c.nb) ? ((n1 - c.nb < c.nb / 2) ? n1 - c.nb : c.nb / 2) : 0;
    { SchedMoe1 S{(const char*)(c.ws + WS_H2), (const char*)(c.ws + WS_WGU), (const int*)(c.ws + WS_INV), base, flag, n1, c.nb, c.bid};
      EpiMoe1 E{(bf16_t*)(c.ws + WS_HID)};
      pg8::gemm_phase<EpiMoe1, SchedMoe1, true, true, true>(c.lds, pg8::Gemm{D, D, opaque_u(D), T}, S, E, c.tid); }
    { SchedMoe2 S{(const char*)(c.ws + WS_HID), (const char*)(c.ws + WS_WD), base, flag, 4 * ntile, c.nb, c.bid, heavy};
      EpiMoe2 E{(bf16_t*)(c.ws + WS_YS)};
      pg8::gemm_phase<EpiMoe2, SchedMoe2, true, true>(c.lds, pg8::Gemm{DE, DE, opaque_u(DE), MAXSLOT}, S, E, c.tid); }
}
template <bool DRY>
__device__ __forceinline__ void phase_combine(const Ctx& c, int l) {
    const int gw = c.bid * NWAVES + c.wave, NGW = c.nb * NWAVES, lane = c.lane;
    const float* mod = (const float*)(c.ws + WS_CTL + CTL_MOD);
    const bf16_t* YS = (const bf16_t*)(c.ws + WS_YS); const i32x4* rt = (const i32x4*)(c.ws + WS_ROUTE); const f32x2* rw = (const f32x2*)(c.ws + WS_ROUTE + 512 * 1024);
    LAS int* base = (LAS int*)(c.lds + 131072); expert_bases((const int*)(c.ws + WS_CTL + CTL_CNT) + l * NE, base, c.tid);
    bf16_t* H = (bf16_t*)(c.ws + WS_H); const bf16_t* X1 = (const bf16_t*)(c.ws + WS_X1);
    for (int m0 = gw; m0 < T; m0 += 4 * NGW) {
        int s1[4], s2[4]; f32x2 w[4]; u32x2 xv[4][4]; u32x2 y1[4][4], y2[4][4];
#pragma unroll
        for (int i = 0; i < 4; ++i) { const int m = (m0 + i * NGW < T) ? m0 + i * NGW : m0; { const i32x4 r = rt[m]; s1[i] = base[r.x] + r.y; s2[i] = base[r.z] + r.w; } w[i] = rw[m];
#pragma unroll
            for (int j = 0; j < 4; ++j) xv[i][j] = *(const u32x2*)(X1 + (size_t)m * D + 4 * lane + 256 * j); }
#pragma unroll
        for (int i = 0; i < 4; ++i)
#pragma unroll
            for (int j = 0; j < 4; ++j) { y1[i][j] = *(const u32x2*)(YS + (size_t)s1[i] * D + 4 * lane + 256 * j); y2[i][j] = *(const u32x2*)(YS + (size_t)s2[i] * D + 4 * lane + 256 * j); }
#pragma unroll
        for (int i = 0; i < 4; ++i) { const int m = m0 + i * NGW; if (m < T) { const int b = m / L; const float* mb = mod + (l * 2 + b) * 6144;
            f32x4 v[4];
#pragma unroll
            for (int j = 0; j < 4; ++j) { const int col = 4 * lane + 256 * j; const f32x4 gv = *(const f32x4*)(mb + 5 * D + col);
                v[j] = unpack4(xv[i][j]) + gv * (unpack4(y1[i][j]) * w[i].x + unpack4(y2[i][j]) * w[i].y);
                if (DRY) { asm volatile("" :: "v"(v[j])); } else if (l == 0) *(u32x2*)((bf16_t*)c.out + (size_t)m * D + col) = pack4(v[j]); else *(f32x4*)(c.out + (size_t)m * D + col) = v[j]; }
            if (l == 0 && !DRY) { const float* m1 = mod + (2 + b) * 6144; norm_row_store(v, c.in[4] + D, m1, m1 + D, H + (size_t)m * D, lane); } } }
    }
    if (l == 0) { LAS float* scr = (LAS float*)(c.lds + c.wave * 8704); convert_items<1>(c, 1, gw, NGW, IT_MOE, scr); }
}

__device__ __forceinline__ void phase_valutest(const Ctx& c) {
    float a[8];
#pragma unroll
    for (int i = 0; i < 8; ++i) a[i] = (float)(c.lane + i);
    const float m = 1.0000001f, b = 1e-9f;
#pragma unroll 1
    for (int it = 0; it < 4096; ++it) {
#pragma unroll
        for (int i = 0; i < 8; ++i) a[i] = fmaf(a[i], m, b);
        asm volatile("" : "+v"(a[0]), "+v"(a[1]), "+v"(a[2]), "+v"(a[3]), "+v"(a[4]), "+v"(a[5]), "+v"(a[6]), "+v"(a[7]));
    }
    float s = 0.f;
#pragma unroll
    for (int i = 0; i < 8; ++i) s += a[i];
    if (s == 12345.678f) ((float*)(c.ws + WS_XS))[c.tid] = s;
}
template <int TB>
__device__ __forceinline__ void phase_memtest(const Ctx& c) {
    const int gw = c.bid * NWAVES + c.wave, NGW = c.nb * NWAVES;
    float* dst = (float*)(c.ws + WS_XS);
    for (int m0 = gw; m0 < T; m0 += TB * NGW) {
        f32x4 v[TB][4];
#pragma unroll
        for (int i = 0; i < TB; ++i) { const int m = (m0 + i * NGW < T) ? m0 + i * NGW : m0;
#pragma unroll
            for (int j = 0; j < 4; ++j) v[i][j] = *(const f32x4*)(c.out + (size_t)m * D + 4 * c.lane + 256 * j); }
#pragma unroll
        for (int i = 0; i < TB; ++i) { const int m = m0 + i * NGW; if (m < T) {
#pragma unroll
            for (int j = 0; j < 4; ++j) *(f32x4*)(dst + (size_t)m * D + 4 * c.lane + 256 * j) = v[i][j]; } }
    }
}

#define XB_TMO      128
#define XB_XCNT(j)  (256  + 64 * (j))
#define XB_XSUB(j)  (1280 + 64 * (j))
#define XB_XGEN(j)  (2304 + 64 * (j))
#define XB_TOP      3328
#define XB_TOPGEN   3392
#define XCD_BAR_WORDS 3456
#define XB_SPIN_CAP (1u << 18)

__device__ __forceinline__ unsigned xb_ld(unsigned* p)              { return __hip_atomic_load(p, __ATOMIC_RELAXED, __HIP_MEMORY_SCOPE_AGENT); }
__device__ __forceinline__ unsigned xb_add(unsigned* p, unsigned v) { return __hip_atomic_fetch_add(p, v, __ATOMIC_RELAXED, __HIP_MEMORY_SCOPE_AGENT); }
__device__ __forceinline__ unsigned xb_xcc_id() { return (unsigned)__builtin_amdgcn_s_getreg((3 << 11) | 20) & 0xFu; }
#define XB_SPIN(cond, bar) do { unsigned _sp = 0; while (cond) { __builtin_amdgcn_s_sleep(1); \
    if ((++_sp & 255u) == 0u) { if (xb_ld(&(bar)[XB_TMO])) break; if (_sp > XB_SPIN_CAP) { atomicAdd(&(bar)[XB_TMO], 1u); break; } } } } while (0)

struct XcdBarrier {
    unsigned* bar; unsigned x;
    volatile LAS unsigned* st;
};

__device__ __forceinline__ XcdBarrier xcd_barrier_post(unsigned* bar, volatile LAS unsigned* st) {
    XcdBarrier b; b.bar = bar; b.x = xb_xcc_id(); b.st = st;
    if (threadIdx.x == 0) (void)xb_add(&bar[XB_XCNT(b.x)], 1u);
    return b;
}
__device__ __forceinline__ void xcd_barrier_complete(unsigned* bar, unsigned x, unsigned& nloc, unsigned& nx) {
    const unsigned G = gridDim.x * gridDim.y * gridDim.z;
    unsigned sum, cnt, mine, sp = 0u;
    for (;;) {
        sum = 0u; cnt = 0u; mine = 0u;
#pragma unroll
        for (unsigned j = 0; j < 16; ++j) { const unsigned c = xb_ld(&bar[XB_XCNT(j)]); sum += c; cnt += (c > 0u) ? 1u : 0u; mine = (j == x) ? c : mine; }
        if (sum == G) break;
        __builtin_amdgcn_s_sleep(1);
        if ((++sp & 255u) == 0u) { if (xb_ld(&bar[XB_TMO])) break; if (sp > XB_SPIN_CAP) { atomicAdd(&bar[XB_TMO], 1u); break; } }
    }
    nloc = mine > 0u ? mine : 1u; nx = cnt > 0u ? cnt : 1u;
}

__device__ __forceinline__ void xcd_barrier(const XcdBarrier& b, bool leader_thread) {
    asm volatile("s_waitcnt vmcnt(0)" ::: "memory");
    __syncthreads();
    if (leader_thread) {
        unsigned* bar = b.bar;
        __builtin_amdgcn_s_waitcnt(0);
        unsigned nloc = b.st[0], nx = b.st[1];
        if (nloc == 0u) { xcd_barrier_complete(bar, b.x, nloc, nx); b.st[0] = nloc; b.st[1] = nx; }
        const unsigned old = xb_add(&bar[XB_XSUB(b.x)], 1u);
        const unsigned gen = old / nloc;
        if (old + 1u == (gen + 1u) * nloc) {
            __builtin_amdgcn_fence(__ATOMIC_RELEASE, "agent");
            asm volatile("s_waitcnt vmcnt(0)" ::: "memory");
            const unsigned og = xb_add(&bar[XB_TOP], 1u);
            const unsigned tg = og / nx;
            if (og + 1u == (tg + 1u) * nx) xb_add(&bar[XB_TOPGEN], 1u);
            else XB_SPIN(xb_ld(&bar[XB_TOPGEN]) == tg, bar);
            __builtin_amdgcn_fence(__ATOMIC_ACQUIRE, "agent");
            xb_add(&bar[XB_XGEN(b.x)], 1u);
            asm volatile("s_waitcnt vmcnt(0)" ::: "memory");
        } else {
            XB_SPIN(xb_ld(&bar[XB_XGEN(b.x)]) == gen, bar);
            __builtin_amdgcn_fence(__ATOMIC_ACQUIRE, "agent");
            asm volatile("s_waitcnt vmcnt(0)" ::: "memory");
        }
    }
    __syncthreads();
}

__global__ void __launch_bounds__(NTHREADS, 2) __attribute__((amdgpu_waves_per_eu(2, 2))) mega(Params p) {
    extern __shared__ __attribute__((aligned(16))) unsigned char lds[];
    Ctx c; c.in = p.in; c.out = p.out; c.ws = p.ws; c.lds = (LAS unsigned char*)lds;
    c.tid = threadIdx.x; c.lane = c.tid & 63; c.wave = __builtin_amdgcn_readfirstlane(c.tid >> 6); c.bid = blockIdx.x; c.nb = gridDim.x;
    const int lo = p.ph_lo, hi = p.ph_hi;
#if ONE_LAUNCH
    volatile LAS unsigned* bmisc = (volatile LAS unsigned*)(c.lds + LDS_BYTES - 64);
    if (c.tid < 16) bmisc[c.tid] = 0u;
    __syncthreads();
    const XcdBarrier bar = xcd_barrier_post((unsigned*)(p.ws + WS_CTL + CTL_BAR), bmisc);
#define SEAM(k) do { if ((k) + 1 < hi) xcd_barrier(bar, cc.tid == 0); } while (0)
#else
#define SEAM(k) do { } while (0)
#endif
#ifdef ONLY_PHASE
#define IN(k) ((k) == ONLY_PHASE)
#else
#define IN(k) (lo <= (k) && (k) < hi)
#endif
#ifndef REP_PH
#define REP_PH -1
#define REP_N 1
#endif
#define PHASE(k, call) do { if (IN(k)) for (int rep_ = 0; rep_ < (((k) == REP_PH) ? REP_N : 1); ++rep_) { Ctx cc = c; cc.ws = opaque_p(cc.ws); cc.out = opaque_p(cc.out); cc.wave = opaque_u(cc.wave); cc.lane = (int)__builtin_amdgcn_mbcnt_hi(~0u, __builtin_amdgcn_mbcnt_lo(~0u, 0u)); cc.tid = cc.wave * 64 + cc.lane; asm volatile("" : "+v"(cc.tid), "+v"(cc.lane)); cc.bid = opaque_u(cc.bid); cc.nb = opaque_u(cc.nb); call; SEAM(k); } } while (0)
    PHASE(0, phase_prep(cc));
    PHASE(1, phase_norm1(cc, 0));
#ifdef DUP_MODE
#define DUPX(k, call) PHASE(k, call)
#else
#define DUPX(k, call)
#endif
#ifndef DUP_PH
#define DUP_PH -1
#endif
#ifndef DUP_PART
#define DUP_PART 3
#endif
#define DUPQ(r, k, call) do { if (DUP_PH == (r)) PHASE(k, call); } while (0)
#define LAYER(l) do { constexpr int p0 = 2 + 10 * (l); \
        DUPQ(0, p0 + 0, phase_gemm_in(cc, l)); \
        PHASE(p0 + 0, phase_gemm_in(cc, l)); \
        DUPQ(1, p0 + 1, phase_post_conv<DUP_PART>(cc, l)); \
        PHASE(p0 + 1, phase_post_conv<3>(cc, l)); \
        DUPX(p0 + 2, phase_idx_attn<DUP_MODE>(cc, l)); \
        PHASE(p0 + 2, phase_idx_attn<0>(cc, l)); \
        DUPQ(3, p0 + 3, phase_gemm_d1(cc, l)); \
        PHASE(p0 + 3, phase_gemm_d1(cc, l)); \
        PHASE(p0 + 4, phase_gemm_d2(cc, l)); \
        DUPQ(53, p0 + 5, (void)0); \
        DUPQ(54, p0 + 5, (void)0); DUPQ(54, p0 + 5, (void)0); DUPQ(54, p0 + 5, (void)0); DUPQ(54, p0 + 5, (void)0); \
        DUPQ(52, p0 + 5, phase_valutest(cc)); \
        DUPQ(50, p0 + 5, phase_memtest<4>(cc)); \
        DUPQ(51, p0 + 5, phase_memtest<8>(cc)); \
        DUPQ(5, p0 + 5, phase_norm2_route<true>(cc, l)); \
        PHASE(p0 + 5, phase_norm2_route<false>(cc, l)); \
        PHASE(p0 + 7, phase_moe(cc, l)); \
        DUPQ(9, p0 + 9, phase_combine<true>(cc, l)); \
        PHASE(p0 + 9, phase_combine<false>(cc, l)); } while (0)
    LAYER(0);
    LAYER(1);
#undef LAYER
#undef PHASE
#undef IN
#undef SEAM
}

extern "C" void kernel_launch(void* const* d_in, const int* in_sizes, int n_in, void* d_out, int out_size, void* d_ws, size_t ws_size, hipStream_t stream) {
    static int grid = 0;
    if (grid == 0) {
        if (n_in != 24 || out_size != T * D || ws_size < WS_END) { fprintf(stderr, "kernel_launch: unexpected shapes (n_in %d out %d ws %zu)\n", n_in, out_size, ws_size); grid = -1; return; }
        int dev = 0, cus = 0, per_cu = 0;
        hipGetDevice(&dev); hipDeviceGetAttribute(&cus, hipDeviceAttributeMultiprocessorCount, dev);
        if (hipFuncSetAttribute((const void*)mega, hipFuncAttributeMaxDynamicSharedMemorySize, LDS_BYTES) != hipSuccess) { fprintf(stderr, "kernel_launch: hipFuncSetAttribute failed\n"); grid = -1; return; }
        if (hipOccupancyMaxActiveBlocksPerMultiprocessor(&per_cu, (const void*)mega, NTHREADS, LDS_BYTES) != hipSuccess || per_cu < 1) { fprintf(stderr, "kernel_launch: occupancy query says %d\n", per_cu); per_cu = 1; }
        (void)hipGetLastError();
        grid = cus;
    }
    if (grid < 0) return;
    hipMemsetAsync((char*)d_ws + WS_CTL, 0, CTL_ZERO, stream);
    Params p{};
    for (int i = 0; i < 24; ++i) p.in[i] = (const float*)d_in[i];
    p.out = (float*)d_out; p.ws = (unsigned char*)d_ws;
#if ONE_LAUNCH
    p.ph_lo = 0; p.ph_hi = NPH;
    hipLaunchKernelGGL(mega, dim3(grid), dim3(NTHREADS), LDS_BYTES, stream, p);
#else
    for (int ph = 0; ph < NPH; ++ph) { p.ph_lo = ph; p.ph_hi = ph + 1; hipLaunchKernelGGL(mega, dim3(grid), dim3(NTHREADS), LDS_BYTES, stream, p); }
#endif
}
```

```cpp
#include <hip/hip_runtime.h>
#include <cstdio>
#include <cstdint>

#ifndef ONE_LAUNCH
#define ONE_LAUNCH 1
#endif

#define LAS __attribute__((address_space(3)))
typedef unsigned short bf16_t;
typedef short bf16x8 __attribute__((ext_vector_type(8)));
typedef float f32x4 __attribute__((ext_vector_type(4)));
typedef float f32x2 __attribute__((ext_vector_type(2)));
typedef unsigned u32x4 __attribute__((ext_vector_type(4)));
typedef unsigned u32x2 __attribute__((ext_vector_type(2)));
typedef int i32x4 __attribute__((ext_vector_type(4)));

constexpr int NB = 2, L = 8192, T = NB * L, D = 1024;
constexpr int NTHREADS = 512, NWAVES = 8;
constexpr int CONV_CH = 512, CONV_W = 31;
constexpr int NH = 8, HD = 64, AW = 512;
constexpr int IH = 8, IDIM = 32;
constexpr int TOPK = 256;
constexpr int NE = 32, EPG = 8, NG = 4, DE = 256;
constexpr int NIN = 4008, NINP = 4096;
constexpr float EPS = 1e-6f;
constexpr int MAXSLOT = T * 2 + NE * 256;
constexpr int NPH = 22;

constexpr size_t MiB = 1u << 20;
constexpr size_t WS_CTL = 0;
constexpr size_t CTL_ZERO = 256 * 1024;
constexpr size_t CTL_CNT = 4096;
constexpr size_t CTL_MOD = 65536;
constexpr size_t CTL_BAR = 16384;
constexpr size_t CTL_MFLAG = 32768;
constexpr size_t CTL_MAXIK = 8192;
constexpr size_t WS_TAB = 1 * MiB;
constexpr size_t WS_WIN = 4 * MiB;
constexpr size_t WS_WCA = 20 * MiB;
constexpr size_t WS_WO = 24 * MiB;
constexpr size_t WS_WGU = 28 * MiB;
constexpr size_t WS_WD = 60 * MiB;
constexpr size_t WS_H = 76 * MiB;
constexpr size_t WS_UGLU = 108 * MiB;
constexpr size_t WS_RAW = 124 * MiB;
constexpr size_t WS_RAWF = 156 * MiB;
constexpr size_t WS_GATES = 188 * MiB;
constexpr size_t WS_QN = 252 * MiB;
constexpr size_t WS_KN = 268 * MiB;
constexpr size_t WS_VB = 270 * MiB;
constexpr size_t WS_IQ = 272 * MiB;
constexpr size_t WS_IK = 280 * MiB;
constexpr size_t WS_IW = 281 * MiB;
constexpr size_t WS_YO = 282 * MiB;
constexpr size_t WS_PR = 315 * MiB;
constexpr size_t WS_ROUTE = 314 * MiB;
constexpr size_t WS_INV = 316 * MiB;
constexpr size_t WS_END = 318 * MiB;
constexpr size_t WS_XS = 144 * MiB;
constexpr size_t WS_H2 = 108 * MiB;
constexpr size_t WS_ROWL = 315 * MiB + 128 * 1024;
constexpr size_t WS_HID = 76 * MiB;
constexpr size_t WS_X1 = 156 * MiB;
constexpr size_t WS_YS = 188 * MiB;

constexpr int LDS_BYTES = 160 * 1024;

__device__ __forceinline__ unsigned f2bf(float f) { unsigned u = __float_as_uint(f); return (u + 0x7fffu + ((u >> 16) & 1u)) >> 16; }
typedef __bf16 hwbf16x2 __attribute__((ext_vector_type(2)));
__device__ __forceinline__ unsigned pk2(float lo, float hi) { const f32x2 v = {lo, hi}; return __builtin_bit_cast(unsigned, __builtin_convertvector(v, hwbf16x2)); }
__device__ __forceinline__ float bflo(unsigned w) { return __uint_as_float(w << 16); }
__device__ __forceinline__ float bfhi(unsigned w) { return __uint_as_float(w & 0xffff0000u); }
__device__ __forceinline__ float bf2f(bf16_t h) { return __uint_as_float((unsigned)h << 16); }
__device__ __forceinline__ float sigmoidf_(float x) { return __builtin_amdgcn_rcpf(1.f + __expf(-x)); }
__device__ __forceinline__ float siluf_(float x) { return x * __builtin_amdgcn_rcpf(1.f + __expf(-x)); }
__device__ __forceinline__ unsigned lds_add(LAS unsigned* p, unsigned v) { return __hip_atomic_fetch_add(p, v, __ATOMIC_RELAXED, __HIP_MEMORY_SCOPE_WORKGROUP); }
__device__ __forceinline__ int lds_addi(LAS int* p, int v) { return __hip_atomic_fetch_add(p, v, __ATOMIC_RELAXED, __HIP_MEMORY_SCOPE_WORKGROUP); }
template <int CTRL> __device__ __forceinline__ float dpp_f(float v) { return __int_as_float(__builtin_amdgcn_update_dpp(0, __float_as_int(v), CTRL, 0xf, 0xf, true)); }
__device__ __forceinline__ float row16_sum(float v) { v += dpp_f<0xB1>(v); v += dpp_f<0x4E>(v); v += dpp_f<0x141>(v); v += dpp_f<0x140>(v); return v; }
__device__ __forceinline__ float row16_max(float v) { v = fmaxf(v, dpp_f<0xB1>(v)); v = fmaxf(v, dpp_f<0x4E>(v)); v = fmaxf(v, dpp_f<0x141>(v)); v = fmaxf(v, dpp_f<0x140>(v)); return v; }
__device__ __forceinline__ float rl_f(float v, int l) { return __int_as_float(__builtin_amdgcn_readlane(__float_as_int(v), l)); }
__device__ __forceinline__ float wave_sum(float v) { v = row16_sum(v); return (rl_f(v, 0) + rl_f(v, 16)) + (rl_f(v, 32) + rl_f(v, 48)); }
__device__ __forceinline__ float wave_max(float v) { v = row16_max(v); return fmaxf(fmaxf(rl_f(v, 0), rl_f(v, 16)), fmaxf(rl_f(v, 32), rl_f(v, 48))); }
__device__ __forceinline__ unsigned wave_incl_scan(unsigned v) {
    v += (unsigned)__builtin_amdgcn_update_dpp(0, (int)v, 0x111, 0xf, 0xf, true);
    v += (unsigned)__builtin_amdgcn_update_dpp(0, (int)v, 0x112, 0xf, 0xf, true);
    v += (unsigned)__builtin_amdgcn_update_dpp(0, (int)v, 0x114, 0xf, 0xf, true);
    v += (unsigned)__builtin_amdgcn_update_dpp(0, (int)v, 0x118, 0xf, 0xf, true);
    v += (unsigned)__builtin_amdgcn_update_dpp(0, (int)v, 0x142, 0xa, 0xf, false);
    v += (unsigned)__builtin_amdgcn_update_dpp(0, (int)v, 0x143, 0xc, 0xf, false);
    return v;
}
__device__ __forceinline__ float xor16_f(float v) { return __int_as_float(__builtin_amdgcn_ds_swizzle(__float_as_int(v), (16 << 10) | 0x1f)); }
__device__ __forceinline__ float max_x32(float v) { const auto r = __builtin_amdgcn_permlane32_swap(__float_as_uint(v), __float_as_uint(v), false, false); return fmaxf(__uint_as_float(r[0]), __uint_as_float(r[1])); }
__device__ __forceinline__ float sum_x32(float v) { const auto r = __builtin_amdgcn_permlane32_swap(__float_as_uint(v), __float_as_uint(v), false, false); return __uint_as_float(r[0]) + __uint_as_float(r[1]); }
__device__ __forceinline__ float oct_sum(float v) { v += dpp_f<0xB1>(v); v += dpp_f<0x4E>(v); v += dpp_f<0x141>(v); return v; }
__device__ __forceinline__ int opaque_u(int x) { asm volatile("" : "+v"(x)); return __builtin_amdgcn_readfirstlane(x); }
template <class P> __device__ __forceinline__ P* opaque_p(P* p) { const unsigned long long v = (unsigned long long)p; unsigned lo = (unsigned)v, hi = (unsigned)(v >> 32); asm volatile("" : "+v"(lo), "+v"(hi));
    lo = __builtin_amdgcn_readfirstlane(lo); hi = __builtin_amdgcn_readfirstlane(hi);
    return (P*)(__attribute__((address_space(1))) P*)(((unsigned long long)hi << 32) | lo); }
struct Params { const float* in[24]; float* out; unsigned char* ws; int ph_lo, ph_hi; };

struct Ctx {
    const float* const* in; float* out; unsigned char* ws;
    LAS unsigned char* lds;
    int tid, lane, wave, bid, nb;
};

struct TItem { const float* src; bf16_t* dst; int ldw, ldt, ncol; };
__device__ __forceinline__ void titem_load(const TItem& t, float (&v)[32], int lane) {
    const int j = lane & 31, kh = lane >> 5;
#pragma unroll
    for (int i = 0; i < 32; ++i) v[i] = (j < t.ncol) ? t.src[(size_t)(2 * i + kh) * t.ldw + j] : 0.f;
}
__device__ __forceinline__ void titem_store(const TItem& t, const float (&v)[32], LAS float* scr, int lane) {
    const int j = lane & 31, kh = lane >> 5;
#pragma unroll
    for (int i = 0; i < 32; ++i) scr[(2 * i + kh) * 33 + j] = v[i];
    asm volatile("s_waitcnt lgkmcnt(0)" ::: "memory");
    const int c = lane & 7;
#pragma unroll
    for (int jj = 0; jj < 4; ++jj) { const int n = (lane >> 3) + 8 * jj; const LAS float* s = scr + (8 * c) * 33 + n;
        u32x4 o; o.x = pk2(s[0 * 33], s[1 * 33]); o.y = pk2(s[2 * 33], s[3 * 33]); o.z = pk2(s[4 * 33], s[5 * 33]); o.w = pk2(s[6 * 33], s[7 * 33]);
        *(u32x4*)(t.dst + (size_t)n * t.ldt + 8 * c) = o; }
    asm volatile("s_waitcnt lgkmcnt(0)" ::: "memory");
}
__device__ __forceinline__ TItem titem(const float* W, int ldw, int k0, int c0, int ncol, bf16_t* WT, int ldt, int r0, int kdst0) {
    TItem t; t.src = W + (size_t)k0 * ldw + c0; t.dst = WT + (size_t)r0 * ldt + kdst0 + k0; t.ldw = ldw; t.ldt = ldt; t.ncol = ncol; return t; }

__device__ __forceinline__ void win_map(int db, int& c0, int& ncol) {
    ncol = 32;
    if (db < 32) { const int i = db >> 3, w = db & 7; c0 = (w < 4) ? (128 * i + 32 * w) : (512 + 128 * i + 32 * (w - 4)); }
    else if (db < 48) c0 = 1024 + 32 * (db - 32);
    else if (db < 56) { const int q = db - 48; if (q < 2) c0 = 1536 + 32 * q; else if (q < 4) c0 = 1600 + 32 * (q - 2); else if (q == 4) c0 = 1920; else if (q == 5) { c0 = 1952; ncol = 8; } else { c0 = 0; ncol = 0; } }
    else if (db < 64) c0 = 1664 + 32 * (db - 56);
    else c0 = 1960 + 32 * (db - 64);
}
constexpr int IT_WIN = 16 * 128, IT_WC = 8 * 32, IT_WA = 8 * 32, IT_WO = 16 * 32, IT_MIX = IT_WIN + IT_WC + IT_WA + IT_WO;
constexpr int IT_GU = 32 * 16 * 16, IT_DN = 32 * 4 * 32, IT_MOE = IT_GU + IT_DN;
__device__ __forceinline__ TItem mixer_item(const Ctx& c, int l, int it) {
    bf16_t* WinT = (bf16_t*)(c.ws + WS_WIN) + (size_t)l * NINP * D;
    bf16_t* WcaT = (bf16_t*)(c.ws + WS_WCA) + (size_t)l * D * D;
    bf16_t* WoT = (bf16_t*)(c.ws + WS_WO) + (size_t)l * D * D;
    if (it < IT_WIN) { const int kb = it / 128, db = it % 128; int c0, nc; win_map(db, c0, nc); return titem(c.in[5] + (size_t)l * D * NIN, NIN, 64 * kb, c0, nc, WinT, D, 32 * db, 0); }
    it -= IT_WIN;
    if (it < IT_WC) { const int kb = it / 32, db = it % 32; return titem(c.in[12] + (size_t)l * CONV_CH * D, D, 64 * kb, 32 * db, 32, WcaT, D, 32 * db, 0); }
    it -= IT_WC;
    if (it < IT_WA) { const int kb = it / 32, db = it % 32; return titem(c.in[14] + (size_t)l * AW * D, D, 64 * kb, 32 * db, 32, WcaT, D, 32 * db, 512); }
    it -= IT_WA;
    { const int kb = it / 32, db = it % 32; return titem(c.in[15] + (size_t)l * D * D, D, 64 * kb, 32 * db, 32, WoT, D, 32 * db, 0); }
}
__device__ __forceinline__ TItem moe_item(const Ctx& c, int l, int it) {
    bf16_t* WguT = (bf16_t*)(c.ws + WS_WGU);
    bf16_t* WdT = (bf16_t*)(c.ws + WS_WD);
    if (it < IT_GU) { const int e = it / 256, r = it % 256, kb = r / 16, db = r % 16, j = db >> 3, w = db & 7;
        const float* src = (w < 4 ? c.in[21] : c.in[22]) + ((size_t)l * NE + e) * D * DE;
        return titem(src, DE, 64 * kb, 128 * j + 32 * (w & 3), 32, WguT + (size_t)e * 512 * D, D, 32 * db, 0); }
    it -= IT_GU;
    { const int e = it / 128, r = it % 128, kb = r / 32, db = r % 32;
        return titem(c.in[23] + ((size_t)l * NE + e) * DE * D, D, 64 * kb, 32 * db, 32, WdT + (size_t)e * D * DE, DE, 32 * db, 0); }
}
template <int KIND>
__device__ __forceinline__ void convert_items(const Ctx& c, int l, int first, int step, int nitems, LAS float* scr) {
    if (first >= nitems) return;
    auto get = [&](int it) { return KIND == 0 ? mixer_item(c, it / IT_MIX, it % IT_MIX) : moe_item(c, l, it); };
    TItem cur = get(first); float v[32]; titem_load(cur, v, c.lane);
    for (int it = first; it < nitems; it += step) {
        const int nx = it + step; TItem nt = cur; float nv[32];
        if (nx < nitems) { nt = get(nx); titem_load(nt, nv, c.lane); }
        titem_store(cur, v, scr, c.lane);
        if (nx < nitems) { cur = nt;
#pragma unroll
            for (int i = 0; i < 32; ++i) v[i] = nv[i]; }
    }
}

__device__ __forceinline__ void phase_prep(const Ctx& c) {
    LAS float* scr = (LAS float*)(c.lds + c.wave * 8704);
    const int gw = c.bid * NWAVES + c.wave, NGW = c.nb * NWAVES;
    float* cosH = (float*)(c.ws + WS_TAB); float* sinH = cosH + L * 32; float* cosI = sinH + L * 32; float* sinI = cosI + L * 16;
    for (int it = gw; it < (L * 32 + L * 16) / 64; it += NGW) {
        const bool hd = it < (L * 32) / 64; const int e = (hd ? it : it - (L * 32) / 64) * 64 + c.lane;
        const int pos = hd ? (e >> 5) : (e >> 4), i = hd ? (e & 31) : (e & 15);
        const float inv = powf(10000.f, -(float)(2 * i) / (hd ? 64.f : 32.f)); const float ang = (float)pos * inv;
        const float n = rintf(ang * 0.15915494309189535f); float r = fmaf(-n, 6.2831854820251465f, ang); r = fmaf(-n, -1.7484555314695172e-07f, r);
        const float cv_ = cosf(r), sv_ = sinf(r);
        if (hd) { cosH[e] = cv_; sinH[e] = sv_; } else { cosI[e] = cv_; sinI[e] = sv_; }
    }
    float* mod = (float*)(c.ws + WS_CTL + CTL_MOD);
    for (int it = c.bid; it < 2 * 96; it += c.nb) {
        const int l = it / 96, cc = it % 96, cg = c.lane & 15, ks = c.lane >> 4, col = 64 * cc + 4 * cg;
        const float* W = c.in[2] + (size_t)l * D * 6144; const float* cv = c.in[1];
        f32x4 a0 = {0.f, 0.f, 0.f, 0.f}, a1 = a0;
#pragma unroll 8
        for (int kk = 0; kk < 32; ++kk) { const int k = 128 * c.wave + 4 * kk + ks; const f32x4 w = *(const f32x4*)(W + (size_t)k * 6144 + col); const float s0 = siluf_(cv[k]), s1 = siluf_(cv[D + k]); a0 += w * s0; a1 += w * s1; }
#pragma unroll
        for (int i = 0; i < 4; ++i) { a0[i] += xor16_f(a0[i]); a0[i] = sum_x32(a0[i]); a1[i] += xor16_f(a1[i]); a1[i] = sum_x32(a1[i]); }
        LAS f32x4* red = (LAS f32x4*)(c.lds + 8 * 8704);
        __syncthreads();
        if (ks == 0) { red[(c.wave * 2 + 0) * 16 + cg] = a0; red[(c.wave * 2 + 1) * 16 + cg] = a1; }
        __syncthreads();
        if (c.tid < 32) { const int b = c.tid >> 4; f32x4 t = *(const f32x4*)(c.in[3] + l * 6144 + col);
#pragma unroll
            for (int w = 0; w < 8; ++w) t += red[(w * 2 + b) * 16 + cg];
            *(f32x4*)(mod + (l * 2 + b) * 6144 + col) = t; }
    }
    convert_items<0>(c, 0, gw, NGW, 2 * IT_MIX, scr);
    convert_items<1>(c, 0, gw, NGW, IT_MOE, scr);
}

__device__ __forceinline__ void norm_row_store(const f32x4 (&v)[4], const float* g, const float* shift, const float* scale, bf16_t* orow, int lane) {
    float s = 0.f;
#pragma unroll
    for (int j = 0; j < 4; ++j) s += (v[j].x * v[j].x + v[j].y * v[j].y) + (v[j].z * v[j].z + v[j].w * v[j].w);
    const float rstd = __builtin_amdgcn_rsqf(wave_sum(s) * (1.f / D) + EPS);
#pragma unroll
    for (int j = 0; j < 4; ++j) { const int col = 4 * lane + 256 * j; const f32x4 gv = *(const f32x4*)(g + col), sh = *(const f32x4*)(shift + col), sc = *(const f32x4*)(scale + col);
        const f32x4 o = v[j] * rstd * gv * (sc + 1.f) + sh;
        u32x2 w; w.x = pk2(o.x, o.y); w.y = pk2(o.z, o.w); *(u32x2*)(orow + col) = w; }
}
__device__ __forceinline__ void phase_norm1(const Ctx& c, int l) {
    const int gw = c.bid * NWAVES + c.wave, NGW = c.nb * NWAVES;
    const float* xin = (l == 0) ? c.in[0] : c.out; const float* mod = (const float*)(c.ws + WS_CTL + CTL_MOD);
    bf16_t* H = (bf16_t*)(c.ws + WS_H);
    for (int m0 = gw; m0 < T; m0 += 4 * NGW) {
        f32x4 v[4][4];
#pragma unroll
        for (int i = 0; i < 4; ++i) { const int m = (m0 + i * NGW < T) ? m0 + i * NGW : m0;
#pragma unroll
            for (int j = 0; j < 4; ++j) v[i][j] = *(const f32x4*)(xin + (size_t)m * D + 4 * c.lane + 256 * j); }
#pragma unroll
        for (int i = 0; i < 4; ++i) { const int m = m0 + i * NGW; if (m < T) { const float* mb = mod + (l * 2 + m / L) * 6144; norm_row_store(v[i], c.in[4] + l * D, mb, mb + D, H + (size_t)m * D, c.lane); } }
    }
}

namespace pg8 {
#define PG8_LAS __attribute__((address_space(3)))
constexpr int BM = 256, BK = 64, HALF = 128, HTB = HALF * BK * 2  , STAGE_BYTES = 8 * HTB, NXCD = 8, WGM = 8;
__host__ __device__ __forceinline__ int lds_byte(int r, int c) { const int st = (r >> 4) * 2 + (c >> 5), rr = r & 15, cc = c & 31, ob = rr * 64 + cc * 2; return st * 1024 + (ob ^ (((ob >> 9) & 1) << 5)); }
__host__ __device__ __forceinline__ void stage_rc(int b, int& R, int& C) { const int st = b / 1024, sb = b % 1024, swz = sb ^ (((sb >> 9) & 1) << 5); R = (st >> 1) * 16 + swz / 64; C = (st & 1) * 32 + (swz % 64) / 2; }
__host__ __device__ __forceinline__ int perm32(int rho) { const int n = rho >> 4, i = rho & 15; return 8 * (i >> 2) + 4 * n + (i & 3); }
struct GUnit { const char* A; const char* B; const int* rows; int pm, pn, aux, row0; };
struct Gemm { int lda, ldb, K, M; };
__device__ __forceinline__ void tile_order(int L, int nM, int nN, int& pm, int& pn) {
    const int nwg = nM * nN; int wgid = L; { const int q = nwg / NXCD, r = nwg % NXCD, xcd = wgid % NXCD, off = wgid / NXCD; wgid = (xcd < r ? xcd * (q + 1) : r * (q + 1) + (xcd - r) * q) + off; }
    const int nig = WGM * nN, gid = wgid / nig, fm = gid * WGM, gsz = (nM - fm) < WGM ? (nM - fm) : WGM;
    pm = fm + ((wgid % nig) % gsz); pn = (wgid % nig) / gsz;
}
template <class Epi, class Sched, bool ALIGN_EPI = false, bool SP2 = false, bool GATHER = false>
__device__ __forceinline__ void gemm_phase(PG8_LAS unsigned char* lds, const Gemm g, const Sched& S, const Epi& E, const int tid_in) {
    const int tid = tid_in, wid = __builtin_amdgcn_readfirstlane(tid >> 6), lane = tid & 63, wr = wid >> 2, wc = wid & 3, fr = lane & 15, fq = lane >> 4;
    const int K = g.K, nt = K / BK;
    unsigned voffA[2], voffB[2];
#pragma unroll
    for (int i = 0; i < 2; ++i) { int R, C; stage_rc(tid * 16 + i * 8192, R, C); const int Rb = Epi::PERM ? ((R & ~31) + perm32(R & 31)) : R;
        voffA[i] = (unsigned)(R * g.lda + C) * 2u; voffB[i] = (unsigned)(Rb * g.ldb + C) * 2u; }
    const size_t kstep = (size_t)(BK * 2);
    const size_t hstepA = (size_t)HALF * g.lda * 2, hstepB = (size_t)HALF * g.ldb * 2;
    const unsigned ldsw = (unsigned)wid * 1024u;
    const int aoff = lds_byte(wr * 64 + fr, fq * 8), boff = lds_byte(wc * 32 + fr, fq * 8);
#define PG8_SA(b, h) (((b) * 2 + (h)) * HTB)
#define PG8_SB(b, h) ((4 + (b) * 2 + (h)) * HTB)
#define PG8_STAGE(bufoff, gbase, voff) do { _Pragma("unroll") for (int _i = 0; _i < 2; ++_i) \
        __builtin_amdgcn_global_load_lds((const unsigned*)((const char*)(gbase) + (voff)[_i]), (PG8_LAS unsigned*)(lds + (bufoff) + ldsw + _i * 8192), 16, 0, 0); } while (0)
#define PG8_STAGE_A(bufoff, gbase, off2) do { _Pragma("unroll") for (int _i = 0; _i < 2; ++_i) \
        __builtin_amdgcn_global_load_lds((const unsigned*)((const char*)(gbase) + (off2)[_i]), (PG8_LAS unsigned*)(lds + (bufoff) + ldsw + _i * 8192), 16, 0, Sched::A_AUX); } while (0)
#define PG8_LDA(dst, b, h) do { _Pragma("unroll") for (int m = 0; m < 4; ++m) _Pragma("unroll") for (int k = 0; k < 2; ++k) dst[m][k] = *(const PG8_LAS bf16x8*)(lds + PG8_SA(b, h) + aoff + m * 2048 + k * 1024); } while (0)
#define PG8_LDB(dst, b, h) do { _Pragma("unroll") for (int n = 0; n < 2; ++n) _Pragma("unroll") for (int k = 0; k < 2; ++k) dst[n][k] = *(const PG8_LAS bf16x8*)(lds + PG8_SB(b, h) + boff + n * 2048 + k * 1024); } while (0)
#define PG8_MMA(ai, bj, At, Bt) do { __builtin_amdgcn_s_setprio(1); _Pragma("unroll") for (int m = 0; m < 4; ++m) _Pragma("unroll") for (int n = 0; n < 2; ++n) _Pragma("unroll") for (int k = 0; k < 2; ++k) \
        acc[ai][bj][m][n] = __builtin_amdgcn_mfma_f32_16x16x32_bf16(Bt[n][k], At[m][k], acc[ai][bj][m][n], 0, 0, 0); __builtin_amdgcn_s_setprio(0); } while (0)
#define PG8_WAIT_V(n) asm volatile("s_waitcnt vmcnt(" #n ")" ::: "memory")
#define PG8_WAIT_L(n) asm volatile("s_waitcnt lgkmcnt(" #n ")" ::: "memory")
#define PG8_BAR __builtin_amdgcn_s_barrier()
#define PG8_SCHED __builtin_amdgcn_sched_barrier(0)
    GUnit cur, nxt; int ui = 0;
    if (!S.next(0, cur)) return;
    f32x4 acc[2][2][4][2];
#pragma unroll
    for (int a = 0; a < 2; ++a)
#pragma unroll
        for (int b = 0; b < 2; ++b)
#pragma unroll
            for (int m = 0; m < 4; ++m)
#pragma unroll
                for (int n = 0; n < 2; ++n) acc[a][b][m][n] = (f32x4){0.f, 0.f, 0.f, 0.f};
    bf16x8 At[4][2], B0[2][2], B1[2][2];
    const char* cA = cur.A; const char* cB = cur.B;
    int stR[2], stC[2];
#pragma unroll
    for (int i = 0; i < 2; ++i) stage_rc(tid * 16 + i * 8192, stR[i], stC[i]);
    unsigned coff[2][2], noff[2][2];
#pragma unroll
    for (int h = 0; h < 2; ++h)
#pragma unroll
        for (int i = 0; i < 2; ++i) { if (GATHER) { int r = cur.rows[128 * h + stR[i]]; r = (unsigned)r < (unsigned)g.M ? r : 0; coff[h][i] = ((unsigned)r * (unsigned)g.lda + (unsigned)stC[i]) * 2u; } else coff[h][i] = voffA[i] + (unsigned)(h * hstepA); noff[h][i] = coff[h][i]; }
    S.a_ready(cur);
    if constexpr (SP2) {
        PG8_STAGE(PG8_SB(0, 0), cB, voffB); PG8_STAGE(PG8_SB(0, 1), cB + hstepB, voffB); PG8_STAGE_A(PG8_SA(0, 0), cA, coff[0]); PG8_STAGE_A(PG8_SA(0, 1), cA, coff[1]);
        if (wr == 1) PG8_BAR;
        PG8_WAIT_V(2); PG8_BAR;
        PG8_STAGE(PG8_SB(1, 0), cB + kstep, voffB); PG8_STAGE_A(PG8_SA(1, 0), cA + kstep, coff[0]); PG8_STAGE(PG8_SB(1, 1), cB + hstepB + kstep, voffB);
        PG8_WAIT_V(6); PG8_BAR;
    } else {
        PG8_STAGE(PG8_SB(0, 0), cB, voffB); PG8_STAGE_A(PG8_SA(0, 0), cA, coff[0]); PG8_STAGE(PG8_SB(0, 1), cB + hstepB, voffB); PG8_STAGE_A(PG8_SA(0, 1), cA, coff[1]);
        if (wr == 1) PG8_BAR;
        PG8_WAIT_V(4); PG8_BAR;
        PG8_STAGE(PG8_SB(1, 0), cB + kstep, voffB); PG8_STAGE_A(PG8_SA(1, 0), cA + kstep, coff[0]); PG8_STAGE(PG8_SB(1, 1), cB + hstepB + kstep, voffB);
        PG8_WAIT_V(6); PG8_BAR;
    }
    for (;;) {
        const bool has_next = S.next(ui + 1, nxt);
        const char* nA = has_next ? nxt.A : cA; const char* nB = has_next ? nxt.B : cB;
        if (GATHER) {
#pragma unroll
            for (int h = 0; h < 2; ++h)
#pragma unroll
                for (int i = 0; i < 2; ++i) { if (has_next) { int r = nxt.rows[128 * h + stR[i]]; r = (unsigned)r < (unsigned)g.M ? r : 0; noff[h][i] = ((unsigned)r * (unsigned)g.lda + (unsigned)stC[i]) * 2u; } else noff[h][i] = coff[h][i]; } }
        for (int t = 0; t < nt; t += 2) {
            const bool last = (t == nt - 2);
            const char* a1 = cA + (size_t)(t + 1) * kstep;
            const char* a2 = last ? nA : cA + (size_t)(t + 2) * kstep; const char* b2 = last ? nB : cB + (size_t)(t + 2) * kstep;
            const char* a3 = a2 + kstep; const char* b3 = b2 + kstep;
            unsigned xoff[2][2];
#pragma unroll
            for (int h = 0; h < 2; ++h)
#pragma unroll
                for (int i = 0; i < 2; ++i) xoff[h][i] = (GATHER && last) ? noff[h][i] : coff[h][i];
            if (last && has_next) S.a_ready(nxt);
            if constexpr (SP2) {
            PG8_LDB(B0, 0, 0); PG8_LDB(B1, 0, 1); PG8_SCHED; PG8_LDA(At, 0, 0); PG8_STAGE_A(PG8_SA(1, 1), a1, coff[1]);
            PG8_WAIT_V(8); PG8_WAIT_L(0); PG8_BAR; PG8_MMA(0, 0, At, B0); PG8_MMA(0, 1, At, B1); PG8_BAR; PG8_SCHED;
            PG8_LDA(At, 0, 1); PG8_STAGE(PG8_SB(0, 0), b2, voffB); PG8_STAGE(PG8_SB(0, 1), b2 + hstepB, voffB); PG8_STAGE_A(PG8_SA(0, 0), a2, xoff[0]);
            PG8_WAIT_V(8); PG8_WAIT_L(0); PG8_BAR; PG8_MMA(1, 0, At, B0); PG8_MMA(1, 1, At, B1); PG8_BAR; PG8_SCHED;
            PG8_LDB(B0, 1, 0); PG8_LDB(B1, 1, 1); PG8_SCHED; PG8_LDA(At, 1, 0); PG8_STAGE_A(PG8_SA(0, 1), a2, xoff[1]);
            PG8_WAIT_V(8); PG8_WAIT_L(0); PG8_BAR; PG8_MMA(0, 0, At, B0); PG8_MMA(0, 1, At, B1); PG8_BAR; PG8_SCHED;
            PG8_LDA(At, 1, 1); PG8_STAGE(PG8_SB(1, 0), b3, voffB); PG8_STAGE(PG8_SB(1, 1), b3 + hstepB, voffB); PG8_STAGE_A(PG8_SA(1, 0), a3, xoff[0]);
            PG8_WAIT_V(8); PG8_WAIT_L(0); PG8_BAR; PG8_MMA(1, 0, At, B0); PG8_MMA(1, 1, At, B1); PG8_BAR; PG8_SCHED;
            } else {
            PG8_LDB(B0, 0, 0); PG8_SCHED; PG8_LDA(At, 0, 0); PG8_STAGE_A(PG8_SA(1, 1), a1, coff[1]);
            PG8_WAIT_L(8); PG8_BAR; PG8_WAIT_L(0); PG8_MMA(0, 0, At, B0); PG8_BAR; PG8_SCHED;
            PG8_LDB(B1, 0, 1); PG8_STAGE(PG8_SB(0, 0), b2, voffB);
            PG8_BAR; PG8_WAIT_L(0); PG8_MMA(0, 1, At, B1); PG8_BAR;
            PG8_LDA(At, 0, 1); PG8_STAGE_A(PG8_SA(0, 0), a2, xoff[0]);
            PG8_BAR; PG8_WAIT_L(0); PG8_MMA(1, 0, At, B0); PG8_BAR; PG8_SCHED;
            PG8_STAGE(PG8_SB(0, 1), b2 + hstepB, voffB);
            PG8_WAIT_V(6); PG8_BAR; PG8_MMA(1, 1, At, B1); PG8_BAR;
            PG8_LDB(B0, 1, 0); PG8_SCHED; PG8_LDA(At, 1, 0); PG8_STAGE_A(PG8_SA(0, 1), a2, xoff[1]);
            PG8_WAIT_L(8); PG8_BAR; PG8_WAIT_L(0); PG8_MMA(0, 0, At, B0); PG8_BAR; PG8_SCHED;
            PG8_LDB(B1, 1, 1); PG8_STAGE(PG8_SB(1, 0), b3, voffB);
            PG8_BAR; PG8_WAIT_L(0); PG8_MMA(0, 1, At, B1); PG8_BAR;
            PG8_LDA(At, 1, 1); PG8_STAGE_A(PG8_SA(1, 0), a3, xoff[0]);
            PG8_BAR; PG8_WAIT_L(0); PG8_MMA(1, 0, At, B0); PG8_BAR; PG8_SCHED;
            PG8_STAGE(PG8_SB(1, 1), b3 + hstepB, voffB);
            PG8_WAIT_V(6); PG8_BAR; PG8_MMA(1, 1, At, B1); PG8_BAR;
            }
        }
        if constexpr (ALIGN_EPI) { if (wr == 0) PG8_BAR; }
        if constexpr (!Epi::AFTER_DRAIN) { E(acc, cur, wr, wc, fr, fq); S.done(cur); }
        if (!has_next) break;
#pragma unroll
        for (int a = 0; a < 2; ++a)
#pragma unroll
            for (int b = 0; b < 2; ++b)
#pragma unroll
                for (int m = 0; m < 4; ++m)
#pragma unroll
                    for (int n = 0; n < 2; ++n) acc[a][b][m][n] = (f32x4){0.f, 0.f, 0.f, 0.f};
        cur = nxt; cA = nA; cB = nB; ++ui;
        if (GATHER) {
#pragma unroll
            for (int h = 0; h < 2; ++h)
#pragma unroll
                for (int i = 0; i < 2; ++i) coff[h][i] = noff[h][i]; }
        if constexpr (ALIGN_EPI) { if (wr == 1) PG8_BAR; }
    }
    PG8_WAIT_V(0);
    if constexpr (!ALIGN_EPI) { if (wr == 0) PG8_BAR; }
    PG8_BAR;
    if constexpr (Epi::AFTER_DRAIN) { E.fused(acc, cur, wr, wc, fr, fq, lds, wid, lane); S.done(cur); }
#undef PG8_SA
#undef PG8_SB
#undef PG8_STAGE
#undef PG8_STAGE_A
#undef PG8_LDA
#undef PG8_LDB
#undef PG8_MMA
#undef PG8_WAIT_V
#undef PG8_WAIT_L
#undef PG8_BAR
#undef PG8_SCHED
}
}
using pg8::GUnit;
#define EPI_COMMON_P static constexpr bool PERM = true, AFTER_DRAIN = false; \
    __device__ __forceinline__ void operator()(const f32x4 (&acc)[2][2][4][2], const GUnit& u, int wr, int wc, int fr, int fq) const { half(acc[0], 0, u, wr, wc, fr, fq); half(acc[1], 1, u, wr, wc, fr, fq); }
#define EPI_COMMON static constexpr bool PERM = false, AFTER_DRAIN = false; \
    __device__ __forceinline__ void operator()(const f32x4 (&acc)[2][2][4][2], const GUnit& u, int wr, int wc, int fr, int fq) const { half(acc[0], 0, u, wr, wc, fr, fq); half(acc[1], 1, u, wr, wc, fr, fq); }

__device__ __forceinline__ u32x2 pack4(const f32x4 v) { u32x2 w; w.x = pk2(v.x, v.y); w.y = pk2(v.z, v.w); return w; }
__device__ __forceinline__ u32x4 pack8(const f32x4 a, const f32x4 b) { return (u32x4){pk2(a.x, a.y), pk2(a.z, a.w), pk2(b.x, b.y), pk2(b.z, b.w)}; }
typedef unsigned v4u_ __attribute__((vector_size(16)));
__device__ __forceinline__ void st16_wt(const void* base, unsigned off, const u32x4 v) {
    __builtin_amdgcn_raw_buffer_store_b128(__builtin_bit_cast(v4u_, v), __builtin_amdgcn_make_buffer_rsrc(const_cast<void*>(base), 0, 0x7FFFFFFF, 0x00020000), (int)off, 0, 16);
}
__device__ __forceinline__ f32x4 unpack4(const u32x2 w) { return (f32x4){bflo(w.x), bfhi(w.x), bflo(w.y), bfhi(w.y)}; }

struct EpiIn {
    EPI_COMMON_P
    bf16_t* uglu; bf16_t* rawb; float* rawf; bf16_t* gates;
    __device__ __forceinline__ void half(const f32x4 (&acc)[2][4][2], int ai, const GUnit& u, int wr, int wc, int fr, int fq) const {
        const int pn = u.pn, c8 = 32 * wc + 8 * fq;
#pragma unroll
        for (int m = 0; m < 4; ++m) { const size_t row = (size_t)u.row0 + 128 * ai + 64 * wr + 16 * m + fr;
            if (pn < 4) { f32x4 o[2];
#pragma unroll
                for (int n = 0; n < 2; ++n)
#pragma unroll
                    for (int i = 0; i < 4; ++i) o[n][i] = acc[0][m][n][i] * sigmoidf_(acc[1][m][n][i]);
                *(u32x4*)(uglu + row * 512 + 128 * pn + c8) = pack8(o[0], o[1]);
            } else if (pn == 6) {
#pragma unroll
                for (int bj = 0; bj < 2; ++bj)
#pragma unroll
                    for (int n = 0; n < 2; ++n) *(f32x4*)(rawf + row * 256 + 128 * bj + c8 + 4 * n) = acc[bj][m][n];
            } else if (pn < 8) { const int cb0 = (pn == 7) ? 512 : 256 * (pn - 4);
#pragma unroll
                for (int bj = 0; bj < 2; ++bj) *(u32x4*)(rawb + row * 768 + cb0 + 128 * bj + c8) = pack8(acc[bj][m][0], acc[bj][m][1]);
            } else {
#pragma unroll
                for (int bj = 0; bj < 2; ++bj) { f32x4 o[2];
#pragma unroll
                    for (int n = 0; n < 2; ++n)
#pragma unroll
                        for (int i = 0; i < 4; ++i) o[n][i] = sigmoidf_(acc[bj][m][n][i]);
                    *(u32x4*)(gates + row * 2048 + 256 * (pn - 8) + 128 * bj + c8) = pack8(o[0], o[1]); }
            } }
    }
};
struct SchedIn { static constexpr int A_AUX = 0; const char* A; const char* B; int G, c;
    __device__ __forceinline__ bool next(int i, GUnit& u) const { const int Lq = i * G + c; if (Lq >= 64 * 16) return false; int pm, pn; pg8::tile_order(Lq, 64, 16, pm, pn);
        u.pm = pm; u.pn = pn; u.aux = 0; u.row0 = pm * 256; u.rows = nullptr; u.A = A + (size_t)pm * 256 * D * 2; u.B = B + (size_t)pn * 256 * D * 2; return true; }
    __device__ __forceinline__ void a_ready(const GUnit&) const {}
    __device__ __forceinline__ void done(const GUnit&) const {}
};
__device__ __forceinline__ void phase_gemm_in(const Ctx& c, int l) {
    SchedIn S{(const char*)(c.ws + WS_H), (const char*)(c.ws + WS_WIN) + (size_t)l * NINP * D * 2, c.nb, c.bid};
    EpiIn E{(bf16_t*)(c.ws + WS_UGLU), (bf16_t*)(c.ws + WS_RAW), (float*)(c.ws + WS_RAWF), (bf16_t*)(c.ws + WS_GATES)};
    pg8::gemm_phase<EpiIn, SchedIn, true, true>(c.lds, pg8::Gemm{D, D, opaque_u(D), T}, S, E, c.tid);
}

template <int PART>
__device__ __forceinline__ void phase_post_conv(const Ctx& c, int l) {
    const int gw = c.bid * NWAVES + c.wave, NGW = c.nb * NWAVES, lane = c.lane;
    const bf16_t* RAWB = (const bf16_t*)(c.ws + WS_RAW); const float* RAWF = (const float*)(c.ws + WS_RAWF);
    const float* cosH = (const float*)(c.ws + WS_TAB); const float* sinH = cosH + L * 32; const float* cosI = sinH + L * 32; const float* sinI = cosI + L * 16;
    bf16_t* QN = (bf16_t*)(c.ws + WS_QN); bf16_t* KN = (bf16_t*)(c.ws + WS_KN); bf16_t* VB = (bf16_t*)(c.ws + WS_VB);
    bf16_t* IQ = (bf16_t*)(c.ws + WS_IQ); bf16_t* IK = (bf16_t*)(c.ws + WS_IK); float* IW = (float*)(c.ws + WS_IW);
    const float* qg = c.in[6] + l * HD; const float* kg = c.in[7] + l * HD; float* PRo = (float*)(c.ws + WS_PR);
    float mxk0 = 0.f, mxk1 = 0.f;
    struct PostIn { f32x4 q0, q1, kv0, kv1, iq, ik, ch0, ch1, sh0, sh1, ci, si; float iw; };
    const int cc = lane & 7, c4 = cc & 3; const bool hi = cc >= 4;
    auto load_in = [&](int m) { PostIn p; const int t = m % L; const bf16_t* rb_ = RAWB + (size_t)m * 768; const float* r = RAWF + (size_t)m * 256;
        { const u32x4 wq = *(const u32x4*)(rb_ + 8 * lane); p.q0 = (f32x4){bflo(wq.x), bfhi(wq.x), bflo(wq.y), bfhi(wq.y)}; p.q1 = (f32x4){bflo(wq.z), bfhi(wq.z), bflo(wq.w), bfhi(wq.w)}; }
        const int off = (lane < 8) ? (8 * lane) : (64 + 8 * (lane & 7)); p.kv0 = *(const f32x4*)(r + off); p.kv1 = *(const f32x4*)(r + off + 4);
        { const u32x2 wi = *(const u32x2*)(rb_ + 512 + 4 * lane); p.iq = (f32x4){bflo(wi.x), bfhi(wi.x), bflo(wi.y), bfhi(wi.y)}; }
        p.ik = *(const f32x4*)(r + 128 + 4 * (lane & 7)); p.iw = r[160 + (lane & 7)];
        p.ch0 = *(const f32x4*)(cosH + t * 32 + 8 * c4); p.ch1 = *(const f32x4*)(cosH + t * 32 + 8 * c4 + 4); p.sh0 = *(const f32x4*)(sinH + t * 32 + 8 * c4); p.sh1 = *(const f32x4*)(sinH + t * 32 + 8 * c4 + 4);
        p.ci = *(const f32x4*)(cosI + t * 16 + 4 * c4); p.si = *(const f32x4*)(sinI + t * 16 + 4 * c4); return p; };
    float qgr[8], kgr[8];
    { const f32x4 a = *(const f32x4*)(qg + 8 * cc), b = *(const f32x4*)(qg + 8 * cc + 4), d = *(const f32x4*)(kg + 8 * cc), e = *(const f32x4*)(kg + 8 * cc + 4);
        qgr[0] = a.x; qgr[1] = a.y; qgr[2] = a.z; qgr[3] = a.w; qgr[4] = b.x; qgr[5] = b.y; qgr[6] = b.z; qgr[7] = b.w;
        kgr[0] = d.x; kgr[1] = d.y; kgr[2] = d.z; kgr[3] = d.w; kgr[4] = e.x; kgr[5] = e.y; kgr[6] = e.z; kgr[7] = e.w; }
    LAS unsigned* mxl = (LAS unsigned*)(c.lds + 64512);
    if (c.tid < 2) mxl[c.tid] = 0u;
    __syncthreads();
    PostIn nx = load_in(gw < T ? gw : 0);
    for (int m = gw; m < ((PART & 1) ? T : 0); m += NGW) {
        const PostIn p = nx; { const int mn = m + NGW; nx = load_in(mn < T ? mn : m); }
        const float csq[8] = {p.ch0.x, p.ch0.y, p.ch0.z, p.ch0.w, p.ch1.x, p.ch1.y, p.ch1.z, p.ch1.w}, snq[8] = {p.sh0.x, p.sh0.y, p.sh0.z, p.sh0.w, p.sh1.x, p.sh1.y, p.sh1.z, p.sh1.w};
        {
            float x[8] = {p.q0.x, p.q0.y, p.q0.z, p.q0.w, p.q1.x, p.q1.y, p.q1.z, p.q1.w}; float s = 0.f;
#pragma unroll
            for (int i = 0; i < 8; ++i) s += x[i] * x[i];
            s = oct_sum(s);
            const float rstd = __builtin_amdgcn_rsqf(s * (1.f / 64.f) + EPS); float o[8];
#pragma unroll
            for (int i = 0; i < 8; ++i) x[i] = x[i] * rstd * qgr[i];
#pragma unroll
            for (int i = 0; i < 8; ++i) { const float other = __shfl_xor(x[i], 4); o[i] = (hi ? (x[i] * csq[i] + other * snq[i]) : (x[i] * csq[i] - other * snq[i])) * 0.125f; }
            u32x4 w; w.x = pk2(o[0], o[1]); w.y = pk2(o[2], o[3]); w.z = pk2(o[4], o[5]); w.w = pk2(o[6], o[7]);
            *(u32x4*)(QN + (size_t)m * 512 + 8 * lane) = w;
        }
        {
            float x[8] = {p.kv0.x, p.kv0.y, p.kv0.z, p.kv0.w, p.kv1.x, p.kv1.y, p.kv1.z, p.kv1.w}; float s = 0.f;
#pragma unroll
            for (int i = 0; i < 8; ++i) s += x[i] * x[i];
            s = oct_sum(s);
            const float rstd = __builtin_amdgcn_rsqf(s * (1.f / 64.f) + EPS); float xn[8], o[8];
#pragma unroll
            for (int i = 0; i < 8; ++i) xn[i] = x[i] * rstd * kgr[i];
#pragma unroll
            for (int i = 0; i < 8; ++i) { const float other = __shfl_xor(xn[i], 4); o[i] = hi ? (xn[i] * csq[i] + other * snq[i]) : (xn[i] * csq[i] - other * snq[i]); }
            if (lane < 8) { u32x4 w; w.x = pk2(o[0], o[1]); w.y = pk2(o[2], o[3]); w.z = pk2(o[4], o[5]); w.w = pk2(o[6], o[7]); *(u32x4*)(KN + (size_t)m * 64 + 8 * lane) = w; }
            else if (lane < 16) { u32x4 w; w.x = pk2(x[0], x[1]); w.y = pk2(x[2], x[3]); w.z = pk2(x[4], x[5]); w.w = pk2(x[6], x[7]); *(u32x4*)(VB + (size_t)m * 64 + 8 * (lane & 7)) = w; }
        }
        const float csi[4] = {p.ci.x, p.ci.y, p.ci.z, p.ci.w}, sni[4] = {p.si.x, p.si.y, p.si.z, p.si.w};
        {
            const f32x4 a = p.iq; float o[4];
#pragma unroll
            for (int i = 0; i < 4; ++i) { const float other = __shfl_xor(a[i], 4); o[i] = hi ? (a[i] * csi[i] + other * sni[i]) : (a[i] * csi[i] - other * sni[i]); }
            u32x2 w; w.x = pk2(o[0], o[1]); w.y = pk2(o[2], o[3]); *(u32x2*)(IQ + (size_t)m * 256 + 4 * lane) = w;
            float n2 = bflo(w.x) * bflo(w.x) + bfhi(w.x) * bfhi(w.x) + bflo(w.y) * bflo(w.y) + bfhi(w.y) * bfhi(w.y);
            n2 = oct_sum(n2);
            const float wh = __shfl(p.iw, lane >> 3);
            const float prs = wave_sum((lane & 7) == 0 ? fabsf(wh) * sqrtf(n2) : 0.f);
            if (lane == 0) PRo[m] = prs;
        }
        {
            const f32x4 a = p.ik; float o[4];
#pragma unroll
            for (int i = 0; i < 4; ++i) { const float other = __shfl_xor(a[i], 4); o[i] = hi ? (a[i] * csi[i] + other * sni[i]) : (a[i] * csi[i] - other * sni[i]); }
            u32x2 w; w.x = pk2(o[0], o[1]); w.y = pk2(o[2], o[3]);
            if (lane < 8) *(u32x2*)(IK + (size_t)m * 32 + 4 * lane) = w;
            else if (lane < 16) IW[(size_t)m * 8 + (lane & 7)] = p.iw;
            float n2 = bflo(w.x) * bflo(w.x) + bfhi(w.x) * bfhi(w.x) + bflo(w.y) * bflo(w.y) + bfhi(w.y) * bfhi(w.y);
            n2 = oct_sum(n2);
            if (m < L) mxk0 = fmaxf(mxk0, n2); else mxk1 = fmaxf(mxk1, n2);
        }
    }
    if (lane == 0) { __hip_atomic_fetch_max(mxl, __float_as_uint(mxk0), __ATOMIC_RELAXED, __HIP_MEMORY_SCOPE_WORKGROUP); __hip_atomic_fetch_max(mxl + 1, __float_as_uint(mxk1), __ATOMIC_RELAXED, __HIP_MEMORY_SCOPE_WORKGROUP); }
    const bf16_t* UG = (const bf16_t*)(c.ws + WS_UGLU); bf16_t* YO = (bf16_t*)(c.ws + WS_YO);
    const float* cw = c.in[8] + (size_t)l * CONV_W * CONV_CH; const float* cb = c.in[9] + l * CONV_CH; const float* lg = c.in[10] + l * CONV_CH; const float* lb = c.in[11] + l * CONV_CH;
    LAS unsigned char* ut = c.lds; LAS float* st = (LAS float*)(c.lds + 63488); LAS f32x2* ys = (LAS f32x2*)(c.lds + 65536) + c.wave * 1024;
    const int half = c.wave >> 2, wq = c.wave & 3, ch = 128 * wq + 2 * lane;
    f32x2 w2[CONV_W];
#pragma unroll
    for (int j = 0; j < CONV_W; ++j) w2[j] = *(const f32x2*)(cw + j * CONV_CH + ch);
    const f32x2 bv = *(const f32x2*)(cb + ch), gv = *(const f32x2*)(lg + ch), lv = *(const f32x2*)(lb + ch);
    for (int tile = c.bid; tile < ((PART & 2) ? T / 32 : 0); tile += c.nb) {
        const int m0 = tile * 32, tl0 = m0 % L;
        __syncthreads();
        { u32x4 sv[8];
#pragma unroll
            for (int k = 0; k < 8; ++k) { const int i = c.tid + NTHREADS * k, row = i >> 6, pc = i & 63; sv[k] = (u32x4){0u, 0u, 0u, 0u};
                if (row < 62 && tl0 - 30 + row >= 0) sv[k] = *(const u32x4*)(UG + (size_t)(m0 - 30 + row) * 512 + 8 * pc); }
#pragma unroll
            for (int k = 0; k < 8; ++k) { const int i = c.tid + NTHREADS * k, row = i >> 6, pc = i & 63; if (row < 62) *(LAS u32x4*)(ut + row * 1024 + 16 * pc) = sv[k]; } }
        __syncthreads();
        {
            f32x2 y16[16];
#pragma unroll
            for (int tk = 0; tk < 16; ++tk) y16[tk] = bv;
            const LAS unsigned char* ub = ut + (16 * half) * 1024 + ch * 2;
#pragma unroll
            for (int i = 0; i < 46; ++i) { const unsigned uu = *(const LAS unsigned*)(ub + i * 1024); const f32x2 u2 = {bflo(uu), bfhi(uu)};
#pragma unroll
                for (int tk = 0; tk < 16; ++tk) if (i - tk >= 0 && i - tk < CONV_W) y16[tk] = __builtin_elementwise_fma(u2, w2[i - tk], y16[tk]); }
#pragma unroll
            for (int tk = 0; tk < 16; ++tk) { const int tr = 16 * half + tk; const f32x2 y2 = y16[tk];
                ys[tk * 64 + lane] = y2;
                const float s1 = wave_sum(y2.x + y2.y), s2 = wave_sum(y2.x * y2.x + y2.y * y2.y);
                if (lane == 0) { st[(tr * 4 + wq) * 2] = s1; st[(tr * 4 + wq) * 2 + 1] = s2; } } }
        __syncthreads();
#pragma unroll 1
        for (int tk = 0; tk < 16; ++tk) { const int tr = 16 * half + tk; const f32x2 y2 = ys[tk * 64 + lane];
            const f32x4 sa = *(const LAS f32x4*)(st + tr * 8), sb = *(const LAS f32x4*)(st + tr * 8 + 4);
            const float mu = ((sa.x + sa.z) + (sb.x + sb.z)) * (1.f / CONV_CH), ex2 = ((sa.y + sa.w) + (sb.y + sb.w)) * (1.f / CONV_CH);
            const float rstd = __builtin_amdgcn_rsqf(fmaxf(ex2 - mu * mu, 0.f) + EPS);
            const float o0 = siluf_((y2.x - mu) * rstd * gv.x + lv.x), o1 = siluf_((y2.y - mu) * rstd * gv.y + lv.y);
            *(unsigned*)(YO + (size_t)(m0 + tr) * 1024 + ch) = pk2(o0, o1); }
    }
    __syncthreads();
    if (c.tid < 2) atomicMax((unsigned*)(c.ws + WS_CTL + CTL_MAXIK) + l * 2 + c.tid, mxl[c.tid]);
}

typedef float f32x16 __attribute__((ext_vector_type(16)));
typedef short s16x4 __attribute__((ext_vector_type(4)));
constexpr int IDX_NB = 2048, IDX_QB = 16, IDX_G = 4;
#ifndef IDX_ZOOM
#define IDX_ZOOM 3
#endif
#ifndef IDX_CAP
#define IDX_CAP 256
#endif
constexpr int IL_HIST = 0;
constexpr int IL_FHIST = 32768;
constexpr int IL_VS = 32768;
constexpr int IL_MASK = 114688;
constexpr int IL_SEL = 131072;
constexpr int IL_QI = 139264;
constexpr int IL_FMISC = IL_QI + 512;
constexpr int IL_FIQ = IL_FMISC + 128;

__device__ __forceinline__ unsigned score_key(float s) { s += 0.f; const unsigned u = __float_as_uint(s); return (u & 0x80000000u) ? ~u : (u | 0x80000000u); }

template <int PASS, int MODE, bool EDGE>
__device__ __forceinline__ void idx_tile(LAS unsigned char* lds, const bf16x8 b0, const bf16x8 b1, int kt, const bf16x8 (&A)[IDX_G][2], const float (&w)[IDX_G][16], const float (&scq)[IDX_G][2], const float (&thr)[IDX_G][2], const float (&thr1)[IDX_G][2], const f32x16& zero16, int t0, int lane) {
    const int r32 = lane & 31, hi = lane >> 5, key = kt * 32 + r32;
    LAS unsigned* mask = (LAS unsigned*)(lds + IL_MASK); LAS int* qi = (LAS int*)(lds + IL_QI); LAS u32x2* cand = (LAS u32x2*)(lds + IL_HIST);
#pragma unroll
    for (int g = 0; g < IDX_G; ++g) {
        f32x16 acc = __builtin_amdgcn_mfma_f32_32x32x16_bf16(A[g][0], b0, zero16, 0, 0, 0);
        acc = __builtin_amdgcn_mfma_f32_32x32x16_bf16(A[g][1], b1, acc, 0, 0, 0);
#pragma unroll
        for (int j = 0; j < 2; ++j) {
            float sA = 0.f, sB = 0.f;
#pragma unroll
            for (int h = 0; h < 8; h += 2) { const float r0 = __builtin_amdgcn_fmed3f(acc[8 * j + h], 0.f, 3.0e38f), r1 = __builtin_amdgcn_fmed3f(acc[8 * j + h + 1], 0.f, 3.0e38f);
                sA = fmaf(r0, w[g][8 * j + h], sA); sB = fmaf(r1, w[g][8 * j + h + 1], sB); }
            asm volatile("" : "+v"(sA), "+v"(sB));
            const float sc = sA + sB;
            const int ql = 4 * g + 2 * hi + j;
            const bool valid = !EDGE || key <= t0 + ql;
            const float xu = fmaf(sc, scq[g][j], (float)(IDX_NB / 2)); const float x = (PASS == 1) ? __builtin_amdgcn_fmed3f(xu, 0.f, (float)IDX_NB - 0.5f) : xu;
            if (PASS == 1) { const unsigned bin = (unsigned)x;
                if (MODE & 4) { asm volatile("" :: "v"(bin), "v"((int)valid)); }
                else { const unsigned addr = ((bin & 0x7feu) << 1) + (unsigned)(IL_HIST + ql * 4096); unsigned val = 1u << ((bin << 4) & 31u); if (EDGE) val = valid ? val : 0u;
                    lds_add((LAS unsigned*)(lds + addr), val); }
            } else {
                const bool ge1 = x >= thr1[g][j], ge0 = x >= thr[g][j];
                const bool above = valid && ge1, cnd = valid && ge0 && !ge1;
                const unsigned long long bal = __ballot(above);
                if (r32 == 0) mask[ql * 256 + kt] = hi ? (unsigned)(bal >> 32) : (unsigned)bal;
                if (cnd) { const int pos = lds_addi(qi + ql * 8 + 3, 1); if (pos < IDX_CAP) cand[ql * 256 + pos] = (u32x2){__float_as_uint(sc + 0.f), (unsigned)key}; }
            }
        }
    }
}
constexpr int IDX_RING = 2;
__device__ __forceinline__ void idx_ring_fill(bf16x8 (&rb)[IDX_RING][2], const bf16_t* IKb, int NT, int wave, int lane) {
    const bf16_t* kp = IKb + (size_t)(lane & 31) * 32 + 8 * (lane >> 5);
#pragma unroll
    for (int d = 0; d < IDX_RING; ++d) { int k2 = wave + 8 * d; k2 = k2 < NT ? k2 : NT - 1; rb[d][0] = *(const bf16x8*)(kp + (size_t)k2 * 1024); rb[d][1] = *(const bf16x8*)(kp + (size_t)k2 * 1024 + 16); }
}
template <int PASS, int MODE>
__device__ __forceinline__ void idx_pass(LAS unsigned char* lds, const bf16_t* IKb, bf16x8 (&rb)[IDX_RING][2], const bf16x8 (&A)[IDX_G][2], const float (&w)[IDX_G][16], const float (&scq)[IDX_G][2], const float (&thr)[IDX_G][2], const float (&thr1)[IDX_G][2], int t0, int NT, int wave, int lane) {
    const int r32 = lane & 31, hi = lane >> 5;
    const bf16_t* kp = IKb + (size_t)r32 * 32 + 8 * hi;
    f32x16 zero16;
#pragma unroll
    for (int i = 0; i < 16; ++i) zero16[i] = 0.f;
    asm volatile("" : "+v"(zero16));
#pragma unroll 1
    for (int kt = wave; kt < NT; kt += IDX_RING * NWAVES) {
#pragma unroll
        for (int d = 0; d < IDX_RING; ++d) { const int ktd = kt + 8 * d;
            const bf16x8 c0 = rb[d][0], c1 = rb[d][1];
            { int k2 = ktd + IDX_RING * NWAVES; if (k2 >= NT) { k2 = wave + 8 * d; k2 = k2 < NT ? k2 : NT - 1; } rb[d][0] = *(const bf16x8*)(kp + (size_t)k2 * 1024); rb[d][1] = *(const bf16x8*)(kp + (size_t)k2 * 1024 + 16); }
            if (ktd < NT) { if (32 * ktd + 31 <= t0) idx_tile<PASS, MODE, false>(lds, c0, c1, ktd, A, w, scq, thr, thr1, zero16, t0, lane); else idx_tile<PASS, MODE, true>(lds, c0, c1, ktd, A, w, scq, thr, thr1, zero16, t0, lane); } }
    }
}

__device__ __forceinline__ void idx_fallback(const Ctx& c, const bf16_t* IQ, const bf16_t* IK, const float* IW, size_t kb, int t, int ql) {
    LAS unsigned* keys = (LAS unsigned*)(c.lds + IL_HIST); LAS unsigned* hist = (LAS unsigned*)(c.lds + IL_FHIST); LAS int* misc = (LAS int*)(c.lds + IL_FMISC);
    LAS float* iqs = (LAS float*)(c.lds + IL_FIQ); LAS float* iws = iqs + 256; LAS unsigned* mask = (LAS unsigned*)(c.lds + IL_MASK);
    const int tid = c.tid, lane = c.lane, wave = c.wave, n = t + 1; const size_t q = kb + t;
    if (tid < 256) iqs[tid] = bf2f(IQ[q * 256 + tid]);
    if (tid < 8) iws[tid] = IW[q * 8 + tid];
    if (tid == 0) { misc[0] = 0; misc[1] = TOPK; }
    __syncthreads();
#pragma unroll 1
    for (int s = tid; s < n; s += NTHREADS) {
        const u32x4* kr = (const u32x4*)(IK + (kb + s) * 32);
        float sc = 0.f;
#pragma unroll 1
        for (int h = 0; h < 8; ++h) { float d = 0.f;
#pragma unroll 1
            for (int i = 0; i < 4; ++i) { asm volatile("" ::: "memory"); const u32x4 w = kr[i]; const f32x4 q0 = *(const LAS f32x4*)(iqs + 32 * h + 8 * i), q1 = *(const LAS f32x4*)(iqs + 32 * h + 8 * i + 4);
                d += q0.x * bflo(w.x) + q0.y * bfhi(w.x) + q0.z * bflo(w.y) + q0.w * bfhi(w.y) + q1.x * bflo(w.z) + q1.y * bfhi(w.z) + q1.z * bflo(w.w) + q1.w * bfhi(w.w); }
            sc = fmaf(fmaxf(d, 0.f), iws[h], sc); }
        keys[s] = score_key(sc);
    }
    for (int rd = 0; rd < 4; ++rd) {
        const int shift = 24 - 8 * rd;
        if (tid < 256) hist[tid] = 0u;
        __syncthreads();
        const unsigned prefix = (unsigned)misc[0];
        for (int s = tid; s < n; s += NTHREADS) { const unsigned k = keys[s]; if (rd == 0 || (k >> (shift + 8)) == prefix) lds_add(&hist[(k >> shift) & 255u], 1u); }
        __syncthreads();
        if (wave == 0) {
            const int need = misc[1];
            unsigned cb[4]; unsigned sl = 0;
#pragma unroll
            for (int j = 0; j < 4; ++j) { cb[j] = hist[4 * lane + j]; sl += cb[j]; }
            const unsigned pre = wave_incl_scan(sl), totw = (unsigned)__builtin_amdgcn_readlane((int)pre, 63);
            const unsigned suf = totw - pre + sl;
            unsigned above = suf - sl;
            if (above < (unsigned)need && (unsigned)need <= suf) {
                bool done = false;
#pragma unroll
                for (int j = 3; j >= 0; --j) { if (!done) { if ((unsigned)need <= above + cb[j]) { misc[0] = (int)((prefix << 8) | (unsigned)(4 * lane + j)); misc[1] = need - (int)above; misc[2] = (int)cb[j]; done = true; } else above += cb[j]; } }
            }
        }
        __syncthreads();
    }
    const unsigned Tk = (unsigned)misc[0]; const int need_eq = misc[1];
    const int seg = (((n + 7) >> 3) + 63) & ~63, s_lo = wave * seg, s_hi = (s_lo + seg < n) ? (s_lo + seg) : n;
    int neq = 0;
    for (int s0 = s_lo; s0 < s_hi; s0 += 64) { const int s = s0 + lane; const bool eq = (s < s_hi) && keys[s] == Tk; neq += __popcll(__ballot(eq)); }
    if (lane == 0) misc[12 + wave] = neq;
    __syncthreads();
    int peq = 0;
    for (int w = 0; w < wave; ++w) peq += misc[12 + w];
    for (int s0 = s_lo; s0 < s_hi; s0 += 64) { const int s = s0 + lane; const unsigned k = (s < s_hi) ? keys[s] : 0u; const bool gt = (s < s_hi) && k > Tk, eq = (s < s_hi) && k == Tk;
        const unsigned long long be_ = __ballot(eq); const int myeq = peq + __popcll(be_ & ((1ull << lane) - 1ull));
        const unsigned long long bs = __ballot(gt || (eq && myeq < need_eq));
        if (lane == 0) { mask[ql * 256 + (s0 >> 5)] = (unsigned)bs; if ((s0 >> 5) + 1 < 256) mask[ql * 256 + (s0 >> 5) + 1] = (unsigned)(bs >> 32); }
        peq += __popcll(be_); }
    __syncthreads();
}

__device__ __forceinline__ void idx_attend(LAS unsigned char* lds, const bf16_t* QN, const bf16_t* KN, const bf16_t* VB, bf16_t* YO, size_t kb, int t, int ql, int NT, int wave, int lane) {
    LAS unsigned* mask = (LAS unsigned*)(lds + IL_MASK) + ql * 256; LAS int* sel = (LAS int*)(lds + IL_SEL) + wave * 256; LAS unsigned char* vs = lds + IL_VS + wave * 10240;
    const size_t tok = kb + t; const int fr = lane & 15, fq = lane >> 4;
    unsigned wd[4]; int cntl = 0;
#pragma unroll
    for (int i = 0; i < 4; ++i) { const int kt = 4 * lane + i; wd[i] = (kt < NT) ? mask[kt] : 0u; cntl += __popc(wd[i]); }
    const int incl = (int)wave_incl_scan((unsigned)cntl);
    const int nsel = __builtin_amdgcn_readlane(incl, 63); int pos = incl - cntl;
#pragma unroll
    for (int i = 0; i < 4; ++i) { unsigned wv = wd[i]; while (wv) { const int bpos = __builtin_ctz(wv); if (pos < 256) sel[pos] = (4 * lane + i) * 32 + bpos; ++pos; wv &= wv - 1u; } }
    for (int p = nsel + lane; p < 256; p += 64) sel[p] = 0;
    asm volatile("s_waitcnt lgkmcnt(0)" ::: "memory");
    const bf16_t* qrow = QN + tok * 512 + (fr & 7) * 64 + 8 * fq; const bf16x8 qb0 = *(const bf16x8*)qrow, qb1 = *(const bf16x8*)(qrow + 32);
    u32x4 vr[2][8];
#pragma unroll
    for (int c2 = 0; c2 < 2; ++c2)
#pragma unroll
        for (int i = 0; i < 8; ++i) { const int key = sel[64 * c2 + (lane >> 3) + 8 * i]; vr[c2][i] = *(const u32x4*)(VB + (kb + key) * 64 + 8 * (lane & 7)); }
    f32x4 sc[16];
#pragma unroll
    for (int hb = 0; hb < 2; ++hb) {
        bf16x8 kf[8][2];
#pragma unroll
        for (int k8 = 0; k8 < 8; ++k8) { const int key = sel[16 * (8 * hb + k8) + fr]; const bf16_t* kr = KN + (kb + key) * 64 + 8 * fq; kf[k8][0] = *(const bf16x8*)kr; kf[k8][1] = *(const bf16x8*)(kr + 32); }
        __builtin_amdgcn_sched_barrier(0);
#pragma unroll
        for (int k8 = 0; k8 < 8; ++k8) { f32x4 a = {0.f, 0.f, 0.f, 0.f}; a = __builtin_amdgcn_mfma_f32_16x16x32_bf16(kf[k8][0], qb0, a, 0, 0, 0); a = __builtin_amdgcn_mfma_f32_16x16x32_bf16(kf[k8][1], qb1, a, 0, 0, 0); sc[8 * hb + k8] = a; }
        __builtin_amdgcn_sched_barrier(0);
    }
    float mx = -INFINITY;
    if (nsel < 256) {
#pragma unroll
        for (int kt = 0; kt < 16; ++kt)
#pragma unroll
            for (int i = 0; i < 4; ++i) if (16 * kt + 4 * fq + i >= nsel) sc[kt][i] = -INFINITY; }
#pragma unroll
    for (int kt = 0; kt < 16; ++kt)
#pragma unroll
        for (int i = 0; i < 4; ++i) mx = fmaxf(mx, sc[kt][i]);
    mx = fmaxf(mx, xor16_f(mx)); mx = max_x32(mx);
    float sm = 0.f;
#pragma unroll
    for (int kt = 0; kt < 16; ++kt)
#pragma unroll
        for (int i = 0; i < 4; ++i) { sc[kt][i] = __expf(sc[kt][i] - mx); sm += sc[kt][i]; }
    sm += xor16_f(sm); sm = sum_x32(sm);
    const float inv = __builtin_amdgcn_rcpf(sm);
    bf16x8 pf[8];
#pragma unroll
    for (int s = 0; s < 8; ++s) { const u32x2 lo = pack4(sc[2 * s] * inv), hi2 = pack4(sc[2 * s + 1] * inv); const u32x4 w4 = {lo.x, lo.y, hi2.x, hi2.y}; pf[s] = __builtin_bit_cast(bf16x8, w4); }
    f32x4 o[4];
#pragma unroll
    for (int dt = 0; dt < 4; ++dt) o[dt] = (f32x4){0.f, 0.f, 0.f, 0.f};
#pragma unroll
    for (int ch = 0; ch < 4; ++ch) {
#pragma unroll
        for (int i = 0; i < 8; ++i) *(LAS u32x4*)(vs + ((lane >> 3) + 8 * i) * 160 + 16 * (lane & 7)) = vr[ch & 1][i];
        if (ch < 2) {
#pragma unroll
            for (int i = 0; i < 8; ++i) { const int key = sel[64 * (ch + 2) + (lane >> 3) + 8 * i]; vr[ch & 1][i] = *(const u32x4*)(VB + (kb + key) * 64 + 8 * (lane & 7)); } }
        __builtin_amdgcn_sched_barrier(0);
#pragma unroll
        for (int ls = 0; ls < 2; ++ls)
#pragma unroll
            for (int dt = 0; dt < 4; ++dt) {
                LAS unsigned char* ad = vs + (32 * ls + 4 * fq + (fr >> 2)) * 160 + (16 * dt + 4 * (lane & 3)) * 2;
                const s16x4 lo = __builtin_amdgcn_ds_read_tr16_b64_v4i16((LAS s16x4*)ad), hi2 = __builtin_amdgcn_ds_read_tr16_b64_v4i16((LAS s16x4*)(ad + 16 * 160));
                const bf16x8 vf = {lo[0], lo[1], lo[2], lo[3], hi2[0], hi2[1], hi2[2], hi2[3]};
                o[dt] = __builtin_amdgcn_mfma_f32_16x16x32_bf16(vf, pf[2 * ch + ls], o[dt], 0, 0, 0);
            }
        __builtin_amdgcn_sched_barrier(0);
    }
    if (fr < 8) {
#pragma unroll
        for (int dt = 0; dt < 4; ++dt) *(u32x2*)(YO + tok * 1024 + 512 + fr * 64 + 16 * dt + 4 * fq) = pack4(o[dt]);
    }
}

template <int MODE  >
__device__ __forceinline__ void phase_idx_attn(const Ctx& c, int l) {
    const int tid = c.tid, lane = c.lane, wave = c.wave;
    const bf16_t* QN = (const bf16_t*)(c.ws + WS_QN); const bf16_t* KN = (const bf16_t*)(c.ws + WS_KN); const bf16_t* VB = (const bf16_t*)(c.ws + WS_VB);
    const bf16_t* IQ = (const bf16_t*)(c.ws + WS_IQ); const bf16_t* IK = (const bf16_t*)(c.ws + WS_IK); const float* IW = (const float*)(c.ws + WS_IW);
    bf16_t* YO = (bf16_t*)(c.ws + WS_YO);
    LAS int* qi = (LAS int*)(c.lds + IL_QI);
    const unsigned* maxik = (const unsigned*)(c.ws + WS_CTL + CTL_MAXIK) + l * 2; const float* PR = (const float*)(c.ws + WS_PR);
    constexpr int UPB = L / IDX_QB;
    for (int o = c.bid; o < 2 * UPB; o += c.nb) {
        const int b = o / UPB, w_ = o % UPB, ub = (w_ < UPB / 2) ? w_ : (UPB + UPB / 2 - 1 - w_);
        const int t0 = ub * IDX_QB, NT = (t0 + IDX_QB + 31) >> 5; const size_t kb = (size_t)b * L;
        const bool need_select = (t0 + IDX_QB - 1 >= TOPK) && !(MODE & 2);
        __syncthreads();
        { LAS u32x4* h4 = (LAS u32x4*)(c.lds + IL_HIST);
#pragma unroll
            for (int i = 0; i < 8; ++i) h4[tid + NTHREADS * i] = (u32x4){0u, 0u, 0u, 0u}; }
        if (tid < IDX_QB) { qi[tid * 8 + 1] = -1; qi[tid * 8 + 2] = 0; qi[tid * 8 + 3] = 0; qi[tid * 8 + 4] = 0; }
        const int NTP = (MODE & 16) ? 8 : NT;
        if (need_select) {
            int lane1 = lane; asm volatile("" : "+v"(lane1));
            const int r32 = lane1 & 31, hi = lane1 >> 5;
            bf16x8 A[IDX_G][2]; float w[IDX_G][16]; float scq[IDX_G][2]; float thr[IDX_G][2], thr1[IDX_G][2]; bf16x8 rb[IDX_RING][2];
            const int qsel = 2 * ((r32 >> 2) & 1) + ((r32 >> 4) & 1), head = (r32 & 3) + 4 * ((r32 >> 3) & 1);
            const float mk = sqrtf(__uint_as_float(maxik[b])) * 1.001f;
#pragma unroll
            for (int g = 0; g < IDX_G; ++g) { const bf16_t* ar = IQ + (kb + t0 + 4 * g + qsel) * 256 + head * 32 + 8 * hi; A[g][0] = *(const bf16x8*)ar; A[g][1] = *(const bf16x8*)(ar + 16);
#pragma unroll
                for (int j = 0; j < 2; ++j) { const int ql = 4 * g + 2 * hi + j; const f32x4 w0 = *(const f32x4*)(IW + (kb + t0 + ql) * 8), w1 = *(const f32x4*)(IW + (kb + t0 + ql) * 8 + 4);
                    w[g][8 * j + 0] = w0.x; w[g][8 * j + 1] = w0.y; w[g][8 * j + 2] = w0.z; w[g][8 * j + 3] = w0.w; w[g][8 * j + 4] = w1.x; w[g][8 * j + 5] = w1.y; w[g][8 * j + 6] = w1.z; w[g][8 * j + 7] = w1.w;
                    scq[g][j] = (float)(IDX_ZOOM * (IDX_NB / 2)) / (PR[kb + t0 + ql] * mk + 1e-30f); thr[g][j] = -1.f; thr1[g][j] = 0.f; } }
            idx_ring_fill(rb, IK + kb * 32, NTP, wave, lane1);
            __syncthreads();
            idx_pass<1, MODE>(c.lds, IK + kb * 32, rb, A, w, scq, thr, thr1, t0, NTP, wave, lane1);
            __syncthreads();
#pragma unroll 1
            for (int qq = 0; qq < 2; ++qq) { const int ql = 2 * wave + qq;
                if (t0 + ql + 1 > TOPK) {
                    const LAS u32x4* hq = (const LAS u32x4*)(c.lds + IL_HIST + ql * 4096) + 4 * lane; unsigned wv[16]; unsigned tot = 0;
#pragma unroll
                    for (int i = 0; i < 4; ++i) { const u32x4 x = hq[i]; wv[4 * i] = x.x; wv[4 * i + 1] = x.y; wv[4 * i + 2] = x.z; wv[4 * i + 3] = x.w; }
#pragma unroll
                    for (int i = 0; i < 16; ++i) tot += (wv[i] & 0xffffu) + (wv[i] >> 16);
                    const unsigned pre = wave_incl_scan(tot), totw = (unsigned)__builtin_amdgcn_readlane((int)pre, 63);
                    const unsigned suf = totw - pre + tot;
                    unsigned above = suf - tot;
                    if (above < (unsigned)TOPK && (unsigned)TOPK <= suf) { bool done = false;
#pragma unroll
                        for (int i = 15; i >= 0; --i)
#pragma unroll
                            for (int hf = 1; hf >= 0; --hf) { const unsigned cn = hf ? (wv[i] >> 16) : (wv[i] & 0xffffu);
                                if (!done) { if ((unsigned)TOPK <= above + cn) { qi[ql * 8 + 1] = 2 * (16 * lane + i) + hf; qi[ql * 8 + 2] = TOPK - (int)above; done = true; } else above += cn; } } }
                } }
            __syncthreads();
#pragma unroll
            for (int g = 0; g < IDX_G; ++g)
#pragma unroll
                for (int j = 0; j < 2; ++j) { const int tb = qi[(4 * g + 2 * hi + j) * 8 + 1]; const float tf = (float)tb; thr[g][j] = (tb <= 0) ? -INFINITY : tf; thr1[g][j] = (tb < 0) ? -INFINITY : ((tb >= IDX_NB - 1) ? INFINITY : tf + 1.f); }
            if (!(MODE & 8)) idx_pass<2, MODE>(c.lds, IK + kb * 32, rb, A, w, scq, thr, thr1, t0, NTP, wave, lane1);
            __syncthreads();
#pragma unroll 1
            for (int qq = 0; qq < 2; ++qq) { const int ql = 2 * wave + qq; const int cn = qi[ql * 8 + 3], need = qi[ql * 8 + 2];
                if (cn > IDX_CAP) { if (lane == 0) qi[ql * 8 + 4] = 1; }
                else { const LAS u32x2* cd = (const LAS u32x2*)(c.lds + IL_HIST) + ql * 256; LAS unsigned* mq = (LAS unsigned*)(c.lds + IL_MASK) + ql * 256;
                    for (int i0 = 0; i0 < cn; i0 += 64) { const int i = i0 + lane; const u32x2 me = cd[i < cn ? i : 0]; const float ms = __uint_as_float(me.x); int rank = 0;
                        for (int j = 0; j < cn; ++j) { const u32x2 ot = cd[j]; const float os = __uint_as_float(ot.x); rank += (os > ms || (os == ms && ot.y < me.y)) ? 1 : 0; }
                        if (i < cn && rank < need) __hip_atomic_fetch_or(mq + (me.y >> 5), 1u << (me.y & 31u), __ATOMIC_RELAXED, __HIP_MEMORY_SCOPE_WORKGROUP); } } }
            __syncthreads();
#pragma unroll 1
            for (int ql = 0; ql < IDX_QB; ++ql) if (qi[ql * 8 + 4] != 0) idx_fallback(c, IQ, IK, IW, kb, t0 + ql, ql);
        } else {
            __syncthreads();
            LAS unsigned* mask = (LAS unsigned*)(c.lds + IL_MASK);
            for (int i = tid; i < IDX_QB * NT; i += NTHREADS) { const int ql = i / NT, kt = i % NT; const int hi_key = t0 + ql - 32 * kt;
                mask[ql * 256 + kt] = hi_key < 0 ? 0u : (hi_key >= 31 ? 0xffffffffu : ((2u << hi_key) - 1u)); }
            __syncthreads();
        }
        if (!(MODE & 1)) {
#pragma unroll 1
            for (int qq = 0; qq < 2; ++qq) { int lane2 = lane; asm volatile("" : "+v"(lane2)); idx_attend(c.lds, QN, KN, VB, YO, kb, t0 + 2 * wave + qq, 2 * wave + qq, NT, wave, lane2); } }
    }
}

struct EpiD1 {
    EPI_COMMON_P
    const bf16_t* gates; const float* bc; bf16_t* Mo;
    __device__ __forceinline__ void half(const f32x4 (&acc)[2][4][2], int ai, const GUnit& u, int wr, int wc, int fr, int fq) const {
        const int which = u.aux;
#pragma unroll
        for (int m = 0; m < 4; ++m) { const size_t row = (size_t)u.row0 + 128 * ai + 64 * wr + 16 * m + fr;
#pragma unroll
            for (int bj = 0; bj < 2; ++bj) { const int col = 256 * u.pn + 128 * bj + 32 * wc + 8 * fq;
                const u32x4 gw = *(const u32x4*)(gates + row * 2048 + which * 1024 + col);
                const f32x4 g0 = {bflo(gw.x), bfhi(gw.x), bflo(gw.y), bfhi(gw.y)}, g1 = {bflo(gw.z), bfhi(gw.z), bflo(gw.w), bfhi(gw.w)}; f32x4 o0, o1;
                if (which == 0) { o0 = g0 * (acc[bj][m][0] + *(const f32x4*)(bc + col)); o1 = g1 * (acc[bj][m][1] + *(const f32x4*)(bc + col + 4)); }
                else { const u32x4 pw = *(const u32x4*)(Mo + row * 1024 + col);
                    o0 = (f32x4){bflo(pw.x), bfhi(pw.x), bflo(pw.y), bfhi(pw.y)} + g0 * acc[bj][m][0]; o1 = (f32x4){bflo(pw.z), bfhi(pw.z), bflo(pw.w), bfhi(pw.w)} + g1 * acc[bj][m][1]; }
                *(u32x4*)(Mo + row * 1024 + col) = pack8(o0, o1); } }
    }
};
struct SchedD1 { static constexpr int A_AUX = 0; const char* A; const char* B; int G, c;
    __device__ __forceinline__ bool next(int i, GUnit& u) const { const int Lq = (i >> 1) * G + c, which = i & 1; if (Lq >= 64 * 4) return false; int pm, pn; pg8::tile_order(Lq, 64, 4, pm, pn);
        u.pm = pm; u.pn = pn; u.aux = which; u.row0 = pm * 256; u.rows = nullptr; u.A = A + ((size_t)pm * 256 * 1024 + which * 512) * 2; u.B = B + ((size_t)pn * 256 * 1024 + which * 512) * 2; return true; }
    __device__ __forceinline__ void a_ready(const GUnit&) const {}
    __device__ __forceinline__ void done(const GUnit&) const {}
};
__device__ __forceinline__ void phase_gemm_d1(const Ctx& c, int l) {
    SchedD1 S{(const char*)(c.ws + WS_YO), (const char*)(c.ws + WS_WCA) + (size_t)l * D * D * 2, c.nb, c.bid};
    EpiD1 E{(const bf16_t*)(c.ws + WS_GATES), c.in[13] + l * D, (bf16_t*)(c.ws + WS_H)};
    pg8::gemm_phase<EpiD1, SchedD1, true, true>(c.lds, pg8::Gemm{1024, 1024, opaque_u(512), T}, S, E, c.tid);
}
template <bool XBF>
struct EpiD2 {
    EPI_COMMON_P
    const void* xin; bf16_t* xout; const float* gate;
    __device__ __forceinline__ void half(const f32x4 (&acc)[2][4][2], int ai, const GUnit& u, int wr, int wc, int fr, int fq) const {
        const float* gb = gate + (u.row0 / L) * 6144;
#pragma unroll
        for (int m = 0; m < 4; ++m) { const size_t row = (size_t)u.row0 + 128 * ai + 64 * wr + 16 * m + fr;
#pragma unroll
            for (int bj = 0; bj < 2; ++bj) { const int col = 256 * u.pn + 128 * bj + 32 * wc + 8 * fq; f32x4 x0, x1;
                if (XBF) { const u32x4 xw = *(const u32x4*)((const bf16_t*)xin + row * D + col); x0 = (f32x4){bflo(xw.x), bfhi(xw.x), bflo(xw.y), bfhi(xw.y)}; x1 = (f32x4){bflo(xw.z), bfhi(xw.z), bflo(xw.w), bfhi(xw.w)}; }
                else { x0 = *(const f32x4*)((const float*)xin + row * D + col); x1 = *(const f32x4*)((const float*)xin + row * D + col + 4); }
                const f32x4 g0 = *(const f32x4*)(gb + col), g1 = *(const f32x4*)(gb + col + 4);
                *(u32x4*)(xout + row * D + col) = pack8(x0 + g0 * acc[bj][m][0], x1 + g1 * acc[bj][m][1]); } }
    }
};
struct SchedD2 { static constexpr int A_AUX = 0; const char* A; const char* B; int G, c;
    __device__ __forceinline__ bool next(int i, GUnit& u) const { const int Lq = i * G + c; if (Lq >= 64 * 4) return false; int pm, pn; pg8::tile_order(Lq, 64, 4, pm, pn);
        u.pm = pm; u.pn = pn; u.aux = 0; u.row0 = pm * 256; u.rows = nullptr; u.A = A + (size_t)pm * 256 * D * 2; u.B = B + (size_t)pn * 256 * D * 2; return true; }
    __device__ __forceinline__ void a_ready(const GUnit&) const {}
    __device__ __forceinline__ void done(const GUnit&) const {}
};
__device__ __forceinline__ void phase_gemm_d2(const Ctx& c, int l) {
    SchedD2 S{(const char*)(c.ws + WS_H), (const char*)(c.ws + WS_WO) + (size_t)l * D * D * 2, c.nb, c.bid};
    const float* gate = (const float*)(c.ws + WS_CTL + CTL_MOD) + (l * 2) * 6144 + 2 * D; bf16_t* X1 = (bf16_t*)(c.ws + WS_X1);
    if (l == 0) { EpiD2<false> E{c.in[0], X1, gate}; pg8::gemm_phase<EpiD2<false>, SchedD2, true, true>(c.lds, pg8::Gemm{D, D, opaque_u(D), T}, S, E, c.tid); }
    else { EpiD2<true> E{c.out, X1, gate}; pg8::gemm_phase<EpiD2<true>, SchedD2, true, true>(c.lds, pg8::Gemm{D, D, opaque_u(D), T}, S, E, c.tid); }
}

constexpr int RT_ROWE = 1032, RT_WLO = 36 * RT_ROWE * 2, RT_LG = 2 * RT_WLO;
template <bool DRY>
__device__ __forceinline__ void phase_norm2_route(const Ctx& c, int l) {
    const float* wg = c.in[17] + (size_t)l * D * NG; const float* wrt = c.in[19] + (size_t)l * D * NE;
    LAS bf16_t* Whi = (LAS bf16_t*)c.lds; LAS bf16_t* Wlo = (LAS bf16_t*)(c.lds + RT_WLO);
    for (int i = c.tid; i < D * NG; i += NTHREADS) { const float w = wg[i]; const unsigned h = f2bf(w); Whi[(i % NG) * RT_ROWE + i / NG] = (bf16_t)h; Wlo[(i % NG) * RT_ROWE + i / NG] = (bf16_t)f2bf(w - __uint_as_float(h << 16)); }
    for (int i = c.tid; i < D * NE; i += NTHREADS) { const float w = wrt[i]; const unsigned h = f2bf(w); Whi[(4 + i % NE) * RT_ROWE + i / NE] = (bf16_t)h; Wlo[(4 + i % NE) * RT_ROWE + i / NE] = (bf16_t)f2bf(w - __uint_as_float(h << 16)); }
    LAS int* lcnt = (LAS int*)(c.lds + RT_LG + 12288 + 128); LAS int* gbase = lcnt + 64;
    if (c.tid < NE) lcnt[c.tid] = 0;
    __syncthreads();
    const int lane = c.lane, wave = c.wave, tk = lane & 7, fr = lane & 15, fq = lane >> 4;
    const float* mod = (const float*)(c.ws + WS_CTL + CTL_MOD); const float* g2 = c.in[16] + l * D;
    int* cnt = (int*)(c.ws + WS_CTL + CTL_CNT) + l * NE; bf16_t* H2 = (bf16_t*)(c.ws + WS_H2);
    i32x4* rt = (i32x4*)(c.ws + WS_ROUTE); f32x2* rw = (f32x2*)(c.ws + WS_ROUTE + 512 * 1024); int* inv = (int*)(c.ws + WS_INV);
    const float* bg = c.in[18] + l * NG; const float* br = c.in[20] + l * NE;
    LAS float* LG = (LAS float*)(c.lds + RT_LG) + wave * (8 * 48);
    for (int m0 = c.bid * 64; m0 < T; m0 += c.nb * 64) {
        const int m = m0 + 8 * wave + tk; const float* mb = mod + (l * 2 + m0 / L) * 6144; const bf16_t* xr = (const bf16_t*)(c.ws + WS_X1) + (size_t)m * D + 8 * fq;
        float ssq = 0.f;
#pragma unroll
        for (int ch = 0; ch < 2; ++ch) { u32x4 xw[16];
#pragma unroll
            for (int s8 = 0; s8 < 16; ++s8) xw[s8] = *(const u32x4*)(xr + 32 * (16 * ch + s8));
#pragma unroll
            for (int s8 = 0; s8 < 16; ++s8) { const f32x4 xa = {bflo(xw[s8].x), bfhi(xw[s8].x), bflo(xw[s8].y), bfhi(xw[s8].y)}, xb = {bflo(xw[s8].z), bfhi(xw[s8].z), bflo(xw[s8].w), bfhi(xw[s8].w)};
                ssq += (xa.x * xa.x + xa.y * xa.y) + (xa.z * xa.z + xa.w * xa.w) + (xb.x * xb.x + xb.y * xb.y) + (xb.z * xb.z + xb.w * xb.w); } }
        ssq += xor16_f(ssq); ssq = sum_x32(ssq);
        const float rstd = __builtin_amdgcn_rsqf(ssq * (1.f / D) + EPS);
        f32x4 acc[3];
#pragma unroll
        for (int n = 0; n < 3; ++n) acc[n] = (f32x4){0.f, 0.f, 0.f, 0.f};
        const int wrow[3] = {fr, 16 + fr, (32 + fr) < 36 ? 32 + fr : 35};
#pragma unroll 2
        for (int s = 0; s < 32; ++s) { const int k0 = 32 * s + 8 * fq;
            const u32x4 xw = *(const u32x4*)(xr + 32 * s); const f32x4 x0 = {bflo(xw.x), bfhi(xw.x), bflo(xw.y), bfhi(xw.y)}, x1 = {bflo(xw.z), bfhi(xw.z), bflo(xw.w), bfhi(xw.w)};
            const f32x4 ga = *(const f32x4*)(g2 + k0), gb = *(const f32x4*)(g2 + k0 + 4), sa = *(const f32x4*)(mb + 4 * D + k0), sb = *(const f32x4*)(mb + 4 * D + k0 + 4), ha = *(const f32x4*)(mb + 3 * D + k0), hb = *(const f32x4*)(mb + 3 * D + k0 + 4);
            const f32x4 h0 = x0 * rstd * ga * (sa + 1.f) + ha, h1 = x1 * rstd * gb * (sb + 1.f) + hb;
            const u32x4 hi4 = {pk2(h0.x, h0.y), pk2(h0.z, h0.w), pk2(h1.x, h1.y), pk2(h1.z, h1.w)};
            const f32x4 l0 = h0 - (f32x4){bflo(hi4.x), bfhi(hi4.x), bflo(hi4.y), bfhi(hi4.y)}, l1 = h1 - (f32x4){bflo(hi4.z), bfhi(hi4.z), bflo(hi4.w), bfhi(hi4.w)};
            const u32x4 lo4 = {pk2(l0.x, l0.y), pk2(l0.z, l0.w), pk2(l1.x, l1.y), pk2(l1.z, l1.w)};
            if (!DRY && fr < 8) *(u32x4*)(H2 + (size_t)m * D + k0) = hi4;
            const bf16x8 ahi = __builtin_bit_cast(bf16x8, hi4), alo = __builtin_bit_cast(bf16x8, lo4);
#pragma unroll
            for (int n = 0; n < 3; ++n) { const bf16x8 bhi = *(const LAS bf16x8*)(Whi + wrow[n] * RT_ROWE + k0), blo = *(const LAS bf16x8*)(Wlo + wrow[n] * RT_ROWE + k0);
                acc[n] = __builtin_amdgcn_mfma_f32_16x16x32_bf16(ahi, bhi, acc[n], 0, 0, 0);
                acc[n] = __builtin_amdgcn_mfma_f32_16x16x32_bf16(ahi, blo, acc[n], 0, 0, 0);
                acc[n] = __builtin_amdgcn_mfma_f32_16x16x32_bf16(alo, bhi, acc[n], 0, 0, 0); } }
        if (fq < 2) {
#pragma unroll
            for (int n = 0; n < 3; ++n)
#pragma unroll
                for (int i = 0; i < 4; ++i) LG[(4 * fq + i) * 48 + 16 * n + fr] = acc[n][i]; }
        asm volatile("s_waitcnt lgkmcnt(0)" ::: "memory");
        int ea = 0, eb = 0, la = 0, lb = 0; float wa = 0.f, wb = 0.f;
        if (lane < 8) { const LAS f32x4* lg4 = (const LAS f32x4*)(LG + lane * 48);
            const f32x4 g4 = lg4[0];
            float gl[4] = {g4.x + bg[0], g4.y + bg[1], g4.z + bg[2], g4.w + bg[3]}; int gs = 0; float gm = gl[0];
#pragma unroll
            for (int g = 1; g < 4; ++g) if (gl[g] > gm) { gm = gl[g]; gs = g; }
            float gsum = 0.f;
#pragma unroll
            for (int g = 0; g < 4; ++g) gsum += __expf(gl[g] - gm);
            const float pg = __builtin_amdgcn_rcpf(gsum);
            const f32x4 ea4 = lg4[1 + 2 * gs], eb4 = lg4[2 + 2 * gs]; const f32x4 ba4 = *(const f32x4*)(br + 8 * gs), bb4 = *(const f32x4*)(br + 8 * gs + 4);
            const float ev[8] = {ea4.x + ba4.x, ea4.y + ba4.y, ea4.z + ba4.z, ea4.w + ba4.w, eb4.x + bb4.x, eb4.y + bb4.y, eb4.z + bb4.z, eb4.w + bb4.w};
            int i1 = 0; float v1 = ev[0];
#pragma unroll
            for (int e = 1; e < 8; ++e) if (ev[e] > v1) { v1 = ev[e]; i1 = e; }
            int i2 = -1; float v2 = -INFINITY;
#pragma unroll
            for (int e = 0; e < 8; ++e) { if (e != i1 && (i2 < 0 || ev[e] > v2)) { i2 = e; v2 = ev[e]; } }
            const float e2 = __expf(v2 - v1), p1 = __builtin_amdgcn_rcpf(1.f + e2), p2 = e2 * p1;
            if (DRY) { asm volatile("" :: "v"(pg * p1), "v"(pg * p2), "v"(gs * 8 + i1), "v"(gs * 8 + i2)); }
            else { ea = gs * 8 + i1; eb = gs * 8 + i2; wa = pg * p1; wb = pg * p2; la = lds_addi(lcnt + ea, 1); lb = lds_addi(lcnt + eb, 1); } }
        if (!DRY) {
            __syncthreads();
            if (c.tid < NE) { const int n = lcnt[c.tid]; gbase[c.tid] = n ? atomicAdd(cnt + c.tid, n) : 0; }
            __syncthreads();
            if (lane < 8) { const int mt = m0 + 8 * wave + lane; const int ra = gbase[ea] + la, rb = gbase[eb] + lb;
                rt[mt] = (i32x4){ea, ra, eb, rb}; rw[mt] = (f32x2){wa, wb}; inv[(size_t)ea * T + ra] = mt; inv[(size_t)eb * T + rb] = mt; }
            __syncthreads();
            if (c.tid < NE) lcnt[c.tid] = 0;
            __syncthreads();
        }
    }
}
__device__ __forceinline__ void expert_bases(const int* cnt, LAS int* base  , int tid) {
    if (tid < 64) {
        const int n = (tid < NE) ? cnt[tid] : 0, nt_ = (n + 255) >> 8; const int incl = (int)wave_incl_scan((unsigned)nt_), start = incl - nt_;
        if (tid < NE) { base[tid] = start << 8; for (int i = 0; i < nt_; ++i) base[40 + start + i] = tid; }
        if (tid == NE - 1) base[NE] = incl << 8; }
    __syncthreads();
}
__device__ __forceinline__ void phase_scatter(const Ctx& c, int l) {
    LAS int* base = (LAS int*)(c.lds + 131072); const int* cnt = (const int*)(c.ws + WS_CTL + CTL_CNT) + l * NE;
    expert_bases(cnt, base, c.tid);
    const i32x4* rt = (const i32x4*)(c.ws + WS_ROUTE); int* slots = (int*)(c.ws + WS_ROUTE + 768 * 1024); int* rowl = (int*)(c.ws + WS_ROWL);
    for (int m = c.bid * NTHREADS + c.tid; m < T; m += c.nb * NTHREADS) { const i32x4 r = rt[m]; const int s1 = base[r.x] + r.y, s2 = base[r.z] + r.w;
        slots[2 * m] = s1; slots[2 * m + 1] = s2; rowl[s1] = m; rowl[s2] = m; }
    for (int e = c.bid; e < NE; e += c.nb) for (int sidx = base[e] + cnt[e] + c.tid; sidx < base[e + 1]; sidx += NTHREADS) rowl[sidx] = -1;
}
struct EpiMoe1 {
    EPI_COMMON_P
    bf16_t* hid;
    __device__ __forceinline__ void half(const f32x4 (&acc)[2][4][2], int ai, const GUnit& u, int wr, int wc, int fr, int fq) const {
#pragma unroll
        for (int m = 0; m < 4; ++m) { const size_t row = (size_t)u.row0 + 128 * ai + 64 * wr + 16 * m + fr; f32x4 o[2];
#pragma unroll
            for (int n = 0; n < 2; ++n)
#pragma unroll
                for (int i = 0; i < 4; ++i) o[n][i] = siluf_(acc[0][m][n][i]) * acc[1][m][n][i];
            st16_wt(hid, (unsigned)(row * DE + 128 * u.pn + 32 * wc + 8 * fq) * 2u, pack8(o[0], o[1])); }
    }
};
struct EpiMoe2 {
    EPI_COMMON_P
    bf16_t* ys;
    __device__ __forceinline__ void half(const f32x4 (&acc)[2][4][2], int ai, const GUnit& u, int wr, int wc, int fr, int fq) const {
#pragma unroll
        for (int m = 0; m < 4; ++m) { const size_t row = (size_t)u.row0 + 128 * ai + 64 * wr + 16 * m + fr;
#pragma unroll
            for (int bj = 0; bj < 2; ++bj) *(u32x4*)(ys + row * D + 256 * u.pn + 128 * bj + 32 * wc + 8 * fq) = pack8(acc[bj][m][0], acc[bj][m][1]); }
    }
};
__device__ __forceinline__ int tile_expert(const LAS int* base, int rt) { return __builtin_amdgcn_readfirstlane(base[40 + rt]); }
__device__ __forceinline__ void seam_wait(unsigned* f, unsigned target) {
    unsigned sp = 0;
    while (__hip_atomic_load(f, __ATOMIC_RELAXED, __HIP_MEMORY_SCOPE_AGENT) < target) { __builtin_amdgcn_s_sleep(2); if (++sp > (1u << 20)) break; }
    asm volatile("" ::: "memory");
}
struct SchedMoe1 { static constexpr int A_AUX = 0; const char* A; const char* B; const int* rowl; const LAS int* base; unsigned* flag; int nunit, G, c;
    __device__ __forceinline__ bool next(int i, GUnit& u) const { const int Lq = i * G + c; if (Lq >= nunit) return false; const int rt = Lq >> 1, j = Lq & 1, e = tile_expert(base, rt);
        u.pm = rt; u.pn = j; u.aux = e; u.row0 = rt * 256; u.rows = rowl + (size_t)e * T + (rt * 256 - __builtin_amdgcn_readfirstlane(base[e])); u.A = A; u.B = B + ((size_t)e * 512 + 256 * j) * D * 2; return true; }
    __device__ __forceinline__ void a_ready(const GUnit&) const {}
    __device__ __forceinline__ void done(const GUnit& u) const {
        asm volatile("s_waitcnt vmcnt(0)" ::: "memory");
        if ((threadIdx.x & 63) == 0) __hip_atomic_fetch_add(flag + u.pm * 16, 1u, __ATOMIC_RELAXED, __HIP_MEMORY_SCOPE_AGENT); }
};
struct SchedMoe2 { static constexpr int A_AUX = 16; const char* A; const char* B; const LAS int* base; unsigned* flag; int nunit, G, c, heavy;
    __device__ __forceinline__ bool next(int i, GUnit& u) const { if (c < heavy) return false; const int Lq = i * (G - heavy) + (c - heavy); if (Lq >= nunit) return false; const int rt = Lq >> 2, pn = Lq & 3, e = tile_expert(base, rt);
        u.pm = rt; u.pn = pn; u.aux = e; u.row0 = rt * 256; u.rows = nullptr; u.A = A + (size_t)rt * 256 * DE * 2; u.B = B + ((size_t)e * D + 256 * pn) * DE * 2; return true; }
    __device__ __forceinline__ void a_ready(const GUnit& u) const { seam_wait(flag + u.pm * 16, 16u); }
    __device__ __forceinline__ void done(const GUnit&) const {}
};
__device__ __forceinline__ void phase_moe(const Ctx& c, int l) {
    LAS int* base = (LAS int*)(c.lds + 131072); const int* cnt = (const int*)(c.ws + WS_CTL + CTL_CNT) + l * NE;
    expert_bases(cnt, base, c.tid);
    unsigned* flag = (unsigned*)(c.ws + WS_CTL + CTL_MFLAG) + l * 4096;
    const int ntile = __builtin_amdgcn_readfirstlane(base[NE] / 256), n1 = 2 * ntile, heavy = (n1 > c.nb) ? ((n1 - c.nb < c.nb / 2) ? n1 - c.nb : c.nb / 2) : 0;
    { SchedMoe1 S{(const char*)(c.ws + WS_H2), (const char*)(c.ws + WS_WGU), (const int*)(c.ws + WS_INV), base, flag, n1, c.nb, c.bid};
      EpiMoe1 E{(bf16_t*)(c.ws + WS_HID)};
      pg8::gemm_phase<EpiMoe1, SchedMoe1, true, true, true>(c.lds, pg8::Gemm{D, D, opaque_u(D), T}, S, E, c.tid); }
    { SchedMoe2 S{(const char*)(c.ws + WS_HID), (const char*)(c.ws + WS_WD), base, flag, 4 * ntile, c.nb, c.bid, heavy};
      EpiMoe2 E{(bf16_t*)(c.ws + WS_YS)};
      pg8::gemm_phase<EpiMoe2, SchedMoe2, true, true>(c.lds, pg8::Gemm{DE, DE, opaque_u(DE), MAXSLOT}, S, E, c.tid); }
}
template <bool DRY>
__device__ __forceinline__ void phase_combine(const Ctx& c, int l) {
    const int gw = c.bid * NWAVES + c.wave, NGW = c.nb * NWAVES, lane = c.lane;
    const float* mod = (const float*)(c.ws + WS_CTL + CTL_MOD);
    const bf16_t* YS = (const bf16_t*)(c.ws + WS_YS); const i32x4* rt = (const i32x4*)(c.ws + WS_ROUTE); const f32x2* rw = (const f32x2*)(c.ws + WS_ROUTE + 512 * 1024);
    LAS int* base = (LAS int*)(c.lds + 131072); expert_bases((const int*)(c.ws + WS_CTL + CTL_CNT) + l * NE, base, c.tid);
    bf16_t* H = (bf16_t*)(c.ws + WS_H); const bf16_t* X1 = (const bf16_t*)(c.ws + WS_X1);
    for (int m0 = gw; m0 < T; m0 += 4 * NGW) {
        int s1[4], s2[4]; f32x2 w[4]; u32x2 xv[4][4]; u32x2 y1[4][4], y2[4][4];
#pragma unroll
        for (int i = 0; i < 4; ++i) { const int m = (m0 + i * NGW < T) ? m0 + i * NGW : m0; { const i32x4 r = rt[m]; s1[i] = base[r.x] + r.y; s2[i] = base[r.z] + r.w; } w[i] = rw[m];
#pragma unroll
            for (int j = 0; j < 4; ++j) xv[i][j] = *(const u32x2*)(X1 + (size_t)m * D + 4 * lane + 256 * j); }
#pragma unroll
        for (int i = 0; i < 4; ++i)
#pragma unroll
            for (int j = 0; j < 4; ++j) { y1[i][j] = *(const u32x2*)(YS + (size_t)s1[i] * D + 4 * lane + 256 * j); y2[i][j] = *(const u32x2*)(YS + (size_t)s2[i] * D + 4 * lane + 256 * j); }
#pragma unroll
        for (int i = 0; i < 4; ++i) { const int m = m0 + i * NGW; if (m < T) { const int b = m / L; const float* mb = mod + (l * 2 + b) * 6144;
            f32x4 v[4];
#pragma unroll
            for (int j = 0; j < 4; ++j) { const int col = 4 * lane + 256 * j; const f32x4 gv = *(const f32x4*)(mb + 5 * D + col);
                v[j] = unpack4(xv[i][j]) + gv * (unpack4(y1[i][j]) * w[i].x + unpack4(y2[i][j]) * w[i].y);
                if (DRY) { asm volatile("" :: "v"(v[j])); } else if (l == 0) *(u32x2*)((bf16_t*)c.out + (size_t)m * D + col) = pack4(v[j]); else *(f32x4*)(c.out + (size_t)m * D + col) = v[j]; }
            if (l == 0 && !DRY) { const float* m1 = mod + (2 + b) * 6144; norm_row_store(v, c.in[4] + D, m1, m1 + D, H + (size_t)m * D, lane); } } }
    }
    if (l == 0) { LAS float* scr = (LAS float*)(c.lds + c.wave * 8704); convert_items<1>(c, 1, gw, NGW, IT_MOE, scr); }
}

__device__ __forceinline__ void phase_valutest(const Ctx& c) {
    float a[8];
#pragma unroll
    for (int i = 0; i < 8; ++i) a[i] = (float)(c.lane + i);
    const float m = 1.0000001f, b = 1e-9f;
#pragma unroll 1
    for (int it = 0; it < 4096; ++it) {
#pragma unroll
        for (int i = 0; i < 8; ++i) a[i] = fmaf(a[i], m, b);
        asm volatile("" : "+v"(a[0]), "+v"(a[1]), "+v"(a[2]), "+v"(a[3]), "+v"(a[4]), "+v"(a[5]), "+v"(a[6]), "+v"(a[7]));
    }
    float s = 0.f;
#pragma unroll
    for (int i = 0; i < 8; ++i) s += a[i];
    if (s == 12345.678f) ((float*)(c.ws + WS_XS))[c.tid] = s;
}
template <int TB>
__device__ __forceinline__ void phase_memtest(const Ctx& c) {
    const int gw = c.bid * NWAVES + c.wave, NGW = c.nb * NWAVES;
    float* dst = (float*)(c.ws + WS_XS);
    for (int m0 = gw; m0 < T; m0 += TB * NGW) {
        f32x4 v[TB][4];
#pragma unroll
        for (int i = 0; i < TB; ++i) { const int m = (m0 + i * NGW < T) ? m0 + i * NGW : m0;
#pragma unroll
            for (int j = 0; j < 4; ++j) v[i][j] = *(const f32x4*)(c.out + (size_t)m * D + 4 * c.lane + 256 * j); }
#pragma unroll
        for (int i = 0; i < TB; ++i) { const int m = m0 + i * NGW; if (m < T) {
#pragma unroll
            for (int j = 0; j < 4; ++j) *(f32x4*)(dst + (size_t)m * D + 4 * c.lane + 256 * j) = v[i][j]; } }
    }
}

#define XB_TMO      128
#define XB_XCNT(j)  (256  + 64 * (j))
#define XB_XSUB(j)  (1280 + 64 * (j))
#define XB_XGEN(j)  (2304 + 64 * (j))
#define XB_TOP      3328
#define XB_TOPGEN   3392
#define XCD_BAR_WORDS 3456
#define XB_SPIN_CAP (1u << 18)

__device__ __forceinline__ unsigned xb_ld(unsigned* p)              { return __hip_atomic_load(p, __ATOMIC_RELAXED, __HIP_MEMORY_SCOPE_AGENT); }
__device__ __forceinline__ unsigned xb_add(unsigned* p, unsigned v) { return __hip_atomic_fetch_add(p, v, __ATOMIC_RELAXED, __HIP_MEMORY_SCOPE_AGENT); }
__device__ __forceinline__ unsigned xb_xcc_id() { return (unsigned)__builtin_amdgcn_s_getreg((3 << 11) | 20) & 0xFu; }
#define XB_SPIN(cond, bar) do { unsigned _sp = 0; while (cond) { __builtin_amdgcn_s_sleep(1); \
    if ((++_sp & 255u) == 0u) { if (xb_ld(&(bar)[XB_TMO])) break; if (_sp > XB_SPIN_CAP) { atomicAdd(&(bar)[XB_TMO], 1u); break; } } } } while (0)

struct XcdBarrier {
    unsigned* bar; unsigned x;
    volatile LAS unsigned* st;
};

__device__ __forceinline__ XcdBarrier xcd_barrier_post(unsigned* bar, volatile LAS unsigned* st) {
    XcdBarrier b; b.bar = bar; b.x = xb_xcc_id(); b.st = st;
    if (threadIdx.x == 0) (void)xb_add(&bar[XB_XCNT(b.x)], 1u);
    return b;
}
__device__ __forceinline__ void xcd_barrier_complete(unsigned* bar, unsigned x, unsigned& nloc, unsigned& nx) {
    const unsigned G = gridDim.x * gridDim.y * gridDim.z;
    unsigned sum, cnt, mine, sp = 0u;
    for (;;) {
        sum = 0u; cnt = 0u; mine = 0u;
#pragma unroll
        for (unsigned j = 0; j < 16; ++j) { const unsigned c = xb_ld(&bar[XB_XCNT(j)]); sum += c; cnt += (c > 0u) ? 1u : 0u; mine = (j == x) ? c : mine; }
        if (sum == G) break;
        __builtin_amdgcn_s_sleep(1);
        if ((++sp & 255u) == 0u) { if (xb_ld(&bar[XB_TMO])) break; if (sp > XB_SPIN_CAP) { atomicAdd(&bar[XB_TMO], 1u); break; } }
    }
    nloc = mine > 0u ? mine : 1u; nx = cnt > 0u ? cnt : 1u;
}

__device__ __forceinline__ void xcd_barrier(const XcdBarrier& b, bool leader_thread) {
    asm volatile("s_waitcnt vmcnt(0)" ::: "memory");
    __syncthreads();
    if (leader_thread) {
        unsigned* bar = b.bar;
        __builtin_amdgcn_s_waitcnt(0);
        unsigned nloc = b.st[0], nx = b.st[1];
        if (nloc == 0u) { xcd_barrier_complete(bar, b.x, nloc, nx); b.st[0] = nloc; b.st[1] = nx; }
        const unsigned old = xb_add(&bar[XB_XSUB(b.x)], 1u);
        const unsigned gen = old / nloc;
        if (old + 1u == (gen + 1u) * nloc) {
            __builtin_amdgcn_fence(__ATOMIC_RELEASE, "agent");
            asm volatile("s_waitcnt vmcnt(0)" ::: "memory");
            const unsigned og = xb_add(&bar[XB_TOP], 1u);
            const unsigned tg = og / nx;
            if (og + 1u == (tg + 1u) * nx) xb_add(&bar[XB_TOPGEN], 1u);
            else XB_SPIN(xb_ld(&bar[XB_TOPGEN]) == tg, bar);
            __builtin_amdgcn_fence(__ATOMIC_ACQUIRE, "agent");
            xb_add(&bar[XB_XGEN(b.x)], 1u);
            asm volatile("s_waitcnt vmcnt(0)" ::: "memory");
        } else {
            XB_SPIN(xb_ld(&bar[XB_XGEN(b.x)]) == gen, bar);
            __builtin_amdgcn_fence(__ATOMIC_ACQUIRE, "agent");
            asm volatile("s_waitcnt vmcnt(0)" ::: "memory");
        }
    }
    __syncthreads();
}

__global__ void __launch_bounds__(NTHREADS, 2) __attribute__((amdgpu_waves_per_eu(2, 2))) mega(Params p) {
    extern __shared__ __attribute__((aligned(16))) unsigned char lds[];
    Ctx c; c.in = p.in; c.out = p.out; c.ws = p.ws; c.lds = (LAS unsigned char*)lds;
    c.tid = threadIdx.x; c.lane = c.tid & 63; c.wave = __builtin_amdgcn_readfirstlane(c.tid >> 6); c.bid = blockIdx.x; c.nb = gridDim.x;
    const int lo = p.ph_lo, hi = p.ph_hi;
#if ONE_LAUNCH
    volatile LAS unsigned* bmisc = (volatile LAS unsigned*)(c.lds + LDS_BYTES - 64);
    if (c.tid < 16) bmisc[c.tid] = 0u;
    __syncthreads();
    const XcdBarrier bar = xcd_barrier_post((unsigned*)(p.ws + WS_CTL + CTL_BAR), bmisc);
#define SEAM(k) do { if ((k) + 1 < hi) xcd_barrier(bar, cc.tid == 0); } while (0)
#else
#define SEAM(k) do { } while (0)
#endif
#ifdef ONLY_PHASE
#define IN(k) ((k) == ONLY_PHASE)
#else
#define IN(k) (lo <= (k) && (k) < hi)
#endif
#ifndef REP_PH
#define REP_PH -1
#define REP_N 1
#endif
#define PHASE(k, call) do { if (IN(k)) for (int rep_ = 0; rep_ < (((k) == REP_PH) ? REP_N : 1); ++rep_) { Ctx cc = c; cc.ws = opaque_p(cc.ws); cc.out = opaque_p(cc.out); cc.wave = opaque_u(cc.wave); cc.lane = (int)__builtin_amdgcn_mbcnt_hi(~0u, __builtin_amdgcn_mbcnt_lo(~0u, 0u)); cc.tid = cc.wave * 64 + cc.lane; asm volatile("" : "+v"(cc.tid), "+v"(cc.lane)); cc.bid = opaque_u(cc.bid); cc.nb = opaque_u(cc.nb); call; SEAM(k); } } while (0)
    PHASE(0, phase_prep(cc));
    PHASE(1, phase_norm1(cc, 0));
#ifdef DUP_MODE
#define DUPX(k, call) PHASE(k, call)
#else
#define DUPX(k, call)
#endif
#ifndef DUP_PH
#define DUP_PH -1
#endif
#ifndef DUP_PART
#define DUP_PART 3
#endif
#define DUPQ(r, k, call) do { if (DUP_PH == (r)) PHASE(k, call); } while (0)
#define LAYER(l) do { constexpr int p0 = 2 + 10 * (l); \
        DUPQ(0, p0 + 0, phase_gemm_in(cc, l)); \
        PHASE(p0 + 0, phase_gemm_in(cc, l)); \
        DUPQ(1, p0 + 1, phase_post_conv<DUP_PART>(cc, l)); \
        PHASE(p0 + 1, phase_post_conv<3>(cc, l)); \
        DUPX(p0 + 2, phase_idx_attn<DUP_MODE>(cc, l)); \
        PHASE(p0 + 2, phase_idx_attn<0>(cc, l)); \
        DUPQ(3, p0 + 3, phase_gemm_d1(cc, l)); \
        PHASE(p0 + 3, phase_gemm_d1(cc, l)); \
        PHASE(p0 + 4, phase_gemm_d2(cc, l)); \
        DUPQ(53, p0 + 5, (void)0); \
        DUPQ(54, p0 + 5, (void)0); DUPQ(54, p0 + 5, (void)0); DUPQ(54, p0 + 5, (void)0); DUPQ(54, p0 + 5, (void)0); \
        DUPQ(52, p0 + 5, phase_valutest(cc)); \
        DUPQ(50, p0 + 5, phase_memtest<4>(cc)); \
        DUPQ(51, p0 + 5, phase_memtest<8>(cc)); \
        DUPQ(5, p0 + 5, phase_norm2_route<true>(cc, l)); \
        PHASE(p0 + 5, phase_norm2_route<false>(cc, l)); \
        PHASE(p0 + 7, phase_moe(cc, l)); \
        DUPQ(9, p0 + 9, phase_combine<true>(cc, l)); \
        PHASE(p0 + 9, phase_combine<false>(cc, l)); } while (0)
    LAYER(0);
    LAYER(1);
#undef LAYER
#undef PHASE
#undef IN
#undef SEAM
}

extern "C" void kernel_launch(void* const* d_in, const int* in_sizes, int n_in, void* d_out, int out_size, void* d_ws, size_t ws_size, hipStream_t stream) {
    static int grid = 0;
    if (grid == 0) {
        if (n_in != 24 || out_size != T * D || ws_size < WS_END) { fprintf(stderr, "kernel_launch: unexpected shapes (n_in %d out %d ws %zu)\n", n_in, out_size, ws_size); grid = -1; return; }
        int dev = 0, cus = 0, per_cu = 0;
        hipGetDevice(&dev); hipDeviceGetAttribute(&cus, hipDeviceAttributeMultiprocessorCount, dev);
        if (hipFuncSetAttribute((const void*)mega, hipFuncAttributeMaxDynamicSharedMemorySize, LDS_BYTES) != hipSuccess) { fprintf(stderr, "kernel_launch: hipFuncSetAttribute failed\n"); grid = -1; return; }
        if (hipOccupancyMaxActiveBlocksPerMultiprocessor(&per_cu, (const void*)mega, NTHREADS, LDS_BYTES) != hipSuccess || per_cu < 1) { fprintf(stderr, "kernel_launch: occupancy query says %d\n", per_cu); per_cu = 1; }
        (void)hipGetLastError();
        grid = cus;
    }
    if (grid < 0) return;
    hipMemsetAsync((char*)d_ws + WS_CTL, 0, CTL_ZERO, stream);
    Params p{};
    for (int i = 0; i < 24; ++i) p.in[i] = (const float*)d_in[i];
    p.out = (float*)d_out; p.ws = (unsigned char*)d_ws;
#if ONE_LAUNCH
    p.ph_lo = 0; p.ph_hi = NPH;
    hipLaunchKernelGGL(mega, dim3(grid), dim3(NTHREADS), LDS_BYTES, stream, p);
#else
    for (int ph = 0; ph < NPH; ++ph) { p.ph_lo = ph; p.ph_hi = ph + 1; hipLaunchKernelGGL(mega, dim3(grid), dim3(NTHREADS), LDS_BYTES, stream, p); }
#endif
}
```

```cpp
#include <hip/hip_runtime.h>
#include <cstdio>
#include <cstdint>

#ifndef ONE_LAUNCH
#define ONE_LAUNCH 1
#endif

#define LAS __attribute__((address_space(3)))
typedef unsigned short bf16_t;
typedef short bf16x8 __attribute__((ext_vector_type(8)));
typedef float f32x4 __attribute__((ext_vector_type(4)));
typedef float f32x2 __attribute__((ext_vector_type(2)));
typedef unsigned u32x4 __attribute__((ext_vector_type(4)));
typedef unsigned u32x2 __attribute__((ext_vector_type(2)));
typedef int i32x4 __attribute__((ext_vector_type(4)));

constexpr int NB = 2, L = 8192, T = NB * L, D = 1024;
constexpr int NTHREADS = 512, NWAVES = 8;
constexpr int CONV_CH = 512, CONV_W = 31;
constexpr int NH = 8, HD = 64, AW = 512;
constexpr int IH = 8, IDIM = 32;
constexpr int TOPK = 256;
constexpr int NE = 32, EPG = 8, NG = 4, DE = 256;
constexpr int NIN = 4008, NINP = 4096;
constexpr float EPS = 1e-6f;
constexpr int MAXSLOT = T * 2 + NE * 256;
constexpr int NPH = 22;

constexpr size_t MiB = 1u << 20;
constexpr size_t WS_CTL = 0;
constexpr size_t CTL_ZERO = 256 * 1024;
constexpr size_t CTL_CNT = 4096;
constexpr size_t CTL_MOD = 65536;
constexpr size_t CTL_BAR = 16384;
constexpr size_t CTL_MFLAG = 32768;
constexpr size_t CTL_MAXIK = 8192;
constexpr size_t WS_RTW = 512 * 1024;
constexpr size_t WS_TAB = 1 * MiB;
constexpr size_t WS_WIN = 4 * MiB;
constexpr size_t WS_WCA = 20 * MiB;
constexpr size_t WS_WO = 24 * MiB;
constexpr size_t WS_WGU = 28 * MiB;
constexpr size_t WS_WD = 60 * MiB;
constexpr size_t WS_H = 76 * MiB;
constexpr size_t WS_UGLU = 108 * MiB;
constexpr size_t WS_RAW = 124 * MiB;
constexpr size_t WS_RAWF = 156 * MiB;
constexpr size_t WS_GATES = 188 * MiB;
constexpr size_t WS_QN = 252 * MiB;
constexpr size_t WS_KN = 268 * MiB;
constexpr size_t WS_VB = 270 * MiB;
constexpr size_t WS_IQ = 272 * MiB;
constexpr size_t WS_IK = 280 * MiB;
constexpr size_t WS_IW = 281 * MiB;
constexpr size_t WS_YO = 282 * MiB;
constexpr size_t WS_PR = 315 * MiB;
constexpr size_t WS_ROUTE = 314 * MiB;
constexpr size_t WS_INV = 316 * MiB;
constexpr size_t WS_END = 318 * MiB;
constexpr size_t WS_XS = 144 * MiB;
constexpr size_t WS_H2 = 108 * MiB;
constexpr size_t WS_ROWL = 315 * MiB + 128 * 1024;
constexpr size_t WS_HID = 76 * MiB;
constexpr size_t WS_X1 = 156 * MiB;
constexpr size_t WS_YS = 188 * MiB;

constexpr int LDS_BYTES = 160 * 1024;

__device__ __forceinline__ unsigned f2bf(float f) { unsigned u = __float_as_uint(f); return (u + 0x7fffu + ((u >> 16) & 1u)) >> 16; }
typedef __bf16 hwbf16x2 __attribute__((ext_vector_type(2)));
__device__ __forceinline__ unsigned pk2(float lo, float hi) { const f32x2 v = {lo, hi}; return __builtin_bit_cast(unsigned, __builtin_convertvector(v, hwbf16x2)); }
__device__ __forceinline__ float bflo(unsigned w) { return __uint_as_float(w << 16); }
__device__ __forceinline__ float bfhi(unsigned w) { return __uint_as_float(w & 0xffff0000u); }
__device__ __forceinline__ float bf2f(bf16_t h) { return __uint_as_float((unsigned)h << 16); }
__device__ __forceinline__ float sigmoidf_(float x) { return __builtin_amdgcn_rcpf(1.f + __expf(-x)); }
__device__ __forceinline__ float siluf_(float x) { return x * __builtin_amdgcn_rcpf(1.f + __expf(-x)); }
__device__ __forceinline__ unsigned lds_add(LAS unsigned* p, unsigned v) { return __hip_atomic_fetch_add(p, v, __ATOMIC_RELAXED, __HIP_MEMORY_SCOPE_WORKGROUP); }
__device__ __forceinline__ int lds_addi(LAS int* p, int v) { return __hip_atomic_fetch_add(p, v, __ATOMIC_RELAXED, __HIP_MEMORY_SCOPE_WORKGROUP); }
template <int CTRL> __device__ __forceinline__ float dpp_f(float v) { return __int_as_float(__builtin_amdgcn_update_dpp(0, __float_as_int(v), CTRL, 0xf, 0xf, true)); }
__device__ __forceinline__ float row16_sum(float v) { v += dpp_f<0xB1>(v); v += dpp_f<0x4E>(v); v += dpp_f<0x141>(v); v += dpp_f<0x140>(v); return v; }
__device__ __forceinline__ float row16_max(float v) { v = fmaxf(v, dpp_f<0xB1>(v)); v = fmaxf(v, dpp_f<0x4E>(v)); v = fmaxf(v, dpp_f<0x141>(v)); v = fmaxf(v, dpp_f<0x140>(v)); return v; }
__device__ __forceinline__ float rl_f(float v, int l) { return __int_as_float(__builtin_amdgcn_readlane(__float_as_int(v), l)); }
__device__ __forceinline__ float wave_sum(float v) { v = row16_sum(v); return (rl_f(v, 0) + rl_f(v, 16)) + (rl_f(v, 32) + rl_f(v, 48)); }
__device__ __forceinline__ float wave_max(float v) { v = row16_max(v); return fmaxf(fmaxf(rl_f(v, 0), rl_f(v, 16)), fmaxf(rl_f(v, 32), rl_f(v, 48))); }
__device__ __forceinline__ unsigned wave_incl_scan(unsigned v) {
    v += (unsigned)__builtin_amdgcn_update_dpp(0, (int)v, 0x111, 0xf, 0xf, true);
    v += (unsigned)__builtin_amdgcn_update_dpp(0, (int)v, 0x112, 0xf, 0xf, true);
    v += (unsigned)__builtin_amdgcn_update_dpp(0, (int)v, 0x114, 0xf, 0xf, true);
    v += (unsigned)__builtin_amdgcn_update_dpp(0, (int)v, 0x118, 0xf, 0xf, true);
    v += (unsigned)__builtin_amdgcn_update_dpp(0, (int)v, 0x142, 0xa, 0xf, false);
    v += (unsigned)__builtin_amdgcn_update_dpp(0, (int)v, 0x143, 0xc, 0xf, false);
    return v;
}
__device__ __forceinline__ float xor16_f(float v) { return __int_as_float(__builtin_amdgcn_ds_swizzle(__float_as_int(v), (16 << 10) | 0x1f)); }
__device__ __forceinline__ float max_x32(float v) { const auto r = __builtin_amdgcn_permlane32_swap(__float_as_uint(v), __float_as_uint(v), false, false); return fmaxf(__uint_as_float(r[0]), __uint_as_float(r[1])); }
__device__ __forceinline__ float sum_x32(float v) { const auto r = __builtin_amdgcn_permlane32_swap(__float_as_uint(v), __float_as_uint(v), false, false); return __uint_as_float(r[0]) + __uint_as_float(r[1]); }
__device__ __forceinline__ float oct_sum(float v) { v += dpp_f<0xB1>(v); v += dpp_f<0x4E>(v); v += dpp_f<0x141>(v); return v; }
__device__ __forceinline__ int opaque_u(int x) { asm volatile("" : "+v"(x)); return __builtin_amdgcn_readfirstlane(x); }
template <class P> __device__ __forceinline__ P* opaque_p(P* p) { const unsigned long long v = (unsigned long long)p; unsigned lo = (unsigned)v, hi = (unsigned)(v >> 32); asm volatile("" : "+v"(lo), "+v"(hi));
    lo = __builtin_amdgcn_readfirstlane(lo); hi = __builtin_amdgcn_readfirstlane(hi);
    return (P*)(__attribute__((address_space(1))) P*)(((unsigned long long)hi << 32) | lo); }
struct Params { const float* in[24]; float* out; unsigned char* ws; int ph_lo, ph_hi; };

struct Ctx {
    const float* const* in; float* out; unsigned char* ws;
    LAS unsigned char* lds;
    int tid, lane, wave, bid, nb;
};

struct TItem { const float* src; bf16_t* dst; int ldw, ldt, ncol; };
__device__ __forceinline__ void titem_load(const TItem& t, float (&v)[32], int lane) {
    const int j = lane & 31, kh = lane >> 5;
#pragma unroll
    for (int i = 0; i < 32; ++i) v[i] = (j < t.ncol) ? t.src[(size_t)(2 * i + kh) * t.ldw + j] : 0.f;
}
__device__ __forceinline__ void titem_store(const TItem& t, const float (&v)[32], LAS float* scr, int lane) {
    const int j = lane & 31, kh = lane >> 5;
#pragma unroll
    for (int i = 0; i < 32; ++i) scr[(2 * i + kh) * 33 + j] = v[i];
    asm volatile("s_waitcnt lgkmcnt(0)" ::: "memory");
    const int c = lane & 7;
#pragma unroll
    for (int jj = 0; jj < 4; ++jj) { const int n = (lane >> 3) + 8 * jj; const LAS float* s = scr + (8 * c) * 33 + n;
        u32x4 o; o.x = pk2(s[0 * 33], s[1 * 33]); o.y = pk2(s[2 * 33], s[3 * 33]); o.z = pk2(s[4 * 33], s[5 * 33]); o.w = pk2(s[6 * 33], s[7 * 33]);
        *(u32x4*)(t.dst + (size_t)n * t.ldt + 8 * c) = o; }
    asm volatile("s_waitcnt lgkmcnt(0)" ::: "memory");
}
__device__ __forceinline__ TItem titem(const float* W, int ldw, int k0, int c0, int ncol, bf16_t* WT, int ldt, int r0, int kdst0) {
    TItem t; t.src = W + (size_t)k0 * ldw + c0; t.dst = WT + (size_t)r0 * ldt + kdst0 + k0; t.ldw = ldw; t.ldt = ldt; t.ncol = ncol; return t; }

__device__ __forceinline__ void win_map(int db, int& c0, int& ncol) {
    ncol = 32;
    if (db < 32) { const int i = db >> 3, w = db & 7; c0 = (w < 4) ? (128 * i + 32 * w) : (512 + 128 * i + 32 * (w - 4)); }
    else if (db < 48) c0 = 1024 + 32 * (db - 32);
    else if (db < 56) { const int q = db - 48; if (q < 2) c0 = 1536 + 32 * q; else if (q < 4) c0 = 1600 + 32 * (q - 2); else if (q == 4) c0 = 1920; else if (q == 5) { c0 = 1952; ncol = 8; } else { c0 = 0; ncol = 0; } }
    else if (db < 64) c0 = 1664 + 32 * (db - 56);
    else c0 = 1960 + 32 * (db - 64);
}
constexpr int IT_WIN = 16 * 128, IT_WC = 8 * 32, IT_WA = 8 * 32, IT_WO = 16 * 32, IT_MIX = IT_WIN + IT_WC + IT_WA + IT_WO;
constexpr int IT_GU = 32 * 16 * 16, IT_DN = 32 * 4 * 32, IT_MOE = IT_GU + IT_DN;
__device__ __forceinline__ TItem mixer_item(const Ctx& c, int l, int it) {
    bf16_t* WinT = (bf16_t*)(c.ws + WS_WIN) + (size_t)l * NINP * D;
    bf16_t* WcaT = (bf16_t*)(c.ws + WS_WCA) + (size_t)l * D * D;
    bf16_t* WoT = (bf16_t*)(c.ws + WS_WO) + (size_t)l * D * D;
    if (it < IT_WIN) { const int kb = it / 128, db = it % 128; int c0, nc; win_map(db, c0, nc); return titem(c.in[5] + (size_t)l * D * NIN, NIN, 64 * kb, c0, nc, WinT, D, 32 * db, 0); }
    it -= IT_WIN;
    if (it < IT_WC) { const int kb = it / 32, db = it % 32; return titem(c.in[12] + (size_t)l * CONV_CH * D, D, 64 * kb, 32 * db, 32, WcaT, D, 32 * db, 0); }
    it -= IT_WC;
    if (it < IT_WA) { const int kb = it / 32, db = it % 32; return titem(c.in[14] + (size_t)l * AW * D, D, 64 * kb, 32 * db, 32, WcaT, D, 32 * db, 512); }
    it -= IT_WA;
    { const int kb = it / 32, db = it % 32; return titem(c.in[15] + (size_t)l * D * D, D, 64 * kb, 32 * db, 32, WoT, D, 32 * db, 0); }
}
__device__ __forceinline__ TItem moe_item(const Ctx& c, int l, int it) {
    bf16_t* WguT = (bf16_t*)(c.ws + WS_WGU);
    bf16_t* WdT = (bf16_t*)(c.ws + WS_WD);
    if (it < IT_GU) { const int e = it / 256, r = it % 256, kb = r / 16, db = r % 16, j = db >> 3, w = db & 7;
        const float* src = (w < 4 ? c.in[21] : c.in[22]) + ((size_t)l * NE + e) * D * DE;
        return titem(src, DE, 64 * kb, 128 * j + 32 * (w & 3), 32, WguT + (size_t)e * 512 * D, D, 32 * db, 0); }
    it -= IT_GU;
    { const int e = it / 128, r = it % 128, kb = r / 32, db = r % 32;
        return titem(c.in[23] + ((size_t)l * NE + e) * DE * D, D, 64 * kb, 32 * db, 32, WdT + (size_t)e * D * DE, DE, 32 * db, 0); }
}
template <int KIND>
__device__ __forceinline__ void convert_items(const Ctx& c, int l, int first, int step, int nitems, LAS float* scr) {
    if (first >= nitems) return;
    auto get = [&](int it) { return KIND == 0 ? mixer_item(c, it / IT_MIX, it % IT_MIX) : moe_item(c, l, it); };
    TItem cur = get(first); float v[32]; titem_load(cur, v, c.lane);
    for (int it = first; it < nitems; it += step) {
        const int nx = it + step; TItem nt = cur; float nv[32];
        if (nx < nitems) { nt = get(nx); titem_load(nt, nv, c.lane); }
        titem_store(cur, v, scr, c.lane);
        if (nx < nitems) { cur = nt;
#pragma unroll
            for (int i = 0; i < 32; ++i) v[i] = nv[i]; }
    }
}

__device__ __forceinline__ void phase_prep(const Ctx& c) {
    LAS float* scr = (LAS float*)(c.lds + c.wave * 8704);
    const int gw = c.bid * NWAVES + c.wave, NGW = c.nb * NWAVES;
    float* cosH = (float*)(c.ws + WS_TAB); float* sinH = cosH + L * 32; float* cosI = sinH + L * 32; float* sinI = cosI + L * 16;
    for (int it = gw; it < (L * 32 + L * 16) / 64; it += NGW) {
        const bool hd = it < (L * 32) / 64; const int e = (hd ? it : it - (L * 32) / 64) * 64 + c.lane;
        const int pos = hd ? (e >> 5) : (e >> 4), i = hd ? (e & 31) : (e & 15);
        const float inv = powf(10000.f, -(float)(2 * i) / (hd ? 64.f : 32.f)); const float ang = (float)pos * inv;
        const float n = rintf(ang * 0.15915494309189535f); float r = fmaf(-n, 6.2831854820251465f, ang); r = fmaf(-n, -1.7484555314695172e-07f, r);
        const float cv_ = cosf(r), sv_ = sinf(r);
        if (hd) { cosH[e] = cv_; sinH[e] = sv_; } else { cosI[e] = cv_; sinI[e] = sv_; }
    }
    float* mod = (float*)(c.ws + WS_CTL + CTL_MOD);
    for (int it = c.bid; it < 2 * 96; it += c.nb) {
        const int l = it / 96, cc = it % 96, cg = c.lane & 15, ks = c.lane >> 4, col = 64 * cc + 4 * cg;
        const float* W = c.in[2] + (size_t)l * D * 6144; const float* cv = c.in[1];
        f32x4 a0 = {0.f, 0.f, 0.f, 0.f}, a1 = a0;
#pragma unroll 8
        for (int kk = 0; kk < 32; ++kk) { const int k = 128 * c.wave + 4 * kk + ks; const f32x4 w = *(const f32x4*)(W + (size_t)k * 6144 + col); const float s0 = siluf_(cv[k]), s1 = siluf_(cv[D + k]); a0 += w * s0; a1 += w * s1; }
#pragma unroll
        for (int i = 0; i < 4; ++i) { a0[i] += xor16_f(a0[i]); a0[i] = sum_x32(a0[i]); a1[i] += xor16_f(a1[i]); a1[i] = sum_x32(a1[i]); }
        LAS f32x4* red = (LAS f32x4*)(c.lds + 8 * 8704);
        __syncthreads();
        if (ks == 0) { red[(c.wave * 2 + 0) * 16 + cg] = a0; red[(c.wave * 2 + 1) * 16 + cg] = a1; }
        __syncthreads();
        if (c.tid < 32) { const int b = c.tid >> 4; f32x4 t = *(const f32x4*)(c.in[3] + l * 6144 + col);
#pragma unroll
            for (int w = 0; w < 8; ++w) t += red[(w * 2 + b) * 16 + cg];
            *(f32x4*)(mod + (l * 2 + b) * 6144 + col) = t; }
    }
    for (int it = gw; it < 2 * 36; it += NGW) { const int l = it / 36, r = it % 36;
        const float* src = (r < 4) ? (c.in[17] + (size_t)l * D * NG + r) : (c.in[19] + (size_t)l * D * NE + (r - 4)); const int ld = (r < 4) ? NG : NE;
        bf16_t* hi_ = (bf16_t*)(c.ws + WS_RTW) + (size_t)l * (2 * 36 * 1032) + r * 1032; bf16_t* lo_ = hi_ + 36 * 1032;
        for (int k = c.lane; k < 1032; k += 64) { const float w = (k < D) ? src[(size_t)k * ld] : 0.f; const unsigned h = f2bf(w); hi_[k] = (bf16_t)h; lo_[k] = (bf16_t)f2bf(w - __uint_as_float(h << 16)); } }
    convert_items<0>(c, 0, gw, NGW, 2 * IT_MIX, scr);
    convert_items<1>(c, 0, gw, NGW, IT_MOE, scr);
}

__device__ __forceinline__ void norm_row_store(const f32x4 (&v)[4], const float* g, const float* shift, const float* scale, bf16_t* orow, int lane) {
    float s = 0.f;
#pragma unroll
    for (int j = 0; j < 4; ++j) s += (v[j].x * v[j].x + v[j].y * v[j].y) + (v[j].z * v[j].z + v[j].w * v[j].w);
    const float rstd = __builtin_amdgcn_rsqf(wave_sum(s) * (1.f / D) + EPS);
#pragma unroll
    for (int j = 0; j < 4; ++j) { const int col = 4 * lane + 256 * j; const f32x4 gv = *(const f32x4*)(g + col), sh = *(const f32x4*)(shift + col), sc = *(const f32x4*)(scale + col);
        const f32x4 o = v[j] * rstd * gv * (sc + 1.f) + sh;
        u32x2 w; w.x = pk2(o.x, o.y); w.y = pk2(o.z, o.w); *(u32x2*)(orow + col) = w; }
}
__device__ __forceinline__ void phase_norm1(const Ctx& c, int l) {
    const int gw = c.bid * NWAVES + c.wave, NGW = c.nb * NWAVES;
    const float* xin = (l == 0) ? c.in[0] : c.out; const float* mod = (const float*)(c.ws + WS_CTL + CTL_MOD);
    bf16_t* H = (bf16_t*)(c.ws + WS_H);
    for (int m0 = gw; m0 < T; m0 += 4 * NGW) {
        f32x4 v[4][4];
#pragma unroll
        for (int i = 0; i < 4; ++i) { const int m = (m0 + i * NGW < T) ? m0 + i * NGW : m0;
#pragma unroll
            for (int j = 0; j < 4; ++j) v[i][j] = *(const f32x4*)(xin + (size_t)m * D + 4 * c.lane + 256 * j); }
#pragma unroll
        for (int i = 0; i < 4; ++i) { const int m = m0 + i * NGW; if (m < T) { const float* mb = mod + (l * 2 + m / L) * 6144; norm_row_store(v[i], c.in[4] + l * D, mb, mb + D, H + (size_t)m * D, c.lane); } }
    }
}

namespace pg8 {
#define PG8_LAS __attribute__((address_space(3)))
constexpr int BM = 256, BK = 64, HALF = 128, HTB = HALF * BK * 2  , STAGE_BYTES = 8 * HTB, NXCD = 8, WGM = 8;
__host__ __device__ __forceinline__ int lds_byte(int r, int c) { const int st = (r >> 4) * 2 + (c >> 5), rr = r & 15, cc = c & 31, ob = rr * 64 + cc * 2; return st * 1024 + (ob ^ (((ob >> 9) & 1) << 5)); }
__host__ __device__ __forceinline__ void stage_rc(int b, int& R, int& C) { const int st = b / 1024, sb = b % 1024, swz = sb ^ (((sb >> 9) & 1) << 5); R = (st >> 1) * 16 + swz / 64; C = (st & 1) * 32 + (swz % 64) / 2; }
__host__ __device__ __forceinline__ int perm32(int rho) { const int n = rho >> 4, i = rho & 15; return 8 * (i >> 2) + 4 * n + (i & 3); }
struct GUnit { const char* A; const char* B; const int* rows; int pm, pn, aux, row0; };
struct Gemm { int lda, ldb, K, M; };
__device__ __forceinline__ void tile_order(int L, int nM, int nN, int& pm, int& pn) {
    const int nwg = nM * nN; int wgid = L; { const int q = nwg / NXCD, r = nwg % NXCD, xcd = wgid % NXCD, off = wgid / NXCD; wgid = (xcd < r ? xcd * (q + 1) : r * (q + 1) + (xcd - r) * q) + off; }
    const int nig = WGM * nN, gid = wgid / nig, fm = gid * WGM, gsz = (nM - fm) < WGM ? (nM - fm) : WGM;
    pm = fm + ((wgid % nig) % gsz); pn = (wgid % nig) / gsz;
}
template <class Epi, class Sched, bool ALIGN_EPI = false, bool SP2 = false, bool GATHER = false>
__device__ __forceinline__ void gemm_phase(PG8_LAS unsigned char* lds, const Gemm g, const Sched& S, const Epi& E, const int tid_in) {
    const int tid = tid_in, wid = __builtin_amdgcn_readfirstlane(tid >> 6), lane = tid & 63, wr = wid >> 2, wc = wid & 3, fr = lane & 15, fq = lane >> 4;
    const int K = g.K, nt = K / BK;
    unsigned voffA[2], voffB[2];
#pragma unroll
    for (int i = 0; i < 2; ++i) { int R, C; stage_rc(tid * 16 + i * 8192, R, C); const int Rb = Epi::PERM ? ((R & ~31) + perm32(R & 31)) : R;
        voffA[i] = (unsigned)(R * g.lda + C) * 2u; voffB[i] = (unsigned)(Rb * g.ldb + C) * 2u; }
    const size_t kstep = (size_t)(BK * 2);
    const size_t hstepA = (size_t)HALF * g.lda * 2, hstepB = (size_t)HALF * g.ldb * 2;
    const unsigned ldsw = (unsigned)wid * 1024u;
    const int aoff = lds_byte(wr * 64 + fr, fq * 8), boff = lds_byte(wc * 32 + fr, fq * 8);
#define PG8_SA(b, h) (((b) * 2 + (h)) * HTB)
#define PG8_SB(b, h) ((4 + (b) * 2 + (h)) * HTB)
#define PG8_STAGE(bufoff, gbase, voff) do { _Pragma("unroll") for (int _i = 0; _i < 2; ++_i) \
        __builtin_amdgcn_global_load_lds((const unsigned*)((const char*)(gbase) + (voff)[_i]), (PG8_LAS unsigned*)(lds + (bufoff) + ldsw + _i * 8192), 16, 0, 0); } while (0)
#define PG8_STAGE_A(bufoff, gbase, off2) do { _Pragma("unroll") for (int _i = 0; _i < 2; ++_i) \
        __builtin_amdgcn_global_load_lds((const unsigned*)((const char*)(gbase) + (off2)[_i]), (PG8_LAS unsigned*)(lds + (bufoff) + ldsw + _i * 8192), 16, 0, Sched::A_AUX); } while (0)
#define PG8_LDA(dst, b, h) do { _Pragma("unroll") for (int m = 0; m < 4; ++m) _Pragma("unroll") for (int k = 0; k < 2; ++k) dst[m][k] = *(const PG8_LAS bf16x8*)(lds + PG8_SA(b, h) + aoff + m * 2048 + k * 1024); } while (0)
#define PG8_LDB(dst, b, h) do { _Pragma("unroll") for (int n = 0; n < 2; ++n) _Pragma("unroll") for (int k = 0; k < 2; ++k) dst[n][k] = *(const PG8_LAS bf16x8*)(lds + PG8_SB(b, h) + boff + n * 2048 + k * 1024); } while (0)
#define PG8_MMA(ai, bj, At, Bt) do { __builtin_amdgcn_s_setprio(1); _Pragma("unroll") for (int m = 0; m < 4; ++m) _Pragma("unroll") for (int n = 0; n < 2; ++n) _Pragma("unroll") for (int k = 0; k < 2; ++k) \
        acc[ai][bj][m][n] = __builtin_amdgcn_mfma_f32_16x16x32_bf16(Bt[n][k], At[m][k], acc[ai][bj][m][n], 0, 0, 0); __builtin_amdgcn_s_setprio(0); } while (0)
#define PG8_WAIT_V(n) asm volatile("s_waitcnt vmcnt(" #n ")" ::: "memory")
#define PG8_WAIT_L(n) asm volatile("s_waitcnt lgkmcnt(" #n ")" ::: "memory")
#define PG8_BAR __builtin_amdgcn_s_barrier()
#define PG8_SCHED __builtin_amdgcn_sched_barrier(0)
    GUnit cur, nxt; int ui = 0;
    if (!S.next(0, cur)) return;
    f32x4 acc[2][2][4][2];
#pragma unroll
    for (int a = 0; a < 2; ++a)
#pragma unroll
        for (int b = 0; b < 2; ++b)
#pragma unroll
            for (int m = 0; m < 4; ++m)
#pragma unroll
                for (int n = 0; n < 2; ++n) acc[a][b][m][n] = (f32x4){0.f, 0.f, 0.f, 0.f};
    bf16x8 At[4][2], B0[2][2], B1[2][2];
    const char* cA = cur.A; const char* cB = cur.B;
    int stR[2], stC[2];
#pragma unroll
    for (int i = 0; i < 2; ++i) stage_rc(tid * 16 + i * 8192, stR[i], stC[i]);
    unsigned coff[2][2], noff[2][2];
#pragma unroll
    for (int h = 0; h < 2; ++h)
#pragma unroll
        for (int i = 0; i < 2; ++i) { if (GATHER) { int r = cur.rows[128 * h + stR[i]]; r = (unsigned)r < (unsigned)g.M ? r : 0; coff[h][i] = ((unsigned)r * (unsigned)g.lda + (unsigned)stC[i]) * 2u; } else coff[h][i] = voffA[i] + (unsigned)(h * hstepA); noff[h][i] = coff[h][i]; }
    S.a_ready(cur);
    if constexpr (SP2) {
        PG8_STAGE(PG8_SB(0, 0), cB, voffB); PG8_STAGE(PG8_SB(0, 1), cB + hstepB, voffB); PG8_STAGE_A(PG8_SA(0, 0), cA, coff[0]); PG8_STAGE_A(PG8_SA(0, 1), cA, coff[1]);
        if (wr == 1) PG8_BAR;
        PG8_WAIT_V(2); PG8_BAR;
        PG8_STAGE(PG8_SB(1, 0), cB + kstep, voffB); PG8_STAGE_A(PG8_SA(1, 0), cA + kstep, coff[0]); PG8_STAGE(PG8_SB(1, 1), cB + hstepB + kstep, voffB);
        PG8_WAIT_V(6); PG8_BAR;
    } else {
        PG8_STAGE(PG8_SB(0, 0), cB, voffB); PG8_STAGE_A(PG8_SA(0, 0), cA, coff[0]); PG8_STAGE(PG8_SB(0, 1), cB + hstepB, voffB); PG8_STAGE_A(PG8_SA(0, 1), cA, coff[1]);
        if (wr == 1) PG8_BAR;
        PG8_WAIT_V(4); PG8_BAR;
        PG8_STAGE(PG8_SB(1, 0), cB + kstep, voffB); PG8_STAGE_A(PG8_SA(1, 0), cA + kstep, coff[0]); PG8_STAGE(PG8_SB(1, 1), cB + hstepB + kstep, voffB);
        PG8_WAIT_V(6); PG8_BAR;
    }
    for (;;) {
        const bool has_next = S.next(ui + 1, nxt);
        const char* nA = has_next ? nxt.A : cA; const char* nB = has_next ? nxt.B : cB;
        if (GATHER) {
#pragma unroll
            for (int h = 0; h < 2; ++h)
#pragma unroll
                for (int i = 0; i < 2; ++i) { if (has_next) { int r = nxt.rows[128 * h + stR[i]]; r = (unsigned)r < (unsigned)g.M ? r : 0; noff[h][i] = ((unsigned)r * (unsigned)g.lda + (unsigned)stC[i]) * 2u; } else noff[h][i] = coff[h][i]; } }
        for (int t = 0; t < nt; t += 2) {
            const bool last = (t == nt - 2);
            const char* a1 = cA + (size_t)(t + 1) * kstep;
            const char* a2 = last ? nA : cA + (size_t)(t + 2) * kstep; const char* b2 = last ? nB : cB + (size_t)(t + 2) * kstep;
            const char* a3 = a2 + kstep; const char* b3 = b2 + kstep;
            unsigned xoff[2][2];
#pragma unroll
            for (int h = 0; h < 2; ++h)
#pragma unroll
                for (int i = 0; i < 2; ++i) xoff[h][i] = (GATHER && last) ? noff[h][i] : coff[h][i];
            if (last && has_next) S.a_ready(nxt);
            if constexpr (SP2) {
            PG8_LDB(B0, 0, 0); PG8_LDB(B1, 0, 1); PG8_SCHED; PG8_LDA(At, 0, 0); PG8_STAGE_A(PG8_SA(1, 1), a1, coff[1]);
            PG8_WAIT_V(8); PG8_WAIT_L(0); PG8_BAR; PG8_MMA(0, 0, At, B0); PG8_MMA(0, 1, At, B1); PG8_BAR; PG8_SCHED;
            PG8_LDA(At, 0, 1); PG8_STAGE(PG8_SB(0, 0), b2, voffB); PG8_STAGE(PG8_SB(0, 1), b2 + hstepB, voffB); PG8_STAGE_A(PG8_SA(0, 0), a2, xoff[0]);
            PG8_WAIT_V(8); PG8_WAIT_L(0); PG8_BAR; PG8_MMA(1, 0, At, B0); PG8_MMA(1, 1, At, B1); PG8_BAR; PG8_SCHED;
            PG8_LDB(B0, 1, 0); PG8_LDB(B1, 1, 1); PG8_SCHED; PG8_LDA(At, 1, 0); PG8_STAGE_A(PG8_SA(0, 1), a2, xoff[1]);
            PG8_WAIT_V(8); PG8_WAIT_L(0); PG8_BAR; PG8_MMA(0, 0, At, B0); PG8_MMA(0, 1, At, B1); PG8_BAR; PG8_SCHED;
            PG8_LDA(At, 1, 1); PG8_STAGE(PG8_SB(1, 0), b3, voffB); PG8_STAGE(PG8_SB(1, 1), b3 + hstepB, voffB); PG8_STAGE_A(PG8_SA(1, 0), a3, xoff[0]);
            PG8_WAIT_V(8); PG8_WAIT_L(0); PG8_BAR; PG8_MMA(1, 0, At, B0); PG8_MMA(1, 1, At, B1); PG8_BAR; PG8_SCHED;
            } else {
            PG8_LDB(B0, 0, 0); PG8_SCHED; PG8_LDA(At, 0, 0); PG8_STAGE_A(PG8_SA(1, 1), a1, coff[1]);
            PG8_WAIT_L(8); PG8_BAR; PG8_WAIT_L(0); PG8_MMA(0, 0, At, B0); PG8_BAR; PG8_SCHED;
            PG8_LDB(B1, 0, 1); PG8_STAGE(PG8_SB(0, 0), b2, voffB);
            PG8_BAR; PG8_WAIT_L(0); PG8_MMA(0, 1, At, B1); PG8_BAR;
            PG8_LDA(At, 0, 1); PG8_STAGE_A(PG8_SA(0, 0), a2, xoff[0]);
            PG8_BAR; PG8_WAIT_L(0); PG8_MMA(1, 0, At, B0); PG8_BAR; PG8_SCHED;
            PG8_STAGE(PG8_SB(0, 1), b2 + hstepB, voffB);
            PG8_WAIT_V(6); PG8_BAR; PG8_MMA(1, 1, At, B1); PG8_BAR;
            PG8_LDB(B0, 1, 0); PG8_SCHED; PG8_LDA(At, 1, 0); PG8_STAGE_A(PG8_SA(0, 1), a2, xoff[1]);
            PG8_WAIT_L(8); PG8_BAR; PG8_WAIT_L(0); PG8_MMA(0, 0, At, B0); PG8_BAR; PG8_SCHED;
            PG8_LDB(B1, 1, 1); PG8_STAGE(PG8_SB(1, 0), b3, voffB);
            PG8_BAR; PG8_WAIT_L(0); PG8_MMA(0, 1, At, B1); PG8_BAR;
            PG8_LDA(At, 1, 1); PG8_STAGE_A(PG8_SA(1, 0), a3, xoff[0]);
            PG8_BAR; PG8_WAIT_L(0); PG8_MMA(1, 0, At, B0); PG8_BAR; PG8_SCHED;
            PG8_STAGE(PG8_SB(1, 1), b3 + hstepB, voffB);
            PG8_WAIT_V(6); PG8_BAR; PG8_MMA(1, 1, At, B1); PG8_BAR;
            }
        }
        if constexpr (ALIGN_EPI) { if (wr == 0) PG8_BAR; }
        if constexpr (!Epi::AFTER_DRAIN) { E(acc, cur, wr, wc, fr, fq); S.done(cur); }
        if (!has_next) break;
#pragma unroll
        for (int a = 0; a < 2; ++a)
#pragma unroll
            for (int b = 0; b < 2; ++b)
#pragma unroll
                for (int m = 0; m < 4; ++m)
#pragma unroll
                    for (int n = 0; n < 2; ++n) acc[a][b][m][n] = (f32x4){0.f, 0.f, 0.f, 0.f};
        cur = nxt; cA = nA; cB = nB; ++ui;
        if (GATHER) {
#pragma unroll
            for (int h = 0; h < 2; ++h)
#pragma unroll
                for (int i = 0; i < 2; ++i) coff[h][i] = noff[h][i]; }
        if constexpr (ALIGN_EPI) { if (wr == 1) PG8_BAR; }
    }
    PG8_WAIT_V(0);
    if constexpr (!ALIGN_EPI) { if (wr == 0) PG8_BAR; }
    PG8_BAR;
    if constexpr (Epi::AFTER_DRAIN) { E.fused(acc, cur, wr, wc, fr, fq, lds, wid, lane); S.done(cur); }
#undef PG8_SA
#undef PG8_SB
#undef PG8_STAGE
#undef PG8_STAGE_A
#undef PG8_LDA
#undef PG8_LDB
#undef PG8_MMA
#undef PG8_WAIT_V
#undef PG8_WAIT_L
#undef PG8_BAR
#undef PG8_SCHED
}
}
using pg8::GUnit;
#define EPI_COMMON_P static constexpr bool PERM = true, AFTER_DRAIN = false; \
    __device__ __forceinline__ void operator()(const f32x4 (&acc)[2][2][4][2], const GUnit& u, int wr, int wc, int fr, int fq) const { half(acc[0], 0, u, wr, wc, fr, fq); half(acc[1], 1, u, wr, wc, fr, fq); }
#define EPI_COMMON static constexpr bool PERM = false, AFTER_DRAIN = false; \
    __device__ __forceinline__ void operator()(const f32x4 (&acc)[2][2][4][2], const GUnit& u, int wr, int wc, int fr, int fq) const { half(acc[0], 0, u, wr, wc, fr, fq); half(acc[1], 1, u, wr, wc, fr, fq); }

__device__ __forceinline__ u32x2 pack4(const f32x4 v) { u32x2 w; w.x = pk2(v.x, v.y); w.y = pk2(v.z, v.w); return w; }
__device__ __forceinline__ u32x4 pack8(const f32x4 a, const f32x4 b) { return (u32x4){pk2(a.x, a.y), pk2(a.z, a.w), pk2(b.x, b.y), pk2(b.z, b.w)}; }
typedef unsigned v4u_ __attribute__((vector_size(16)));
__device__ __forceinline__ void st16_wt(const void* base, unsigned off, const u32x4 v) {
    __builtin_amdgcn_raw_buffer_store_b128(__builtin_bit_cast(v4u_, v), __builtin_amdgcn_make_buffer_rsrc(const_cast<void*>(base), 0, 0x7FFFFFFF, 0x00020000), (int)off, 0, 16);
}
__device__ __forceinline__ f32x4 unpack4(const u32x2 w) { return (f32x4){bflo(w.x), bfhi(w.x), bflo(w.y), bfhi(w.y)}; }

struct EpiIn {
    EPI_COMMON_P
    bf16_t* uglu; bf16_t* rawb; float* rawf; bf16_t* gates;
    __device__ __forceinline__ void half(const f32x4 (&acc)[2][4][2], int ai, const GUnit& u, int wr, int wc, int fr, int fq) const {
        const int pn = u.pn, c8 = 32 * wc + 8 * fq;
#pragma unroll
        for (int m = 0; m < 4; ++m) { const size_t row = (size_t)u.row0 + 128 * ai + 64 * wr + 16 * m + fr;
            if (pn < 4) { f32x4 o[2];
#pragma unroll
                for (int n = 0; n < 2; ++n)
#pragma unroll
                    for (int i = 0; i < 4; ++i) o[n][i] = acc[0][m][n][i] * sigmoidf_(acc[1][m][n][i]);
                *(u32x4*)(uglu + row * 512 + 128 * pn + c8) = pack8(o[0], o[1]);
            } else if (pn == 6) {
#pragma unroll
                for (int bj = 0; bj < 2; ++bj)
#pragma unroll
                    for (int n = 0; n < 2; ++n) *(f32x4*)(rawf + row * 256 + 128 * bj + c8 + 4 * n) = acc[bj][m][n];
            } else if (pn < 8) { const int cb0 = (pn == 7) ? 512 : 256 * (pn - 4);
#pragma unroll
                for (int bj = 0; bj < 2; ++bj) *(u32x4*)(rawb + row * 768 + cb0 + 128 * bj + c8) = pack8(acc[bj][m][0], acc[bj][m][1]);
            } else {
#pragma unroll
                for (int bj = 0; bj < 2; ++bj) { f32x4 o[2];
#pragma unroll
                    for (int n = 0; n < 2; ++n)
#pragma unroll
                        for (int i = 0; i < 4; ++i) o[n][i] = sigmoidf_(acc[bj][m][n][i]);
                    *(u32x4*)(gates + row * 2048 + 256 * (pn - 8) + 128 * bj + c8) = pack8(o[0], o[1]); }
            } }
    }
};
struct SchedIn { static constexpr int A_AUX = 0; const char* A; const char* B; int G, c;
    __device__ __forceinline__ bool next(int i, GUnit& u) const { const int Lq = i * G + c; if (Lq >= 64 * 16) return false; int pm, pn; pg8::tile_order(Lq, 64, 16, pm, pn);
        u.pm = pm; u.pn = pn; u.aux = 0; u.row0 = pm * 256; u.rows = nullptr; u.A = A + (size_t)pm * 256 * D * 2; u.B = B + (size_t)pn * 256 * D * 2; return true; }
    __device__ __forceinline__ void a_ready(const GUnit&) const {}
    __device__ __forceinline__ void done(const GUnit&) const {}
};
__device__ __forceinline__ void phase_gemm_in(const Ctx& c, int l) {
    SchedIn S{(const char*)(c.ws + WS_H), (const char*)(c.ws + WS_WIN) + (size_t)l * NINP * D * 2, c.nb, c.bid};
    EpiIn E{(bf16_t*)(c.ws + WS_UGLU), (bf16_t*)(c.ws + WS_RAW), (float*)(c.ws + WS_RAWF), (bf16_t*)(c.ws + WS_GATES)};
    pg8::gemm_phase<EpiIn, SchedIn, true, true>(c.lds, pg8::Gemm{D, D, opaque_u(D), T}, S, E, c.tid);
}

template <int PART>
__device__ __forceinline__ void phase_post_conv(const Ctx& c, int l) {
    const int gw = c.bid * NWAVES + c.wave, NGW = c.nb * NWAVES, lane = c.lane;
    const bf16_t* RAWB = (const bf16_t*)(c.ws + WS_RAW); const float* RAWF = (const float*)(c.ws + WS_RAWF);
    const float* cosH = (const float*)(c.ws + WS_TAB); const float* sinH = cosH + L * 32; const float* cosI = sinH + L * 32; const float* sinI = cosI + L * 16;
    bf16_t* QN = (bf16_t*)(c.ws + WS_QN); bf16_t* KN = (bf16_t*)(c.ws + WS_KN); bf16_t* VB = (bf16_t*)(c.ws + WS_VB);
    bf16_t* IQ = (bf16_t*)(c.ws + WS_IQ); bf16_t* IK = (bf16_t*)(c.ws + WS_IK); float* IW = (float*)(c.ws + WS_IW);
    const float* qg = c.in[6] + l * HD; const float* kg = c.in[7] + l * HD; float* PRo = (float*)(c.ws + WS_PR);
    float mxk0 = 0.f, mxk1 = 0.f;
    struct PostIn { f32x4 q0, q1, kv0, kv1, iq, ik, ch0, ch1, sh0, sh1, ci, si; float iw; };
    const int cc = lane & 7, c4 = cc & 3; const bool hi = cc >= 4;
    auto load_in = [&](int m) { PostIn p; const int t = m % L; const bf16_t* rb_ = RAWB + (size_t)m * 768; const float* r = RAWF + (size_t)m * 256;
        { const u32x4 wq = *(const u32x4*)(rb_ + 8 * lane); p.q0 = (f32x4){bflo(wq.x), bfhi(wq.x), bflo(wq.y), bfhi(wq.y)}; p.q1 = (f32x4){bflo(wq.z), bfhi(wq.z), bflo(wq.w), bfhi(wq.w)}; }
        const int off = (lane < 8) ? (8 * lane) : (64 + 8 * (lane & 7)); p.kv0 = *(const f32x4*)(r + off); p.kv1 = *(const f32x4*)(r + off + 4);
        { const u32x2 wi = *(const u32x2*)(rb_ + 512 + 4 * lane); p.iq = (f32x4){bflo(wi.x), bfhi(wi.x), bflo(wi.y), bfhi(wi.y)}; }
        p.ik = *(const f32x4*)(r + 128 + 4 * (lane & 7)); p.iw = r[160 + (lane & 7)];
        p.ch0 = *(const f32x4*)(cosH + t * 32 + 8 * c4); p.ch1 = *(const f32x4*)(cosH + t * 32 + 8 * c4 + 4); p.sh0 = *(const f32x4*)(sinH + t * 32 + 8 * c4); p.sh1 = *(const f32x4*)(sinH + t * 32 + 8 * c4 + 4);
        p.ci = *(const f32x4*)(cosI + t * 16 + 4 * c4); p.si = *(const f32x4*)(sinI + t * 16 + 4 * c4); return p; };
    float qgr[8], kgr[8];
    { const f32x4 a = *(const f32x4*)(qg + 8 * cc), b = *(const f32x4*)(qg + 8 * cc + 4), d = *(const f32x4*)(kg + 8 * cc), e = *(const f32x4*)(kg + 8 * cc + 4);
        qgr[0] = a.x; qgr[1] = a.y; qgr[2] = a.z; qgr[3] = a.w; qgr[4] = b.x; qgr[5] = b.y; qgr[6] = b.z; qgr[7] = b.w;
        kgr[0] = d.x; kgr[1] = d.y; kgr[2] = d.z; kgr[3] = d.w; kgr[4] = e.x; kgr[5] = e.y; kgr[6] = e.z; kgr[7] = e.w; }
    LAS unsigned* mxl = (LAS unsigned*)(c.lds + 64512);
    if (c.tid < 2) mxl[c.tid] = 0u;
    __syncthreads();
    PostIn nx = load_in(gw < T ? gw : 0);
    for (int m = gw; m < ((PART & 1) ? T : 0); m += NGW) {
        const PostIn p = nx; { const int mn = m + NGW; nx = load_in(mn < T ? mn : m); }
        const float csq[8] = {p.ch0.x, p.ch0.y, p.ch0.z, p.ch0.w, p.ch1.x, p.ch1.y, p.ch1.z, p.ch1.w}, snq[8] = {p.sh0.x, p.sh0.y, p.sh0.z, p.sh0.w, p.sh1.x, p.sh1.y, p.sh1.z, p.sh1.w};
        {
            float x[8] = {p.q0.x, p.q0.y, p.q0.z, p.q0.w, p.q1.x, p.q1.y, p.q1.z, p.q1.w}; float s = 0.f;
#pragma unroll
            for (int i = 0; i < 8; ++i) s += x[i] * x[i];
            s = oct_sum(s);
            const float rstd = __builtin_amdgcn_rsqf(s * (1.f / 64.f) + EPS); float o[8];
#pragma unroll
            for (int i = 0; i < 8; ++i) x[i] = x[i] * rstd * qgr[i];
#pragma unroll
            for (int i = 0; i < 8; ++i) { const float other = __shfl_xor(x[i], 4); o[i] = (hi ? (x[i] * csq[i] + other * snq[i]) : (x[i] * csq[i] - other * snq[i])) * 0.125f; }
            u32x4 w; w.x = pk2(o[0], o[1]); w.y = pk2(o[2], o[3]); w.z = pk2(o[4], o[5]); w.w = pk2(o[6], o[7]);
            *(u32x4*)(QN + (size_t)m * 512 + 8 * lane) = w;
        }
        {
            float x[8] = {p.kv0.x, p.kv0.y, p.kv0.z, p.kv0.w, p.kv1.x, p.kv1.y, p.kv1.z, p.kv1.w}; float s = 0.f;
#pragma unroll
            for (int i = 0; i < 8; ++i) s += x[i] * x[i];
            s = oct_sum(s);
            const float rstd = __builtin_amdgcn_rsqf(s * (1.f / 64.f) + EPS); float xn[8], o[8];
#pragma unroll
            for (int i = 0; i < 8; ++i) xn[i] = x[i] * rstd * kgr[i];
#pragma unroll
            for (int i = 0; i < 8; ++i) { const float other = __shfl_xor(xn[i], 4); o[i] = hi ? (xn[i] * csq[i] + other * snq[i]) : (xn[i] * csq[i] - other * snq[i]); }
            if (lane < 8) { u32x4 w; w.x = pk2(o[0], o[1]); w.y = pk2(o[2], o[3]); w.z = pk2(o[4], o[5]); w.w = pk2(o[6], o[7]); *(u32x4*)(KN + (size_t)m * 64 + 8 * lane) = w; }
            else if (lane < 16) { u32x4 w; w.x = pk2(x[0], x[1]); w.y = pk2(x[2], x[3]); w.z = pk2(x[4], x[5]); w.w = pk2(x[6], x[7]); *(u32x4*)(VB + (size_t)m * 64 + 8 * (lane & 7)) = w; }
        }
        const float csi[4] = {p.ci.x, p.ci.y, p.ci.z, p.ci.w}, sni[4] = {p.si.x, p.si.y, p.si.z, p.si.w};
        {
            const f32x4 a = p.iq; float o[4];
#pragma unroll
            for (int i = 0; i < 4; ++i) { const float other = __shfl_xor(a[i], 4); o[i] = hi ? (a[i] * csi[i] + other * sni[i]) : (a[i] * csi[i] - other * sni[i]); }
            u32x2 w; w.x = pk2(o[0], o[1]); w.y = pk2(o[2], o[3]); *(u32x2*)(IQ + (size_t)m * 256 + 4 * lane) = w;
            float n2 = bflo(w.x) * bflo(w.x) + bfhi(w.x) * bfhi(w.x) + bflo(w.y) * bflo(w.y) + bfhi(w.y) * bfhi(w.y);
            n2 = oct_sum(n2);
            const float wh = __shfl(p.iw, lane >> 3);
            const float prs = wave_sum((lane & 7) == 0 ? fabsf(wh) * sqrtf(n2) : 0.f);
            if (lane == 0) PRo[m] = prs;
        }
        {
            const f32x4 a = p.ik; float o[4];
#pragma unroll
            for (int i = 0; i < 4; ++i) { const float other = __shfl_xor(a[i], 4); o[i] = hi ? (a[i] * csi[i] + other * sni[i]) : (a[i] * csi[i] - other * sni[i]); }
            u32x2 w; w.x = pk2(o[0], o[1]); w.y = pk2(o[2], o[3]);
            if (lane < 8) *(u32x2*)(IK + (size_t)m * 32 + 4 * lane) = w;
            else if (lane < 16) IW[(size_t)m * 8 + (lane & 7)] = p.iw;
            float n2 = bflo(w.x) * bflo(w.x) + bfhi(w.x) * bfhi(w.x) + bflo(w.y) * bflo(w.y) + bfhi(w.y) * bfhi(w.y);
            n2 = oct_sum(n2);
            if (m < L) mxk0 = fmaxf(mxk0, n2); else mxk1 = fmaxf(mxk1, n2);
        }
    }
    if (lane == 0) { __hip_atomic_fetch_max(mxl, __float_as_uint(mxk0), __ATOMIC_RELAXED, __HIP_MEMORY_SCOPE_WORKGROUP); __hip_atomic_fetch_max(mxl + 1, __float_as_uint(mxk1), __ATOMIC_RELAXED, __HIP_MEMORY_SCOPE_WORKGROUP); }
    const bf16_t* UG = (const bf16_t*)(c.ws + WS_UGLU); bf16_t* YO = (bf16_t*)(c.ws + WS_YO);
    const float* cw = c.in[8] + (size_t)l * CONV_W * CONV_CH; const float* cb = c.in[9] + l * CONV_CH; const float* lg = c.in[10] + l * CONV_CH; const float* lb = c.in[11] + l * CONV_CH;
    LAS unsigned char* ut = c.lds; LAS float* st = (LAS float*)(c.lds + 63488); LAS f32x2* ys = (LAS f32x2*)(c.lds + 65536) + c.wave * 1024;
    const int half = c.wave >> 2, wq = c.wave & 3, ch = 128 * wq + 2 * lane;
    f32x2 w2[CONV_W];
#pragma unroll
    for (int j = 0; j < CONV_W; ++j) w2[j] = *(const f32x2*)(cw + j * CONV_CH + ch);
    const f32x2 bv = *(const f32x2*)(cb + ch), gv = *(const f32x2*)(lg + ch), lv = *(const f32x2*)(lb + ch);
    for (int tile = c.bid; tile < ((PART & 2) ? T / 32 : 0); tile += c.nb) {
        const int m0 = tile * 32, tl0 = m0 % L;
        __syncthreads();
        { u32x4 sv[8];
#pragma unroll
            for (int k = 0; k < 8; ++k) { const int i = c.tid + NTHREADS * k, row = i >> 6, pc = i & 63; sv[k] = (u32x4){0u, 0u, 0u, 0u};
                if (row < 62 && tl0 - 30 + row >= 0) sv[k] = *(const u32x4*)(UG + (size_t)(m0 - 30 + row) * 512 + 8 * pc); }
#pragma unroll
            for (int k = 0; k < 8; ++k) { const int i = c.tid + NTHREADS * k, row = i >> 6, pc = i & 63; if (row < 62) *(LAS u32x4*)(ut + row * 1024 + 16 * pc) = sv[k]; } }
        __syncthreads();
        {
            f32x2 y16[16];
#pragma unroll
            for (int tk = 0; tk < 16; ++tk) y16[tk] = bv;
            const LAS unsigned char* ub = ut + (16 * half) * 1024 + ch * 2;
#pragma unroll
            for (int i = 0; i < 46; ++i) { const unsigned uu = *(const LAS unsigned*)(ub + i * 1024); const f32x2 u2 = {bflo(uu), bfhi(uu)};
#pragma unroll
                for (int tk = 0; tk < 16; ++tk) if (i - tk >= 0 && i - tk < CONV_W) y16[tk] = __builtin_elementwise_fma(u2, w2[i - tk], y16[tk]); }
#pragma unroll
            for (int tk = 0; tk < 16; ++tk) { const int tr = 16 * half + tk; const f32x2 y2 = y16[tk];
                ys[tk * 64 + lane] = y2;
                const float s1 = wave_sum(y2.x + y2.y), s2 = wave_sum(y2.x * y2.x + y2.y * y2.y);
                if (lane == 0) { st[(tr * 4 + wq) * 2] = s1; st[(tr * 4 + wq) * 2 + 1] = s2; } } }
        __syncthreads();
#pragma unroll 1
        for (int tk = 0; tk < 16; ++tk) { const int tr = 16 * half + tk; const f32x2 y2 = ys[tk * 64 + lane];
            const f32x4 sa = *(const LAS f32x4*)(st + tr * 8), sb = *(const LAS f32x4*)(st + tr * 8 + 4);
            const float mu = ((sa.x + sa.z) + (sb.x + sb.z)) * (1.f / CONV_CH), ex2 = ((sa.y + sa.w) + (sb.y + sb.w)) * (1.f / CONV_CH);
            const float rstd = __builtin_amdgcn_rsqf(fmaxf(ex2 - mu * mu, 0.f) + EPS);
            const float o0 = siluf_((y2.x - mu) * rstd * gv.x + lv.x), o1 = siluf_((y2.y - mu) * rstd * gv.y + lv.y);
            *(unsigned*)(YO + (size_t)(m0 + tr) * 1024 + ch) = pk2(o0, o1); }
    }
    __syncthreads();
    if (c.tid < 2) atomicMax((unsigned*)(c.ws + WS_CTL + CTL_MAXIK) + l * 2 + c.tid, mxl[c.tid]);
}

typedef float f32x16 __attribute__((ext_vector_type(16)));
typedef short s16x4 __attribute__((ext_vector_type(4)));
constexpr int IDX_NB = 2048, IDX_QB = 16, IDX_G = 4;
#ifndef IDX_ZOOM
#define IDX_ZOOM 3
#endif
#ifndef IDX_CAP
#define IDX_CAP 256
#endif
constexpr int IL_HIST = 0;
constexpr int IL_FHIST = 32768;
constexpr int IL_VS = 32768;
constexpr int IL_MASK = 114688;
constexpr int IL_SEL = 131072;
constexpr int IL_QI = 139264;
constexpr int IL_FMISC = IL_QI + 512;
constexpr int IL_FIQ = IL_FMISC + 128;

__device__ __forceinline__ unsigned score_key(float s) { s += 0.f; const unsigned u = __float_as_uint(s); return (u & 0x80000000u) ? ~u : (u | 0x80000000u); }

template <int PASS, int MODE, bool EDGE>
__device__ __forceinline__ void idx_tile(LAS unsigned char* lds, const bf16x8 b0, const bf16x8 b1, int kt, const bf16x8 (&A)[IDX_G][2], const float (&w)[IDX_G][16], const float (&scq)[IDX_G][2], const float (&thr)[IDX_G][2], const float (&thr1)[IDX_G][2], const f32x16& zero16, int t0, int lane) {
    const int r32 = lane & 31, hi = lane >> 5, key = kt * 32 + r32;
    LAS unsigned* mask = (LAS unsigned*)(lds + IL_MASK); LAS int* qi = (LAS int*)(lds + IL_QI); LAS u32x2* cand = (LAS u32x2*)(lds + IL_HIST);
#pragma unroll
    for (int g = 0; g < IDX_G; ++g) {
        f32x16 acc = __builtin_amdgcn_mfma_f32_32x32x16_bf16(A[g][0], b0, zero16, 0, 0, 0);
        acc = __builtin_amdgcn_mfma_f32_32x32x16_bf16(A[g][1], b1, acc, 0, 0, 0);
#pragma unroll
        for (int j = 0; j < 2; ++j) {
            float sA = 0.f, sB = 0.f;
#pragma unroll
            for (int h = 0; h < 8; h += 2) { const float r0 = __builtin_amdgcn_fmed3f(acc[8 * j + h], 0.f, 3.0e38f), r1 = __builtin_amdgcn_fmed3f(acc[8 * j + h + 1], 0.f, 3.0e38f);
                sA = fmaf(r0, w[g][8 * j + h], sA); sB = fmaf(r1, w[g][8 * j + h + 1], sB); }
            asm volatile("" : "+v"(sA), "+v"(sB));
            const float sc = sA + sB;
            const int ql = 4 * g + 2 * hi + j;
            const bool valid = !EDGE || key <= t0 + ql;
            const float xu = fmaf(sc, scq[g][j], (float)(IDX_NB / 2)); const float x = (PASS == 1) ? __builtin_amdgcn_fmed3f(xu, 0.f, (float)IDX_NB - 0.5f) : xu;
            if (PASS == 1) { const unsigned bin = (unsigned)x;
                if (MODE & 4) { asm volatile("" :: "v"(bin), "v"((int)valid)); }
                else { const unsigned addr = ((bin & 0x7feu) << 1) + (unsigned)(IL_HIST + ql * 4096); unsigned val = 1u << ((bin << 4) & 31u); if (EDGE) val = valid ? val : 0u;
                    lds_add((LAS unsigned*)(lds + addr), val); }
            } else {
                const bool ge1 = x >= thr1[g][j], ge0 = x >= thr[g][j];
                const bool above = valid && ge1, cnd = valid && ge0 && !ge1;
                const unsigned long long bal = __ballot(above);
                if (r32 == 0) mask[ql * 256 + kt] = hi ? (unsigned)(bal >> 32) : (unsigned)bal;
                if (cnd) { const int pos = lds_addi(qi + ql * 8 + 3, 1); if (pos < IDX_CAP) cand[ql * 256 + pos] = (u32x2){__float_as_uint(sc + 0.f), (unsigned)key}; }
            }
        }
    }
}
constexpr int IDX_RING = 2;
__device__ __forceinline__ void idx_ring_fill(bf16x8 (&rb)[IDX_RING][2], const bf16_t* IKb, int NT, int wave, int lane) {
    const bf16_t* kp = IKb + (size_t)(lane & 31) * 32 + 8 * (lane >> 5);
#pragma unroll
    for (int d = 0; d < IDX_RING; ++d) { int k2 = wave + 8 * d; k2 = k2 < NT ? k2 : NT - 1; rb[d][0] = *(const bf16x8*)(kp + (size_t)k2 * 1024); rb[d][1] = *(const bf16x8*)(kp + (size_t)k2 * 1024 + 16); }
}
template <int PASS, int MODE>
__device__ __forceinline__ void idx_pass(LAS unsigned char* lds, const bf16_t* IKb, bf16x8 (&rb)[IDX_RING][2], const bf16x8 (&A)[IDX_G][2], const float (&w)[IDX_G][16], const float (&scq)[IDX_G][2], const float (&thr)[IDX_G][2], const float (&thr1)[IDX_G][2], int t0, int NT, int wave, int lane) {
    const int r32 = lane & 31, hi = lane >> 5;
    const bf16_t* kp = IKb + (size_t)r32 * 32 + 8 * hi;
    f32x16 zero16;
#pragma unroll
    for (int i = 0; i < 16; ++i) zero16[i] = 0.f;
    asm volatile("" : "+v"(zero16));
#pragma unroll 1
    for (int kt = wave; kt < NT; kt += IDX_RING * NWAVES) {
#pragma unroll
        for (int d = 0; d < IDX_RING; ++d) { const int ktd = kt + 8 * d;
            const bf16x8 c0 = rb[d][0], c1 = rb[d][1];
            { int k2 = ktd + IDX_RING * NWAVES; if (k2 >= NT) { k2 = wave + 8 * d; k2 = k2 < NT ? k2 : NT - 1; } rb[d][0] = *(const bf16x8*)(kp + (size_t)k2 * 1024); rb[d][1] = *(const bf16x8*)(kp + (size_t)k2 * 1024 + 16); }
            if (ktd < NT) { if (32 * ktd + 31 <= t0) idx_tile<PASS, MODE, false>(lds, c0, c1, ktd, A, w, scq, thr, thr1, zero16, t0, lane); else idx_tile<PASS, MODE, true>(lds, c0, c1, ktd, A, w, scq, thr, thr1, zero16, t0, lane); } }
    }
}

__device__ __forceinline__ void idx_fallback(const Ctx& c, const bf16_t* IQ, const bf16_t* IK, const float* IW, size_t kb, int t, int ql) {
    LAS unsigned* keys = (LAS unsigned*)(c.lds + IL_HIST); LAS unsigned* hist = (LAS unsigned*)(c.lds + IL_FHIST); LAS int* misc = (LAS int*)(c.lds + IL_FMISC);
    LAS float* iqs = (LAS float*)(c.lds + IL_FIQ); LAS float* iws = iqs + 256; LAS unsigned* mask = (LAS unsigned*)(c.lds + IL_MASK);
    const int tid = c.tid, lane = c.lane, wave = c.wave, n = t + 1; const size_t q = kb + t;
    if (tid < 256) iqs[tid] = bf2f(IQ[q * 256 + tid]);
    if (tid < 8) iws[tid] = IW[q * 8 + tid];
    if (tid == 0) { misc[0] = 0; misc[1] = TOPK; }
    __syncthreads();
#pragma unroll 1
    for (int s = tid; s < n; s += NTHREADS) {
        const u32x4* kr = (const u32x4*)(IK + (kb + s) * 32);
        float sc = 0.f;
#pragma unroll 1
        for (int h = 0; h < 8; ++h) { float d = 0.f;
#pragma unroll 1
            for (int i = 0; i < 4; ++i) { asm volatile("" ::: "memory"); const u32x4 w = kr[i]; const f32x4 q0 = *(const LAS f32x4*)(iqs + 32 * h + 8 * i), q1 = *(const LAS f32x4*)(iqs + 32 * h + 8 * i + 4);
                d += q0.x * bflo(w.x) + q0.y * bfhi(w.x) + q0.z * bflo(w.y) + q0.w * bfhi(w.y) + q1.x * bflo(w.z) + q1.y * bfhi(w.z) + q1.z * bflo(w.w) + q1.w * bfhi(w.w); }
            sc = fmaf(fmaxf(d, 0.f), iws[h], sc); }
        keys[s] = score_key(sc);
    }
    for (int rd = 0; rd < 4; ++rd) {
        const int shift = 24 - 8 * rd;
        if (tid < 256) hist[tid] = 0u;
        __syncthreads();
        const unsigned prefix = (unsigned)misc[0];
        for (int s = tid; s < n; s += NTHREADS) { const unsigned k = keys[s]; if (rd == 0 || (k >> (shift + 8)) == prefix) lds_add(&hist[(k >> shift) & 255u], 1u); }
        __syncthreads();
        if (wave == 0) {
            const int need = misc[1];
            unsigned cb[4]; unsigned sl = 0;
#pragma unroll
            for (int j = 0; j < 4; ++j) { cb[j] = hist[4 * lane + j]; sl += cb[j]; }
            const unsigned pre = wave_incl_scan(sl), totw = (unsigned)__builtin_amdgcn_readlane((int)pre, 63);
            const unsigned suf = totw - pre + sl;
            unsigned above = suf - sl;
            if (above < (unsigned)need && (unsigned)need <= suf) {
                bool done = false;
#pragma unroll
                for (int j = 3; j >= 0; --j) { if (!done) { if ((unsigned)need <= above + cb[j]) { misc[0] = (int)((prefix << 8) | (unsigned)(4 * lane + j)); misc[1] = need - (int)above; misc[2] = (int)cb[j]; done = true; } else above += cb[j]; } }
            }
        }
        __syncthreads();
    }
    const unsigned Tk = (unsigned)misc[0]; const int need_eq = misc[1];
    const int seg = (((n + 7) >> 3) + 63) & ~63, s_lo = wave * seg, s_hi = (s_lo + seg < n) ? (s_lo + seg) : n;
    int neq = 0;
    for (int s0 = s_lo; s0 < s_hi; s0 += 64) { const int s = s0 + lane; const bool eq = (s < s_hi) && keys[s] == Tk; neq += __popcll(__ballot(eq)); }
    if (lane == 0) misc[12 + wave] = neq;
    __syncthreads();
    int peq = 0;
    for (int w = 0; w < wave; ++w) peq += misc[12 + w];
    for (int s0 = s_lo; s0 < s_hi; s0 += 64) { const int s = s0 + lane; const unsigned k = (s < s_hi) ? keys[s] : 0u; const bool gt = (s < s_hi) && k > Tk, eq = (s < s_hi) && k == Tk;
        const unsigned long long be_ = __ballot(eq); const int myeq = peq + __popcll(be_ & ((1ull << lane) - 1ull));
        const unsigned long long bs = __ballot(gt || (eq && myeq < need_eq));
        if (lane == 0) { mask[ql * 256 + (s0 >> 5)] = (unsigned)bs; if ((s0 >> 5) + 1 < 256) mask[ql * 256 + (s0 >> 5) + 1] = (unsigned)(bs >> 32); }
        peq += __popcll(be_); }
    __syncthreads();
}

__device__ __forceinline__ void idx_attend(LAS unsigned char* lds, const bf16_t* QN, const bf16_t* KN, const bf16_t* VB, bf16_t* YO, size_t kb, int t, int ql, int NT, int wave, int lane) {
    LAS unsigned* mask = (LAS unsigned*)(lds + IL_MASK) + ql * 256; LAS int* sel = (LAS int*)(lds + IL_SEL) + wave * 256; LAS unsigned char* vs = lds + IL_VS + wave * 10240;
    const size_t tok = kb + t; const int fr = lane & 15, fq = lane >> 4;
    unsigned wd[4]; int cntl = 0;
#pragma unroll
    for (int i = 0; i < 4; ++i) { const int kt = 4 * lane + i; wd[i] = (kt < NT) ? mask[kt] : 0u; cntl += __popc(wd[i]); }
    const int incl = (int)wave_incl_scan((unsigned)cntl);
    const int nsel = __builtin_amdgcn_readlane(incl, 63); int pos = incl - cntl;
#pragma unroll
    for (int i = 0; i < 4; ++i) { unsigned wv = wd[i]; while (wv) { const int bpos = __builtin_ctz(wv); if (pos < 256) sel[pos] = (4 * lane + i) * 32 + bpos; ++pos; wv &= wv - 1u; } }
    for (int p = nsel + lane; p < 256; p += 64) sel[p] = 0;
    asm volatile("s_waitcnt lgkmcnt(0)" ::: "memory");
    const bf16_t* qrow = QN + tok * 512 + (fr & 7) * 64 + 8 * fq; const bf16x8 qb0 = *(const bf16x8*)qrow, qb1 = *(const bf16x8*)(qrow + 32);
    u32x4 vr[2][8];
#pragma unroll
    for (int c2 = 0; c2 < 2; ++c2)
#pragma unroll
        for (int i = 0; i < 8; ++i) { const int key = sel[64 * c2 + (lane >> 3) + 8 * i]; vr[c2][i] = *(const u32x4*)(VB + (kb + key) * 64 + 8 * (lane & 7)); }
    f32x4 sc[16];
#pragma unroll
    for (int hb = 0; hb < 2; ++hb) {
        bf16x8 kf[8][2];
#pragma unroll
        for (int k8 = 0; k8 < 8; ++k8) { const int key = sel[16 * (8 * hb + k8) + fr]; const bf16_t* kr = KN + (kb + key) * 64 + 8 * fq; kf[k8][0] = *(const bf16x8*)kr; kf[k8][1] = *(const bf16x8*)(kr + 32); }
        __builtin_amdgcn_sched_barrier(0);
#pragma unroll
        for (int k8 = 0; k8 < 8; ++k8) { f32x4 a = {0.f, 0.f, 0.f, 0.f}; a = __builtin_amdgcn_mfma_f32_16x16x32_bf16(kf[k8][0], qb0, a, 0, 0, 0); a = __builtin_amdgcn_mfma_f32_16x16x32_bf16(kf[k8][1], qb1, a, 0, 0, 0); sc[8 * hb + k8] = a; }
        __builtin_amdgcn_sched_barrier(0);
    }
    float mx = -INFINITY;
    if (nsel < 256) {
#pragma unroll
        for (int kt = 0; kt < 16; ++kt)
#pragma unroll
            for (int i = 0; i < 4; ++i) if (16 * kt + 4 * fq + i >= nsel) sc[kt][i] = -INFINITY; }
#pragma unroll
    for (int kt = 0; kt < 16; ++kt)
#pragma unroll
        for (int i = 0; i < 4; ++i) mx = fmaxf(mx, sc[kt][i]);
    mx = fmaxf(mx, xor16_f(mx)); mx = max_x32(mx);
    float sm = 0.f;
#pragma unroll
    for (int kt = 0; kt < 16; ++kt)
#pragma unroll
        for (int i = 0; i < 4; ++i) { sc[kt][i] = __expf(sc[kt][i] - mx); sm += sc[kt][i]; }
    sm += xor16_f(sm); sm = sum_x32(sm);
    const float inv = __builtin_amdgcn_rcpf(sm);
    bf16x8 pf[8];
#pragma unroll
    for (int s = 0; s < 8; ++s) { const u32x2 lo = pack4(sc[2 * s] * inv), hi2 = pack4(sc[2 * s + 1] * inv); const u32x4 w4 = {lo.x, lo.y, hi2.x, hi2.y}; pf[s] = __builtin_bit_cast(bf16x8, w4); }
    f32x4 o[4];
#pragma unroll
    for (int dt = 0; dt < 4; ++dt) o[dt] = (f32x4){0.f, 0.f, 0.f, 0.f};
#pragma unroll
    for (int ch = 0; ch < 4; ++ch) {
#pragma unroll
        for (int i = 0; i < 8; ++i) *(LAS u32x4*)(vs + ((lane >> 3) + 8 * i) * 160 + 16 * (lane & 7)) = vr[ch & 1][i];
        if (ch < 2) {
#pragma unroll
            for (int i = 0; i < 8; ++i) { const int key = sel[64 * (ch + 2) + (lane >> 3) + 8 * i]; vr[ch & 1][i] = *(const u32x4*)(VB + (kb + key) * 64 + 8 * (lane & 7)); } }
        __builtin_amdgcn_sched_barrier(0);
#pragma unroll
        for (int ls = 0; ls < 2; ++ls)
#pragma unroll
            for (int dt = 0; dt < 4; ++dt) {
                LAS unsigned char* ad = vs + (32 * ls + 4 * fq + (fr >> 2)) * 160 + (16 * dt + 4 * (lane & 3)) * 2;
                const s16x4 lo = __builtin_amdgcn_ds_read_tr16_b64_v4i16((LAS s16x4*)ad), hi2 = __builtin_amdgcn_ds_read_tr16_b64_v4i16((LAS s16x4*)(ad + 16 * 160));
                const bf16x8 vf = {lo[0], lo[1], lo[2], lo[3], hi2[0], hi2[1], hi2[2], hi2[3]};
                o[dt] = __builtin_amdgcn_mfma_f32_16x16x32_bf16(vf, pf[2 * ch + ls], o[dt], 0, 0, 0);
            }
        __builtin_amdgcn_sched_barrier(0);
    }
    if (fr < 8) {
#pragma unroll
        for (int dt = 0; dt < 4; ++dt) *(u32x2*)(YO + tok * 1024 + 512 + fr * 64 + 16 * dt + 4 * fq) = pack4(o[dt]);
    }
}

template <int MODE  >
__device__ __forceinline__ void phase_idx_attn(const Ctx& c, int l) {
    const int tid = c.tid, lane = c.lane, wave = c.wave;
    const bf16_t* QN = (const bf16_t*)(c.ws + WS_QN); const bf16_t* KN = (const bf16_t*)(c.ws + WS_KN); const bf16_t* VB = (const bf16_t*)(c.ws + WS_VB);
    const bf16_t* IQ = (const bf16_t*)(c.ws + WS_IQ); const bf16_t* IK = (const bf16_t*)(c.ws + WS_IK); const float* IW = (const float*)(c.ws + WS_IW);
    bf16_t* YO = (bf16_t*)(c.ws + WS_YO);
    LAS int* qi = (LAS int*)(c.lds + IL_QI);
    const unsigned* maxik = (const unsigned*)(c.ws + WS_CTL + CTL_MAXIK) + l * 2; const float* PR = (const float*)(c.ws + WS_PR);
    constexpr int UPB = L / IDX_QB;
    for (int o = c.bid; o < 2 * UPB; o += c.nb) {
        const int b = o / UPB, w_ = o % UPB, ub = (w_ < UPB / 2) ? w_ : (UPB + UPB / 2 - 1 - w_);
        const int t0 = ub * IDX_QB, NT = (t0 + IDX_QB + 31) >> 5; const size_t kb = (size_t)b * L;
        const bool need_select = (t0 + IDX_QB - 1 >= TOPK) && !(MODE & 2);
        __syncthreads();
        { LAS u32x4* h4 = (LAS u32x4*)(c.lds + IL_HIST);
#pragma unroll
            for (int i = 0; i < 8; ++i) h4[tid + NTHREADS * i] = (u32x4){0u, 0u, 0u, 0u}; }
        if (tid < IDX_QB) { qi[tid * 8 + 1] = -1; qi[tid * 8 + 2] = 0; qi[tid * 8 + 3] = 0; qi[tid * 8 + 4] = 0; }
        const int NTP = (MODE & 16) ? 8 : NT;
        if (need_select) {
            int lane1 = lane; asm volatile("" : "+v"(lane1));
            const int r32 = lane1 & 31, hi = lane1 >> 5;
            bf16x8 A[IDX_G][2]; float w[IDX_G][16]; float scq[IDX_G][2]; float thr[IDX_G][2], thr1[IDX_G][2]; bf16x8 rb[IDX_RING][2];
            const int qsel = 2 * ((r32 >> 2) & 1) + ((r32 >> 4) & 1), head = (r32 & 3) + 4 * ((r32 >> 3) & 1);
            const float mk = sqrtf(__uint_as_float(maxik[b])) * 1.001f;
#pragma unroll
            for (int g = 0; g < IDX_G; ++g) { const bf16_t* ar = IQ + (kb + t0 + 4 * g + qsel) * 256 + head * 32 + 8 * hi; A[g][0] = *(const bf16x8*)ar; A[g][1] = *(const bf16x8*)(ar + 16);
#pragma unroll
                for (int j = 0; j < 2; ++j) { const int ql = 4 * g + 2 * hi + j; const f32x4 w0 = *(const f32x4*)(IW + (kb + t0 + ql) * 8), w1 = *(const f32x4*)(IW + (kb + t0 + ql) * 8 + 4);
                    w[g][8 * j + 0] = w0.x; w[g][8 * j + 1] = w0.y; w[g][8 * j + 2] = w0.z; w[g][8 * j + 3] = w0.w; w[g][8 * j + 4] = w1.x; w[g][8 * j + 5] = w1.y; w[g][8 * j + 6] = w1.z; w[g][8 * j + 7] = w1.w;
                    scq[g][j] = (float)(IDX_ZOOM * (IDX_NB / 2)) / (PR[kb + t0 + ql] * mk + 1e-30f); thr[g][j] = -1.f; thr1[g][j] = 0.f; } }
            idx_ring_fill(rb, IK + kb * 32, NTP, wave, lane1);
            __syncthreads();
            idx_pass<1, MODE>(c.lds, IK + kb * 32, rb, A, w, scq, thr, thr1, t0, NTP, wave, lane1);
            __syncthreads();
#pragma unroll 1
            for (int qq = 0; qq < 2; ++qq) { const int ql = 2 * wave + qq;
                if (t0 + ql + 1 > TOPK) {
                    const LAS u32x4* hq = (const LAS u32x4*)(c.lds + IL_HIST + ql * 4096) + 4 * lane; unsigned wv[16]; unsigned tot = 0;
#pragma unroll
                    for (int i = 0; i < 4; ++i) { const u32x4 x = hq[i]; wv[4 * i] = x.x; wv[4 * i + 1] = x.y; wv[4 * i + 2] = x.z; wv[4 * i + 3] = x.w; }
#pragma unroll
                    for (int i = 0; i < 16; ++i) tot += (wv[i] & 0xffffu) + (wv[i] >> 16);
                    const unsigned pre = wave_incl_scan(tot), totw = (unsigned)__builtin_amdgcn_readlane((int)pre, 63);
                    const unsigned suf = totw - pre + tot;
                    unsigned above = suf - tot;
                    if (above < (unsigned)TOPK && (unsigned)TOPK <= suf) { bool done = false;
#pragma unroll
                        for (int i = 15; i >= 0; --i)
#pragma unroll
                            for (int hf = 1; hf >= 0; --hf) { const unsigned cn = hf ? (wv[i] >> 16) : (wv[i] & 0xffffu);
                                if (!done) { if ((unsigned)TOPK <= above + cn) { qi[ql * 8 + 1] = 2 * (16 * lane + i) + hf; qi[ql * 8 + 2] = TOPK - (int)above; done = true; } else above += cn; } } }
                } }
            __syncthreads();
#pragma unroll
            for (int g = 0; g < IDX_G; ++g)
#pragma unroll
                for (int j = 0; j < 2; ++j) { const int tb = qi[(4 * g + 2 * hi + j) * 8 + 1]; const float tf = (float)tb; thr[g][j] = (tb <= 0) ? -INFINITY : tf; thr1[g][j] = (tb < 0) ? -INFINITY : ((tb >= IDX_NB - 1) ? INFINITY : tf + 1.f); }
            if (!(MODE & 8)) idx_pass<2, MODE>(c.lds, IK + kb * 32, rb, A, w, scq, thr, thr1, t0, NTP, wave, lane1);
            __syncthreads();
#pragma unroll 1
            for (int qq = 0; qq < 2; ++qq) { const int ql = 2 * wave + qq; const int cn = qi[ql * 8 + 3], need = qi[ql * 8 + 2];
                if (cn > IDX_CAP) { if (lane == 0) qi[ql * 8 + 4] = 1; }
                else { const LAS u32x2* cd = (const LAS u32x2*)(c.lds + IL_HIST) + ql * 256; LAS unsigned* mq = (LAS unsigned*)(c.lds + IL_MASK) + ql * 256;
                    for (int i0 = 0; i0 < cn; i0 += 64) { const int i = i0 + lane; const u32x2 me = cd[i < cn ? i : 0]; const float ms = __uint_as_float(me.x); int rank = 0;
                        for (int j = 0; j < cn; ++j) { const u32x2 ot = cd[j]; const float os = __uint_as_float(ot.x); rank += (os > ms || (os == ms && ot.y < me.y)) ? 1 : 0; }
                        if (i < cn && rank < need) __hip_atomic_fetch_or(mq + (me.y >> 5), 1u << (me.y & 31u), __ATOMIC_RELAXED, __HIP_MEMORY_SCOPE_WORKGROUP); } } }
            __syncthreads();
#pragma unroll 1
            for (int ql = 0; ql < IDX_QB; ++ql) if (qi[ql * 8 + 4] != 0) idx_fallback(c, IQ, IK, IW, kb, t0 + ql, ql);
        } else {
            __syncthreads();
            LAS unsigned* mask = (LAS unsigned*)(c.lds + IL_MASK);
            for (int i = tid; i < IDX_QB * NT; i += NTHREADS) { const int ql = i / NT, kt = i % NT; const int hi_key = t0 + ql - 32 * kt;
                mask[ql * 256 + kt] = hi_key < 0 ? 0u : (hi_key >= 31 ? 0xffffffffu : ((2u << hi_key) - 1u)); }
            __syncthreads();
        }
        if (!(MODE & 1)) {
#pragma unroll 1
            for (int qq = 0; qq < 2; ++qq) { int lane2 = lane; asm volatile("" : "+v"(lane2)); idx_attend(c.lds, QN, KN, VB, YO, kb, t0 + 2 * wave + qq, 2 * wave + qq, NT, wave, lane2); } }
    }
}

struct EpiD1 {
    EPI_COMMON_P
    const bf16_t* gates; const float* bc; bf16_t* Mo;
    __device__ __forceinline__ void half(const f32x4 (&acc)[2][4][2], int ai, const GUnit& u, int wr, int wc, int fr, int fq) const {
        const int which = u.aux;
#pragma unroll
        for (int m = 0; m < 4; ++m) { const size_t row = (size_t)u.row0 + 128 * ai + 64 * wr + 16 * m + fr;
#pragma unroll
            for (int bj = 0; bj < 2; ++bj) { const int col = 256 * u.pn + 128 * bj + 32 * wc + 8 * fq;
                const u32x4 gw = *(const u32x4*)(gates + row * 2048 + which * 1024 + col);
                const f32x4 g0 = {bflo(gw.x), bfhi(gw.x), bflo(gw.y), bfhi(gw.y)}, g1 = {bflo(gw.z), bfhi(gw.z), bflo(gw.w), bfhi(gw.w)}; f32x4 o0, o1;
                if (which == 0) { o0 = g0 * (acc[bj][m][0] + *(const f32x4*)(bc + col)); o1 = g1 * (acc[bj][m][1] + *(const f32x4*)(bc + col + 4)); }
                else { const u32x4 pw = *(const u32x4*)(Mo + row * 1024 + col);
                    o0 = (f32x4){bflo(pw.x), bfhi(pw.x), bflo(pw.y), bfhi(pw.y)} + g0 * acc[bj][m][0]; o1 = (f32x4){bflo(pw.z), bfhi(pw.z), bflo(pw.w), bfhi(pw.w)} + g1 * acc[bj][m][1]; }
                *(u32x4*)(Mo + row * 1024 + col) = pack8(o0, o1); } }
    }
};
struct SchedD1 { static constexpr int A_AUX = 0; const char* A; const char* B; int G, c;
    __device__ __forceinline__ bool next(int i, GUnit& u) const { const int Lq = (i >> 1) * G + c, which = i & 1; if (Lq >= 64 * 4) return false; int pm, pn; pg8::tile_order(Lq, 64, 4, pm, pn);
        u.pm = pm; u.pn = pn; u.aux = which; u.row0 = pm * 256; u.rows = nullptr; u.A = A + ((size_t)pm * 256 * 1024 + which * 512) * 2; u.B = B + ((size_t)pn * 256 * 1024 + which * 512) * 2; return true; }
    __device__ __forceinline__ void a_ready(const GUnit&) const {}
    __device__ __forceinline__ void done(const GUnit&) const {}
};
__device__ __forceinline__ void phase_gemm_d1(const Ctx& c, int l) {
    SchedD1 S{(const char*)(c.ws + WS_YO), (const char*)(c.ws + WS_WCA) + (size_t)l * D * D * 2, c.nb, c.bid};
    EpiD1 E{(const bf16_t*)(c.ws + WS_GATES), c.in[13] + l * D, (bf16_t*)(c.ws + WS_H)};
    pg8::gemm_phase<EpiD1, SchedD1, true, true>(c.lds, pg8::Gemm{1024, 1024, opaque_u(512), T}, S, E, c.tid);
}
template <bool XBF>
struct EpiD2 {
    EPI_COMMON_P
    const void* xin; bf16_t* xout; const float* gate;
    __device__ __forceinline__ void half(const f32x4 (&acc)[2][4][2], int ai, const GUnit& u, int wr, int wc, int fr, int fq) const {
        const float* gb = gate + (u.row0 / L) * 6144;
#pragma unroll
        for (int m = 0; m < 4; ++m) { const size_t row = (size_t)u.row0 + 128 * ai + 64 * wr + 16 * m + fr;
#pragma unroll
            for (int bj = 0; bj < 2; ++bj) { const int col = 256 * u.pn + 128 * bj + 32 * wc + 8 * fq; f32x4 x0, x1;
                if (XBF) { const u32x4 xw = *(const u32x4*)((const bf16_t*)xin + row * D + col); x0 = (f32x4){bflo(xw.x), bfhi(xw.x), bflo(xw.y), bfhi(xw.y)}; x1 = (f32x4){bflo(xw.z), bfhi(xw.z), bflo(xw.w), bfhi(xw.w)}; }
                else { x0 = *(const f32x4*)((const float*)xin + row * D + col); x1 = *(const f32x4*)((const float*)xin + row * D + col + 4); }
                const f32x4 g0 = *(const f32x4*)(gb + col), g1 = *(const f32x4*)(gb + col + 4);
                *(u32x4*)(xout + row * D + col) = pack8(x0 + g0 * acc[bj][m][0], x1 + g1 * acc[bj][m][1]); } }
    }
};
struct SchedD2 { static constexpr int A_AUX = 0; const char* A; const char* B; int G, c;
    __device__ __forceinline__ bool next(int i, GUnit& u) const { const int Lq = i * G + c; if (Lq >= 64 * 4) return false; int pm, pn; pg8::tile_order(Lq, 64, 4, pm, pn);
        u.pm = pm; u.pn = pn; u.aux = 0; u.row0 = pm * 256; u.rows = nullptr; u.A = A + (size_t)pm * 256 * D * 2; u.B = B + (size_t)pn * 256 * D * 2; return true; }
    __device__ __forceinline__ void a_ready(const GUnit&) const {}
    __device__ __forceinline__ void done(const GUnit&) const {}
};
__device__ __forceinline__ void phase_gemm_d2(const Ctx& c, int l) {
    SchedD2 S{(const char*)(c.ws + WS_H), (const char*)(c.ws + WS_WO) + (size_t)l * D * D * 2, c.nb, c.bid};
    const float* gate = (const float*)(c.ws + WS_CTL + CTL_MOD) + (l * 2) * 6144 + 2 * D; bf16_t* X1 = (bf16_t*)(c.ws + WS_X1);
    if (l == 0) { EpiD2<false> E{c.in[0], X1, gate}; pg8::gemm_phase<EpiD2<false>, SchedD2, true, true>(c.lds, pg8::Gemm{D, D, opaque_u(D), T}, S, E, c.tid); }
    else { EpiD2<true> E{c.out, X1, gate}; pg8::gemm_phase<EpiD2<true>, SchedD2, true, true>(c.lds, pg8::Gemm{D, D, opaque_u(D), T}, S, E, c.tid); }
}

constexpr int RT_ROWE = 1032, RT_WLO = 36 * RT_ROWE * 2, RT_LG = 2 * RT_WLO;
template <bool DRY>
__device__ __forceinline__ void phase_norm2_route(const Ctx& c, int l) {
    LAS bf16_t* Whi = (LAS bf16_t*)c.lds; LAS bf16_t* Wlo = (LAS bf16_t*)(c.lds + RT_WLO);
    { const u32x4* img = (const u32x4*)(c.ws + WS_RTW + (size_t)l * RT_LG); LAS u32x4* dst = (LAS u32x4*)c.lds;
        for (int i = c.tid; i < RT_LG / 16; i += NTHREADS) dst[i] = img[i]; }
    LAS int* lcnt = (LAS int*)(c.lds + RT_LG + 12288 + 128); LAS int* gbase = lcnt + 64;
    if (c.tid < NE) lcnt[c.tid] = 0;
    __syncthreads();
    const int lane = c.lane, wave = c.wave, tk = lane & 7, fr = lane & 15, fq = lane >> 4;
    const float* mod = (const float*)(c.ws + WS_CTL + CTL_MOD); const float* g2 = c.in[16] + l * D;
    int* cnt = (int*)(c.ws + WS_CTL + CTL_CNT) + l * NE; bf16_t* H2 = (bf16_t*)(c.ws + WS_H2);
    i32x4* rt = (i32x4*)(c.ws + WS_ROUTE); f32x2* rw = (f32x2*)(c.ws + WS_ROUTE + 512 * 1024); int* inv = (int*)(c.ws + WS_INV);
    const float* bg = c.in[18] + l * NG; const float* br = c.in[20] + l * NE;
    LAS float* LG = (LAS float*)(c.lds + RT_LG) + wave * (8 * 48);
    for (int m0 = c.bid * 64; m0 < T; m0 += c.nb * 64) {
        const int m = m0 + 8 * wave + tk; const float* mb = mod + (l * 2 + m0 / L) * 6144; const bf16_t* xr = (const bf16_t*)(c.ws + WS_X1) + (size_t)m * D + 8 * fq;
        float ssq = 0.f;
#pragma unroll
        for (int ch = 0; ch < 2; ++ch) { u32x4 xw[16];
#pragma unroll
            for (int s8 = 0; s8 < 16; ++s8) xw[s8] = *(const u32x4*)(xr + 32 * (16 * ch + s8));
#pragma unroll
            for (int s8 = 0; s8 < 16; ++s8) { const f32x4 xa = {bflo(xw[s8].x), bfhi(xw[s8].x), bflo(xw[s8].y), bfhi(xw[s8].y)}, xb = {bflo(xw[s8].z), bfhi(xw[s8].z), bflo(xw[s8].w), bfhi(xw[s8].w)};
                ssq += (xa.x * xa.x + xa.y * xa.y) + (xa.z * xa.z + xa.w * xa.w) + (xb.x * xb.x + xb.y * xb.y) + (xb.z * xb.z + xb.w * xb.w); } }
        ssq += xor16_f(ssq); ssq = sum_x32(ssq);
        const float rstd = __builtin_amdgcn_rsqf(ssq * (1.f / D) + EPS);
        f32x4 acc[3];
#pragma unroll
        for (int n = 0; n < 3; ++n) acc[n] = (f32x4){0.f, 0.f, 0.f, 0.f};
        const int wrow[3] = {fr, 16 + fr, (32 + fr) < 36 ? 32 + fr : 35};
#pragma unroll 2
        for (int s = 0; s < 32; ++s) { const int k0 = 32 * s + 8 * fq;
            const u32x4 xw = *(const u32x4*)(xr + 32 * s); const f32x4 x0 = {bflo(xw.x), bfhi(xw.x), bflo(xw.y), bfhi(xw.y)}, x1 = {bflo(xw.z), bfhi(xw.z), bflo(xw.w), bfhi(xw.w)};
            const f32x4 ga = *(const f32x4*)(g2 + k0), gb = *(const f32x4*)(g2 + k0 + 4), sa = *(const f32x4*)(mb + 4 * D + k0), sb = *(const f32x4*)(mb + 4 * D + k0 + 4), ha = *(const f32x4*)(mb + 3 * D + k0), hb = *(const f32x4*)(mb + 3 * D + k0 + 4);
            const f32x4 h0 = x0 * rstd * ga * (sa + 1.f) + ha, h1 = x1 * rstd * gb * (sb + 1.f) + hb;
            const u32x4 hi4 = {pk2(h0.x, h0.y), pk2(h0.z, h0.w), pk2(h1.x, h1.y), pk2(h1.z, h1.w)};
            const f32x4 l0 = h0 - (f32x4){bflo(hi4.x), bfhi(hi4.x), bflo(hi4.y), bfhi(hi4.y)}, l1 = h1 - (f32x4){bflo(hi4.z), bfhi(hi4.z), bflo(hi4.w), bfhi(hi4.w)};
            const u32x4 lo4 = {pk2(l0.x, l0.y), pk2(l0.z, l0.w), pk2(l1.x, l1.y), pk2(l1.z, l1.w)};
            if (!DRY && fr < 8) *(u32x4*)(H2 + (size_t)m * D + k0) = hi4;
            const bf16x8 ahi = __builtin_bit_cast(bf16x8, hi4), alo = __builtin_bit_cast(bf16x8, lo4);
#pragma unroll
            for (int n = 0; n < 3; ++n) { const bf16x8 bhi = *(const LAS bf16x8*)(Whi + wrow[n] * RT_ROWE + k0), blo = *(const LAS bf16x8*)(Wlo + wrow[n] * RT_ROWE + k0);
                acc[n] = __builtin_amdgcn_mfma_f32_16x16x32_bf16(ahi, bhi, acc[n], 0, 0, 0);
                acc[n] = __builtin_amdgcn_mfma_f32_16x16x32_bf16(ahi, blo, acc[n], 0, 0, 0);
                acc[n] = __builtin_amdgcn_mfma_f32_16x16x32_bf16(alo, bhi, acc[n], 0, 0, 0); } }
        if (fq < 2) {
#pragma unroll
            for (int n = 0; n < 3; ++n)
#pragma unroll
                for (int i = 0; i < 4; ++i) LG[(4 * fq + i) * 48 + 16 * n + fr] = acc[n][i]; }
        asm volatile("s_waitcnt lgkmcnt(0)" ::: "memory");
        int ea = 0, eb = 0, la = 0, lb = 0; float wa = 0.f, wb = 0.f;
        if (lane < 8) { const LAS f32x4* lg4 = (const LAS f32x4*)(LG + lane * 48);
            const f32x4 g4 = lg4[0];
            float gl[4] = {g4.x + bg[0], g4.y + bg[1], g4.z + bg[2], g4.w + bg[3]}; int gs = 0; float gm = gl[0];
#pragma unroll
            for (int g = 1; g < 4; ++g) if (gl[g] > gm) { gm = gl[g]; gs = g; }
            float gsum = 0.f;
#pragma unroll
            for (int g = 0; g < 4; ++g) gsum += __expf(gl[g] - gm);
            const float pg = __builtin_amdgcn_rcpf(gsum);
            const f32x4 ea4 = lg4[1 + 2 * gs], eb4 = lg4[2 + 2 * gs]; const f32x4 ba4 = *(const f32x4*)(br + 8 * gs), bb4 = *(const f32x4*)(br + 8 * gs + 4);
            const float ev[8] = {ea4.x + ba4.x, ea4.y + ba4.y, ea4.z + ba4.z, ea4.w + ba4.w, eb4.x + bb4.x, eb4.y + bb4.y, eb4.z + bb4.z, eb4.w + bb4.w};
            int i1 = 0; float v1 = ev[0];
#pragma unroll
            for (int e = 1; e < 8; ++e) if (ev[e] > v1) { v1 = ev[e]; i1 = e; }
            int i2 = -1; float v2 = -INFINITY;
#pragma unroll
            for (int e = 0; e < 8; ++e) { if (e != i1 && (i2 < 0 || ev[e] > v2)) { i2 = e; v2 = ev[e]; } }
            const float e2 = __expf(v2 - v1), p1 = __builtin_amdgcn_rcpf(1.f + e2), p2 = e2 * p1;
            if (DRY) { asm volatile("" :: "v"(pg * p1), "v"(pg * p2), "v"(gs * 8 + i1), "v"(gs * 8 + i2)); }
            else { ea = gs * 8 + i1; eb = gs * 8 + i2; wa = pg * p1; wb = pg * p2; la = lds_addi(lcnt + ea, 1); lb = lds_addi(lcnt + eb, 1); } }
        if (!DRY) {
            __syncthreads();
            if (c.tid < NE) { const int n = lcnt[c.tid]; gbase[c.tid] = n ? atomicAdd(cnt + c.tid, n) : 0; }
            __syncthreads();
            if (lane < 8) { const int mt = m0 + 8 * wave + lane; const int ra = gbase[ea] + la, rb = gbase[eb] + lb;
                rt[mt] = (i32x4){ea, ra, eb, rb}; rw[mt] = (f32x2){wa, wb}; inv[(size_t)ea * T + ra] = mt; inv[(size_t)eb * T + rb] = mt; }
            __syncthreads();
            if (c.tid < NE) lcnt[c.tid] = 0;
            __syncthreads();
        }
    }
}
__device__ __forceinline__ void expert_bases(const int* cnt, LAS int* base  , int tid) {
    if (tid < 64) {
        const int n = (tid < NE) ? cnt[tid] : 0, nt_ = (n + 255) >> 8; const int incl = (int)wave_incl_scan((unsigned)nt_), start = incl - nt_;
        if (tid < NE) { base[tid] = start << 8; for (int i = 0; i < nt_; ++i) base[40 + start + i] = tid; }
        if (tid == NE - 1) base[NE] = incl << 8; }
    __syncthreads();
}
__device__ __forceinline__ void phase_scatter(const Ctx& c, int l) {
    LAS int* base = (LAS int*)(c.lds + 131072); const int* cnt = (const int*)(c.ws + WS_CTL + CTL_CNT) + l * NE;
    expert_bases(cnt, base, c.tid);
    const i32x4* rt = (const i32x4*)(c.ws + WS_ROUTE); int* slots = (int*)(c.ws + WS_ROUTE + 768 * 1024); int* rowl = (int*)(c.ws + WS_ROWL);
    for (int m = c.bid * NTHREADS + c.tid; m < T; m += c.nb * NTHREADS) { const i32x4 r = rt[m]; const int s1 = base[r.x] + r.y, s2 = base[r.z] + r.w;
        slots[2 * m] = s1; slots[2 * m + 1] = s2; rowl[s1] = m; rowl[s2] = m; }
    for (int e = c.bid; e < NE; e += c.nb) for (int sidx = base[e] + cnt[e] + c.tid; sidx < base[e + 1]; sidx += NTHREADS) rowl[sidx] = -1;
}
struct EpiMoe1 {
    EPI_COMMON_P
    bf16_t* hid;
    __device__ __forceinline__ void half(const f32x4 (&acc)[2][4][2], int ai, const GUnit& u, int wr, int wc, int fr, int fq) const {
#pragma unroll
        for (int m = 0; m < 4; ++m) { const size_t row = (size_t)u.row0 + 128 * ai + 64 * wr + 16 * m + fr; f32x4 o[2];
#pragma unroll
            for (int n = 0; n < 2; ++n)
#pragma unroll
                for (int i = 0; i < 4; ++i) o[n][i] = siluf_(acc[0][m][n][i]) * acc[1][m][n][i];
            st16_wt(hid, (unsigned)(row * DE + 128 * u.pn + 32 * wc + 8 * fq) * 2u, pack8(o[0], o[1])); }
    }
};
struct EpiMoe2 {
    EPI_COMMON_P
    bf16_t* ys;
    __device__ __forceinline__ void half(const f32x4 (&acc)[2][4][2], int ai, const GUnit& u, int wr, int wc, int fr, int fq) const {
#pragma unroll
        for (int m = 0; m < 4; ++m) { const size_t row = (size_t)u.row0 + 128 * ai + 64 * wr + 16 * m + fr;
#pragma unroll
            for (int bj = 0; bj < 2; ++bj) *(u32x4*)(ys + row * D + 256 * u.pn + 128 * bj + 32 * wc + 8 * fq) = pack8(acc[bj][m][0], acc[bj][m][1]); }
    }
};
__device__ __forceinline__ int tile_expert(const LAS int* base, int rt) { return __builtin_amdgcn_readfirstlane(base[40 + rt]); }
__device__ __forceinline__ void seam_wait(unsigned* f, unsigned target) {
    unsigned sp = 0;
    while (__hip_atomic_load(f, __ATOMIC_RELAXED, __HIP_MEMORY_SCOPE_AGENT) < target) { __builtin_amdgcn_s_sleep(2); if (++sp > (1u << 20)) break; }
    asm volatile("" ::: "memory");
}
struct SchedMoe1 { static constexpr int A_AUX = 0; const char* A; const char* B; const int* rowl; const LAS int* base; unsigned* flag; int nunit, G, c;
    __device__ __forceinline__ bool next(int i, GUnit& u) const { const int Lq = i * G + c; if (Lq >= nunit) return false; const int rt = Lq >> 1, j = Lq & 1, e = tile_expert(base, rt);
        u.pm = rt; u.pn = j; u.aux = e; u.row0 = rt * 256; u.rows = rowl + (size_t)e * T + (rt * 256 - __builtin_amdgcn_readfirstlane(base[e])); u.A = A; u.B = B + ((size_t)e * 512 + 256 * j) * D * 2; return true; }
    __device__ __forceinline__ void a_ready(const GUnit&) const {}
    __device__ __forceinline__ void done(const GUnit& u) const {
        asm volatile("s_waitcnt vmcnt(0)" ::: "memory");
        if ((threadIdx.x & 63) == 0) __hip_atomic_fetch_add(flag + u.pm * 16, 1u, __ATOMIC_RELAXED, __HIP_MEMORY_SCOPE_AGENT); }
};
struct SchedMoe2 { static constexpr int A_AUX = 16; const char* A; const char* B; const LAS int* base; unsigned* flag; int nunit, G, c, heavy;
    __device__ __forceinline__ bool next(int i, GUnit& u) const { if (c < heavy) return false; const int Lq = i * (G - heavy) + (c - heavy); if (Lq >= nunit) return false; const int rt = Lq >> 2, pn = Lq & 3, e = tile_expert(base, rt);
        u.pm = rt; u.pn = pn; u.aux = e; u.row0 = rt * 256; u.rows = nullptr; u.A = A + (size_t)rt * 256 * DE * 2; u.B = B + ((size_t)e * D + 256 * pn) * DE * 2; return true; }
    __device__ __forceinline__ void a_ready(const GUnit& u) const { seam_wait(flag + u.pm * 16, 16u); }
    __device__ __forceinline__ void done(const GUnit&) const {}
};
__device__ __forceinline__ void phase_moe(const Ctx& c, int l) {
    LAS int* base = (LAS int*)(c.lds + 131072); const int* cnt = (const int*)(c.ws + WS_CTL + CTL_CNT) + l * NE;
    expert_bases(cnt, base, c.tid);
    unsigned* flag = (unsigned*)(c.ws + WS_CTL + CTL_MFLAG) + l * 4096;
    const int ntile = __builtin_amdgcn_readfirstlane(base[NE] / 256), n1 = 2 * ntile, heavy = (n1 > c.nb) ? ((n1 - c.nb < c.nb / 2) ? n1 - c.nb : c.nb / 2) : 0;
    { SchedMoe1 S{(const char*)(c.ws + WS_H2), (const char*)(c.ws + WS_WGU), (const int*)(c.ws + WS_INV), base, flag, n1, c.nb, c.bid};
      EpiMoe1 E{(bf16_t*)(c.ws + WS_HID)};
      pg8::gemm_phase<EpiMoe1, SchedMoe1, true, true, true>(c.lds, pg8::Gemm{D, D, opaque_u(D), T}, S, E, c.tid); }
    { SchedMoe2 S{(const char*)(c.ws + WS_HID), (const char*)(c.ws + WS_WD), base, flag, 4 * ntile, c.nb, c.bid, heavy};
      EpiMoe2 E{(bf16_t*)(c.ws + WS_YS)};
      pg8::gemm_phase<EpiMoe2, SchedMoe2, true, true>(c.lds, pg8::Gemm{DE, DE, opaque_u(DE), MAXSLOT}, S, E, c.tid); }
}
template <bool DRY>
__device__ __forceinline__ void phase_combine(const Ctx& c, int l) {
    const int gw = c.bid * NWAVES + c.wave, NGW = c.nb * NWAVES, lane = c.lane;
    const float* mod = (const float*)(c.ws + WS_CTL + CTL_MOD);
    const bf16_t* YS = (const bf16_t*)(c.ws + WS_YS); const i32x4* rt = (const i32x4*)(c.ws + WS_ROUTE); const f32x2* rw = (const f32x2*)(c.ws + WS_ROUTE + 512 * 1024);
    LAS int* base = (LAS int*)(c.lds + 131072); expert_bases((const int*)(c.ws + WS_CTL + CTL_CNT) + l * NE, base, c.tid);
    bf16_t* H = (bf16_t*)(c.ws + WS_H); const bf16_t* X1 = (const bf16_t*)(c.ws + WS_X1);
    for (int m0 = gw; m0 < T; m0 += 4 * NGW) {
        int s1[4], s2[4]; f32x2 w[4]; u32x2 xv[4][4]; u32x2 y1[4][4], y2[4][4];
#pragma unroll
        for (int i = 0; i < 4; ++i) { const int m = (m0 + i * NGW < T) ? m0 + i * NGW : m0; { const i32x4 r = rt[m]; s1[i] = base[r.x] + r.y; s2[i] = base[r.z] + r.w; } w[i] = rw[m];
#pragma unroll
            for (int j = 0; j < 4; ++j) xv[i][j] = *(const u32x2*)(X1 + (size_t)m * D + 4 * lane + 256 * j); }
#pragma unroll
        for (int i = 0; i < 4; ++i)
#pragma unroll
            for (int j = 0; j < 4; ++j) { y1[i][j] = *(const u32x2*)(YS + (size_t)s1[i] * D + 4 * lane + 256 * j); y2[i][j] = *(const u32x2*)(YS + (size_t)s2[i] * D + 4 * lane + 256 * j); }
#pragma unroll
        for (int i = 0; i < 4; ++i) { const int m = m0 + i * NGW; if (m < T) { const int b = m / L; const float* mb = mod + (l * 2 + b) * 6144;
            f32x4 v[4];
#pragma unroll
            for (int j = 0; j < 4; ++j) { const int col = 4 * lane + 256 * j; const f32x4 gv = *(const f32x4*)(mb + 5 * D + col);
                v[j] = unpack4(xv[i][j]) + gv * (unpack4(y1[i][j]) * w[i].x + unpack4(y2[i][j]) * w[i].y);
                if (DRY) { asm volatile("" :: "v"(v[j])); } else if (l == 0) *(u32x2*)((bf16_t*)c.out + (size_t)m * D + col) = pack4(v[j]); else *(f32x4*)(c.out + (size_t)m * D + col) = v[j]; }
            if (l == 0 && !DRY) { const float* m1 = mod + (2 + b) * 6144; norm_row_store(v, c.in[4] + D, m1, m1 + D, H + (size_t)m * D, lane); } } }
    }
    if (l == 0) { LAS float* scr = (LAS float*)(c.lds + c.wave * 8704); convert_items<1>(c, 1, gw, NGW, IT_MOE, scr); }
}

__device__ __forceinline__ void phase_valutest(const Ctx& c) {
    float a[8];
#pragma unroll
    for (int i = 0; i < 8; ++i) a[i] = (float)(c.lane + i);
    const float m = 1.0000001f, b = 1e-9f;
#pragma unroll 1
    for (int it = 0; it < 4096; ++it) {
#pragma unroll
        for (int i = 0; i < 8; ++i) a[i] = fmaf(a[i], m, b);
        asm volatile("" : "+v"(a[0]), "+v"(a[1]), "+v"(a[2]), "+v"(a[3]), "+v"(a[4]), "+v"(a[5]), "+v"(a[6]), "+v"(a[7]));
    }
    float s = 0.f;
#pragma unroll
    for (int i = 0; i < 8; ++i) s += a[i];
    if (s == 12345.678f) ((float*)(c.ws + WS_XS))[c.tid] = s;
}
template <int TB>
__device__ __forceinline__ void phase_memtest(const Ctx& c) {
    const int gw = c.bid * NWAVES + c.wave, NGW = c.nb * NWAVES;
    float* dst = (float*)(c.ws + WS_XS);
    for (int m0 = gw; m0 < T; m0 += TB * NGW) {
        f32x4 v[TB][4];
#pragma unroll
        for (int i = 0; i < TB; ++i) { const int m = (m0 + i * NGW < T) ? m0 + i * NGW : m0;
#pragma unroll
            for (int j = 0; j < 4; ++j) v[i][j] = *(const f32x4*)(c.out + (size_t)m * D + 4 * c.lane + 256 * j); }
#pragma unroll
        for (int i = 0; i < TB; ++i) { const int m = m0 + i * NGW; if (m < T) {
#pragma unroll
            for (int j = 0; j < 4; ++j) *(f32x4*)(dst + (size_t)m * D + 4 * c.lane + 256 * j) = v[i][j]; } }
    }
}

#define XB_TMO      128
#define XB_XCNT(j)  (256  + 64 * (j))
#define XB_XSUB(j)  (1280 + 64 * (j))
#define XB_XGEN(j)  (2304 + 64 * (j))
#define XB_TOP      3328
#define XB_TOPGEN   3392
#define XCD_BAR_WORDS 3456
#define XB_SPIN_CAP (1u << 18)

__device__ __forceinline__ unsigned xb_ld(unsigned* p)              { return __hip_atomic_load(p, __ATOMIC_RELAXED, __HIP_MEMORY_SCOPE_AGENT); }
__device__ __forceinline__ unsigned xb_add(unsigned* p, unsigned v) { return __hip_atomic_fetch_add(p, v, __ATOMIC_RELAXED, __HIP_MEMORY_SCOPE_AGENT); }
__device__ __forceinline__ unsigned xb_xcc_id() { return (unsigned)__builtin_amdgcn_s_getreg((3 << 11) | 20) & 0xFu; }
#define XB_SPIN(cond, bar) do { unsigned _sp = 0; while (cond) { __builtin_amdgcn_s_sleep(1); \
    if ((++_sp & 255u) == 0u) { if (xb_ld(&(bar)[XB_TMO])) break; if (_sp > XB_SPIN_CAP) { atomicAdd(&(bar)[XB_TMO], 1u); break; } } } } while (0)

struct XcdBarrier {
    unsigned* bar; unsigned x;
    volatile LAS unsigned* st;
};

__device__ __forceinline__ XcdBarrier xcd_barrier_post(unsigned* bar, volatile LAS unsigned* st) {
    XcdBarrier b; b.bar = bar; b.x = xb_xcc_id(); b.st = st;
    if (threadIdx.x == 0) (void)xb_add(&bar[XB_XCNT(b.x)], 1u);
    return b;
}
__device__ __forceinline__ void xcd_barrier_complete(unsigned* bar, unsigned x, unsigned& nloc, unsigned& nx) {
    const unsigned G = gridDim.x * gridDim.y * gridDim.z;
    unsigned sum, cnt, mine, sp = 0u;
    for (;;) {
        sum = 0u; cnt = 0u; mine = 0u;
#pragma unroll
        for (unsigned j = 0; j < 16; ++j) { const unsigned c = xb_ld(&bar[XB_XCNT(j)]); sum += c; cnt += (c > 0u) ? 1u : 0u; mine = (j == x) ? c : mine; }
        if (sum == G) break;
        __builtin_amdgcn_s_sleep(1);
        if ((++sp & 255u) == 0u) { if (xb_ld(&bar[XB_TMO])) break; if (sp > XB_SPIN_CAP) { atomicAdd(&bar[XB_TMO], 1u); break; } }
    }
    nloc = mine > 0u ? mine : 1u; nx = cnt > 0u ? cnt : 1u;
}

__device__ __forceinline__ void xcd_barrier(const XcdBarrier& b, bool leader_thread) {
    asm volatile("s_waitcnt vmcnt(0)" ::: "memory");
    __syncthreads();
    if (leader_thread) {
        unsigned* bar = b.bar;
        __builtin_amdgcn_s_waitcnt(0);
        unsigned nloc = b.st[0], nx = b.st[1];
        if (nloc == 0u) { xcd_barrier_complete(bar, b.x, nloc, nx); b.st[0] = nloc; b.st[1] = nx; }
        const unsigned old = xb_add(&bar[XB_XSUB(b.x)], 1u);
        const unsigned gen = old / nloc;
        if (old + 1u == (gen + 1u) * nloc) {
            __builtin_amdgcn_fence(__ATOMIC_RELEASE, "agent");
            asm volatile("s_waitcnt vmcnt(0)" ::: "memory");
            const unsigned og = xb_add(&bar[XB_TOP], 1u);
            const unsigned tg = og / nx;
            if (og + 1u == (tg + 1u) * nx) xb_add(&bar[XB_TOPGEN], 1u);
            else XB_SPIN(xb_ld(&bar[XB_TOPGEN]) == tg, bar);
            __builtin_amdgcn_fence(__ATOMIC_ACQUIRE, "agent");
            xb_add(&bar[XB_XGEN(b.x)], 1u);
            asm volatile("s_waitcnt vmcnt(0)" ::: "memory");
        } else {
            XB_SPIN(xb_ld(&bar[XB_XGEN(b.x)]) == gen, bar);
            __builtin_amdgcn_fence(__ATOMIC_ACQUIRE, "agent");
            asm volatile("s_waitcnt vmcnt(0)" ::: "memory");
        }
    }
    __syncthreads();
}

__global__ void __launch_bounds__(NTHREADS, 2) __attribute__((amdgpu_waves_per_eu(2, 2))) mega(Params p) {
    extern __shared__ __attribute__((aligned(16))) unsigned char lds[];
    Ctx c; c.in = p.in; c.out = p.out; c.ws = p.ws; c.lds = (LAS unsigned char*)lds;
    c.tid = threadIdx.x; c.lane = c.tid & 63; c.wave = __builtin_amdgcn_readfirstlane(c.tid >> 6); c.bid = blockIdx.x; c.nb = gridDim.x;
    const int lo = p.ph_lo, hi = p.ph_hi;
#if ONE_LAUNCH
    volatile LAS unsigned* bmisc = (volatile LAS unsigned*)(c.lds + LDS_BYTES - 64);
    if (c.tid < 16) bmisc[c.tid] = 0u;
    __syncthreads();
    const XcdBarrier bar = xcd_barrier_post((unsigned*)(p.ws + WS_CTL + CTL_BAR), bmisc);
#define SEAM(k) do { if ((k) + 1 < hi) xcd_barrier(bar, cc.tid == 0); } while (0)
#else
#define SEAM(k) do { } while (0)
#endif
#ifdef ONLY_PHASE
#define IN(k) ((k) == ONLY_PHASE)
#else
#define IN(k) (lo <= (k) && (k) < hi)
#endif
#ifndef REP_PH
#define REP_PH -1
#define REP_N 1
#endif
#define PHASE(k, call) do { if (IN(k)) for (int rep_ = 0; rep_ < (((k) == REP_PH) ? REP_N : 1); ++rep_) { Ctx cc = c; cc.ws = opaque_p(cc.ws); cc.out = opaque_p(cc.out); cc.wave = opaque_u(cc.wave); cc.lane = (int)__builtin_amdgcn_mbcnt_hi(~0u, __builtin_amdgcn_mbcnt_lo(~0u, 0u)); cc.tid = cc.wave * 64 + cc.lane; asm volatile("" : "+v"(cc.tid), "+v"(cc.lane)); cc.bid = opaque_u(cc.bid); cc.nb = opaque_u(cc.nb); call; SEAM(k); } } while (0)
    PHASE(0, phase_prep(cc));
    PHASE(1, phase_norm1(cc, 0));
#ifdef DUP_MODE
#define DUPX(k, call) PHASE(k, call)
#else
#define DUPX(k, call)
#endif
#ifndef DUP_PH
#define DUP_PH -1
#endif
#ifndef DUP_PART
#define DUP_PART 3
#endif
#define DUPQ(r, k, call) do { if (DUP_PH == (r)) PHASE(k, call); } while (0)
#define LAYER(l) do { constexpr int p0 = 2 + 10 * (l); \
        DUPQ(0, p0 + 0, phase_gemm_in(cc, l)); \
        PHASE(p0 + 0, phase_gemm_in(cc, l)); \
        DUPQ(1, p0 + 1, phase_post_conv<DUP_PART>(cc, l)); \
        PHASE(p0 + 1, phase_post_conv<3>(cc, l)); \
        DUPX(p0 + 2, phase_idx_attn<DUP_MODE>(cc, l)); \
        PHASE(p0 + 2, phase_idx_attn<0>(cc, l)); \
        DUPQ(3, p0 + 3, phase_gemm_d1(cc, l)); \
        PHASE(p0 + 3, phase_gemm_d1(cc, l)); \
        PHASE(p0 + 4, phase_gemm_d2(cc, l)); \
        DUPQ(53, p0 + 5, (void)0); \
        DUPQ(54, p0 + 5, (void)0); DUPQ(54, p0 + 5, (void)0); DUPQ(54, p0 + 5, (void)0); DUPQ(54, p0 + 5, (void)0); \
        DUPQ(52, p0 + 5, phase_valutest(cc)); \
        DUPQ(50, p0 + 5, phase_memtest<4>(cc)); \
        DUPQ(51, p0 + 5, phase_memtest<8>(cc)); \
        DUPQ(5, p0 + 5, phase_norm2_route<true>(cc, l)); \
        PHASE(p0 + 5, phase_norm2_route<false>(cc, l)); \
        PHASE(p0 + 7, phase_moe(cc, l)); \
        DUPQ(9, p0 + 9, phase_combine<true>(cc, l)); \
        PHASE(p0 + 9, phase_combine<false>(cc, l)); } while (0)
    LAYER(0);
    LAYER(1);
#undef LAYER
#undef PHASE
#undef IN
#undef SEAM
}

extern "C" void kernel_launch(void* const* d_in, const int* in_sizes, int n_in, void* d_out, int out_size, void* d_ws, size_t ws_size, hipStream_t stream) {
    static int grid = 0;
    if (grid == 0) {
        if (n_in != 24 || out_size != T * D || ws_size < WS_END) { fprintf(stderr, "kernel_launch: unexpected shapes (n_in %d out %d ws %zu)\n", n_in, out_size, ws_size); grid = -1; return; }
        int dev = 0, cus = 0, per_cu = 0;
        hipGetDevice(&dev); hipDeviceGetAttribute(&cus, hipDeviceAttributeMultiprocessorCount, dev);
        if (hipFuncSetAttribute((const void*)mega, hipFuncAttributeMaxDynamicSharedMemorySize, LDS_BYTES) != hipSuccess) { fprintf(stderr, "kernel_launch: hipFuncSetAttribute failed\n"); grid = -1; return; }
        if (hipOccupancyMaxActiveBlocksPerMultiprocessor(&per_cu, (const void*)mega, NTHREADS, LDS_BYTES) != hipSuccess || per_cu < 1) { fprintf(stderr, "kernel_launch: occupancy query says %d\n", per_cu); per_cu = 1; }
        (void)hipGetLastError();
        grid = cus;
    }
    if (grid < 0) return;
    hipMemsetAsync((char*)d_ws + WS_CTL, 0, CTL_ZERO, stream);
    Params p{};
    for (int i = 0; i < 24; ++i) p.in[i] = (const float*)d_in[i];
    p.out = (float*)d_out; p.ws = (unsigned char*)d_ws;
#if ONE_LAUNCH
    p.ph_lo = 0; p.ph_hi = NPH;
    hipLaunchKernelGGL(mega, dim3(grid), dim3(NTHREADS), LDS_BYTES, stream, p);
#else
    for (int ph = 0; ph < NPH; ++ph) { p.ph_lo = ph; p.ph_hi = ph + 1; hipLaunchKernelGGL(mega, dim3(grid), dim3(NTHREADS), LDS_BYTES, stream, p); }
#endif
}
```

```cpp
#include <hip/hip_runtime.h>
#include <cstdio>
#include <cstdint>

#ifndef ONE_LAUNCH
#define ONE_LAUNCH 1
#endif

#define LAS __attribute__((address_space(3)))
typedef unsigned short bf16_t;
typedef short bf16x8 __attribute__((ext_vector_type(8)));
typedef float f32x4 __attribute__((ext_vector_type(4)));
typedef float f32x2 __attribute__((ext_vector_type(2)));
typedef unsigned u32x4 __attribute__((ext_vector_type(4)));
typedef unsigned u32x2 __attribute__((ext_vector_type(2)));
typedef int i32x4 __attribute__((ext_vector_type(4)));

constexpr int NB = 2, L = 8192, T = NB * L, D = 1024;
constexpr int NTHREADS = 512, NWAVES = 8;
constexpr int CONV_CH = 512, CONV_W = 31;
constexpr int NH = 8, HD = 64, AW = 512;
constexpr int IH = 8, IDIM = 32;
constexpr int TOPK = 256;
constexpr int NE = 32, EPG = 8, NG = 4, DE = 256;
constexpr int NIN = 4008, NINP = 4096;
constexpr float EPS = 1e-6f;
constexpr int MAXSLOT = T * 2 + NE * 256;
constexpr int NPH = 22;

constexpr size_t MiB = 1u << 20;
constexpr size_t WS_CTL = 0;
constexpr size_t CTL_ZERO = 256 * 1024;
constexpr size_t CTL_CNT = 4096;
constexpr size_t CTL_MOD = 65536;
constexpr size_t CTL_BAR = 16384;
constexpr size_t CTL_MFLAG = 32768;
constexpr size_t CTL_MAXIK = 8192;
constexpr size_t WS_RTW = 512 * 1024;
constexpr size_t WS_TAB = 1 * MiB;
constexpr size_t WS_WIN = 4 * MiB;
constexpr size_t WS_WCA = 20 * MiB;
constexpr size_t WS_WO = 24 * MiB;
constexpr size_t WS_WGU = 28 * MiB;
constexpr size_t WS_WD = 60 * MiB;
constexpr size_t WS_H = 76 * MiB;
constexpr size_t WS_UGLU = 108 * MiB;
constexpr size_t WS_RAW = 124 * MiB;
constexpr size_t WS_RAWF = 156 * MiB;
constexpr size_t WS_GATES = 188 * MiB;
constexpr size_t WS_QN = 252 * MiB;
constexpr size_t WS_KN = 268 * MiB;
constexpr size_t WS_VB = 270 * MiB;
constexpr size_t WS_IQ = 272 * MiB;
constexpr size_t WS_IK = 280 * MiB;
constexpr size_t WS_IW = 281 * MiB;
constexpr size_t WS_YO = 282 * MiB;
constexpr size_t WS_PR = 315 * MiB;
constexpr size_t WS_ROUTE = 314 * MiB;
constexpr size_t WS_INV = 316 * MiB;
constexpr size_t WS_END = 318 * MiB;
constexpr size_t WS_XS = 144 * MiB;
constexpr size_t WS_H2 = 108 * MiB;
constexpr size_t WS_ROWL = 315 * MiB + 128 * 1024;
constexpr size_t WS_HID = 76 * MiB;
constexpr size_t WS_X1 = 156 * MiB;
constexpr size_t WS_YS = 188 * MiB;

constexpr int LDS_BYTES = 160 * 1024;

__device__ __forceinline__ unsigned f2bf(float f) { unsigned u = __float_as_uint(f); return (u + 0x7fffu + ((u >> 16) & 1u)) >> 16; }
typedef __bf16 hwbf16x2 __attribute__((ext_vector_type(2)));
__device__ __forceinline__ unsigned pk2(float lo, float hi) { const f32x2 v = {lo, hi}; return __builtin_bit_cast(unsigned, __builtin_convertvector(v, hwbf16x2)); }
__device__ __forceinline__ float bflo(unsigned w) { return __uint_as_float(w << 16); }
__device__ __forceinline__ float bfhi(unsigned w) { return __uint_as_float(w & 0xffff0000u); }
__device__ __forceinline__ float bf2f(bf16_t h) { return __uint_as_float((unsigned)h << 16); }
__device__ __forceinline__ float sigmoidf_(float x) { return __builtin_amdgcn_rcpf(1.f + __expf(-x)); }
__device__ __forceinline__ float siluf_(float x) { return x * __builtin_amdgcn_rcpf(1.f + __expf(-x)); }
__device__ __forceinline__ unsigned lds_add(LAS unsigned* p, unsigned v) { return __hip_atomic_fetch_add(p, v, __ATOMIC_RELAXED, __HIP_MEMORY_SCOPE_WORKGROUP); }
__device__ __forceinline__ int lds_addi(LAS int* p, int v) { return __hip_atomic_fetch_add(p, v, __ATOMIC_RELAXED, __HIP_MEMORY_SCOPE_WORKGROUP); }
template <int CTRL> __device__ __forceinline__ float dpp_f(float v) { return __int_as_float(__builtin_amdgcn_update_dpp(0, __float_as_int(v), CTRL, 0xf, 0xf, true)); }
__device__ __forceinline__ float row16_sum(float v) { v += dpp_f<0xB1>(v); v += dpp_f<0x4E>(v); v += dpp_f<0x141>(v); v += dpp_f<0x140>(v); return v; }
__device__ __forceinline__ float row16_max(float v) { v = fmaxf(v, dpp_f<0xB1>(v)); v = fmaxf(v, dpp_f<0x4E>(v)); v = fmaxf(v, dpp_f<0x141>(v)); v = fmaxf(v, dpp_f<0x140>(v)); return v; }
__device__ __forceinline__ float rl_f(float v, int l) { return __int_as_float(__builtin_amdgcn_readlane(__float_as_int(v), l)); }
__device__ __forceinline__ float wave_sum(float v) { v = row16_sum(v); return (rl_f(v, 0) + rl_f(v, 16)) + (rl_f(v, 32) + rl_f(v, 48)); }
__device__ __forceinline__ float wave_max(float v) { v = row16_max(v); return fmaxf(fmaxf(rl_f(v, 0), rl_f(v, 16)), fmaxf(rl_f(v, 32), rl_f(v, 48))); }
__device__ __forceinline__ unsigned wave_incl_scan(unsigned v) {
    v += (unsigned)__builtin_amdgcn_update_dpp(0, (int)v, 0x111, 0xf, 0xf, true);
    v += (unsigned)__builtin_amdgcn_update_dpp(0, (int)v, 0x112, 0xf, 0xf, true);
    v += (unsigned)__builtin_amdgcn_update_dpp(0, (int)v, 0x114, 0xf, 0xf, true);
    v += (unsigned)__builtin_amdgcn_update_dpp(0, (int)v, 0x118, 0xf, 0xf, true);
    v += (unsigned)__builtin_amdgcn_update_dpp(0, (int)v, 0x142, 0xa, 0xf, false);
    v += (unsigned)__builtin_amdgcn_update_dpp(0, (int)v, 0x143, 0xc, 0xf, false);
    return v;
}
__device__ __forceinline__ float xor16_f(float v) { return __int_as_float(__builtin_amdgcn_ds_swizzle(__float_as_int(v), (16 << 10) | 0x1f)); }
__device__ __forceinline__ float max_x32(float v) { const auto r = __builtin_amdgcn_permlane32_swap(__float_as_uint(v), __float_as_uint(v), false, false); return fmaxf(__uint_as_float(r[0]), __uint_as_float(r[1])); }
__device__ __forceinline__ float sum_x32(float v) { const auto r = __builtin_amdgcn_permlane32_swap(__float_as_uint(v), __float_as_uint(v), false, false); return __uint_as_float(r[0]) + __uint_as_float(r[1]); }
__device__ __forceinline__ float oct_sum(float v) { v += dpp_f<0xB1>(v); v += dpp_f<0x4E>(v); v += dpp_f<0x141>(v); return v; }
__device__ __forceinline__ int opaque_u(int x) { asm volatile("" : "+v"(x)); return __builtin_amdgcn_readfirstlane(x); }
template <class P> __device__ __forceinline__ P* opaque_p(P* p) { const unsigned long long v = (unsigned long long)p; unsigned lo = (unsigned)v, hi = (unsigned)(v >> 32); asm volatile("" : "+v"(lo), "+v"(hi));
    lo = __builtin_amdgcn_readfirstlane(lo); hi = __builtin_amdgcn_readfirstlane(hi);
    return (P*)(__attribute__((address_space(1))) P*)(((unsigned long long)hi << 32) | lo); }
struct Params { const float* in[24]; float* out; unsigned char* ws; int ph_lo, ph_hi; };

struct Ctx {
    const float* const* in; float* out; unsigned char* ws;
    LAS unsigned char* lds;
    int tid, lane, wave, bid, nb;
};

struct TItem { const float* src; bf16_t* dst; int ldw, ldt, ncol; };
__device__ __forceinline__ void titem_load(const TItem& t, float (&v)[32], int lane) {
    const int r8 = lane >> 3, c4 = lane & 7;
#pragma unroll
    for (int i = 0; i < 8; ++i) { f32x4 x = {0.f, 0.f, 0.f, 0.f};
        if (4 * c4 < t.ncol) x = __builtin_nontemporal_load((const f32x4*)(t.src + (size_t)(8 * i + r8) * t.ldw + 4 * c4));
        v[4 * i] = x.x; v[4 * i + 1] = x.y; v[4 * i + 2] = x.z; v[4 * i + 3] = x.w; }
}
__device__ __forceinline__ void titem_store(const TItem& t, const float (&v)[32], LAS float* scr, int lane) {
    const int r8 = lane >> 3, c4 = lane & 7;
#pragma unroll
    for (int i = 0; i < 8; ++i)
#pragma unroll
        for (int e = 0; e < 4; ++e) scr[(8 * i + r8) * 33 + 4 * c4 + e] = v[4 * i + e];
    asm volatile("s_waitcnt lgkmcnt(0)" ::: "memory");
    const int c = lane & 7;
#pragma unroll
    for (int jj = 0; jj < 4; ++jj) { const int n = (lane >> 3) + 8 * jj; const LAS float* s = scr + (8 * c) * 33 + n;
        u32x4 o; o.x = pk2(s[0 * 33], s[1 * 33]); o.y = pk2(s[2 * 33], s[3 * 33]); o.z = pk2(s[4 * 33], s[5 * 33]); o.w = pk2(s[6 * 33], s[7 * 33]);
        __builtin_nontemporal_store(o, (u32x4*)(t.dst + (size_t)n * t.ldt + 8 * c)); }
    asm volatile("s_waitcnt lgkmcnt(0)" ::: "memory");
}
__device__ __forceinline__ TItem titem(const float* W, int ldw, int k0, int c0, int ncol, bf16_t* WT, int ldt, int r0, int kdst0) {
    TItem t; t.src = W + (size_t)k0 * ldw + c0; t.dst = WT + (size_t)r0 * ldt + kdst0 + k0; t.ldw = ldw; t.ldt = ldt; t.ncol = ncol; return t; }

__device__ __forceinline__ void win_map(int db, int& c0, int& ncol) {
    ncol = 32;
    if (db < 32) { const int i = db >> 3, w = db & 7; c0 = (w < 4) ? (128 * i + 32 * w) : (512 + 128 * i + 32 * (w - 4)); }
    else if (db < 48) c0 = 1024 + 32 * (db - 32);
    else if (db < 56) { const int q = db - 48; if (q < 2) c0 = 1536 + 32 * q; else if (q < 4) c0 = 1600 + 32 * (q - 2); else if (q == 4) c0 = 1920; else if (q == 5) { c0 = 1952; ncol = 8; } else { c0 = 0; ncol = 0; } }
    else if (db < 64) c0 = 1664 + 32 * (db - 56);
    else c0 = 1960 + 32 * (db - 64);
}
constexpr int IT_WIN = 16 * 128, IT_WC = 8 * 32, IT_WA = 8 * 32, IT_WO = 16 * 32, IT_MIX = IT_WIN + IT_WC + IT_WA + IT_WO;
constexpr int IT_GU = 32 * 16 * 16, IT_DN = 32 * 4 * 32, IT_MOE = IT_GU + IT_DN;
__device__ __forceinline__ TItem mixer_item(const Ctx& c, int l, int it) {
    bf16_t* WinT = (bf16_t*)(c.ws + WS_WIN) + (size_t)l * NINP * D;
    bf16_t* WcaT = (bf16_t*)(c.ws + WS_WCA) + (size_t)l * D * D;
    bf16_t* WoT = (bf16_t*)(c.ws + WS_WO) + (size_t)l * D * D;
    if (it < IT_WIN) { const int kb = it / 128, db = it % 128; int c0, nc; win_map(db, c0, nc); return titem(c.in[5] + (size_t)l * D * NIN, NIN, 64 * kb, c0, nc, WinT, D, 32 * db, 0); }
    it -= IT_WIN;
    if (it < IT_WC) { const int kb = it / 32, db = it % 32; return titem(c.in[12] + (size_t)l * CONV_CH * D, D, 64 * kb, 32 * db, 32, WcaT, D, 32 * db, 0); }
    it -= IT_WC;
    if (it < IT_WA) { const int kb = it / 32, db = it % 32; return titem(c.in[14] + (size_t)l * AW * D, D, 64 * kb, 32 * db, 32, WcaT, D, 32 * db, 512); }
    it -= IT_WA;
    { const int kb = it / 32, db = it % 32; return titem(c.in[15] + (size_t)l * D * D, D, 64 * kb, 32 * db, 32, WoT, D, 32 * db, 0); }
}
__device__ __forceinline__ TItem moe_item(const Ctx& c, int l, int it) {
    bf16_t* WguT = (bf16_t*)(c.ws + WS_WGU);
    bf16_t* WdT = (bf16_t*)(c.ws + WS_WD);
    if (it < IT_GU) { const int e = it / 256, r = it % 256, kb = r / 16, db = r % 16, j = db >> 3, w = db & 7;
        const float* src = (w < 4 ? c.in[21] : c.in[22]) + ((size_t)l * NE + e) * D * DE;
        return titem(src, DE, 64 * kb, 128 * j + 32 * (w & 3), 32, WguT + (size_t)e * 512 * D, D, 32 * db, 0); }
    it -= IT_GU;
    { const int e = it / 128, r = it % 128, kb = r / 32, db = r % 32;
        return titem(c.in[23] + ((size_t)l * NE + e) * DE * D, D, 64 * kb, 32 * db, 32, WdT + (size_t)e * D * DE, DE, 32 * db, 0); }
}
template <int KIND>
__device__ __forceinline__ void convert_items(const Ctx& c, int l, int first, int step, int nitems, LAS float* scr) {
    if (first >= nitems) return;
    auto get = [&](int it) { return KIND == 0 ? mixer_item(c, it / IT_MIX, it % IT_MIX) : moe_item(c, l, it); };
    TItem cur = get(first); float v[32]; titem_load(cur, v, c.lane);
    for (int it = first; it < nitems; it += step) {
        const int nx = it + step; TItem nt = cur; float nv[32];
        if (nx < nitems) { nt = get(nx); titem_load(nt, nv, c.lane); }
        titem_store(cur, v, scr, c.lane);
        if (nx < nitems) { cur = nt;
#pragma unroll
            for (int i = 0; i < 32; ++i) v[i] = nv[i]; }
    }
}

__device__ __forceinline__ void phase_prep(const Ctx& c) {
    LAS float* scr = (LAS float*)(c.lds + c.wave * 8704);
    const int gw = c.bid * NWAVES + c.wave, NGW = c.nb * NWAVES;
    float* cosH = (float*)(c.ws + WS_TAB); float* sinH = cosH + L * 32; float* cosI = sinH + L * 32; float* sinI = cosI + L * 16;
    for (int it = gw; it < (L * 32 + L * 16) / 64; it += NGW) {
        const bool hd = it < (L * 32) / 64; const int e = (hd ? it : it - (L * 32) / 64) * 64 + c.lane;
        const int pos = hd ? (e >> 5) : (e >> 4), i = hd ? (e & 31) : (e & 15);
        const float inv = powf(10000.f, -(float)(2 * i) / (hd ? 64.f : 32.f)); const float ang = (float)pos * inv;
        const float n = rintf(ang * 0.15915494309189535f); float r = fmaf(-n, 6.2831854820251465f, ang); r = fmaf(-n, -1.7484555314695172e-07f, r);
        const float cv_ = cosf(r), sv_ = sinf(r);
        if (hd) { cosH[e] = cv_; sinH[e] = sv_; } else { cosI[e] = cv_; sinI[e] = sv_; }
    }
    float* mod = (float*)(c.ws + WS_CTL + CTL_MOD);
    for (int it = c.bid; it < 2 * 96; it += c.nb) {
        const int l = it / 96, cc = it % 96, cg = c.lane & 15, ks = c.lane >> 4, col = 64 * cc + 4 * cg;
        const float* W = c.in[2] + (size_t)l * D * 6144; const float* cv = c.in[1];
        f32x4 a0 = {0.f, 0.f, 0.f, 0.f}, a1 = a0;
#pragma unroll 8
        for (int kk = 0; kk < 32; ++kk) { const int k = 128 * c.wave + 4 * kk + ks; const f32x4 w = __builtin_nontemporal_load((const f32x4*)(W + (size_t)k * 6144 + col)); const float s0 = siluf_(cv[k]), s1 = siluf_(cv[D + k]); a0 += w * s0; a1 += w * s1; }
#pragma unroll
        for (int i = 0; i < 4; ++i) { a0[i] += xor16_f(a0[i]); a0[i] = sum_x32(a0[i]); a1[i] += xor16_f(a1[i]); a1[i] = sum_x32(a1[i]); }
        LAS f32x4* red = (LAS f32x4*)(c.lds + 8 * 8704);
        __syncthreads();
        if (ks == 0) { red[(c.wave * 2 + 0) * 16 + cg] = a0; red[(c.wave * 2 + 1) * 16 + cg] = a1; }
        __syncthreads();
        if (c.tid < 32) { const int b = c.tid >> 4; f32x4 t = *(const f32x4*)(c.in[3] + l * 6144 + col);
#pragma unroll
            for (int w = 0; w < 8; ++w) t += red[(w * 2 + b) * 16 + cg];
            *(f32x4*)(mod + (l * 2 + b) * 6144 + col) = t; }
    }
    for (int it = gw; it < 2 * 36; it += NGW) { const int l = it / 36, r = it % 36;
        const float* src = (r < 4) ? (c.in[17] + (size_t)l * D * NG + r) : (c.in[19] + (size_t)l * D * NE + (r - 4)); const int ld = (r < 4) ? NG : NE;
        bf16_t* hi_ = (bf16_t*)(c.ws + WS_RTW) + (size_t)l * (2 * 36 * 1032) + r * 1032; bf16_t* lo_ = hi_ + 36 * 1032;
        for (int k = c.lane; k < 1032; k += 64) { const float w = (k < D) ? src[(size_t)k * ld] : 0.f; const unsigned h = f2bf(w); hi_[k] = (bf16_t)h; lo_[k] = (bf16_t)f2bf(w - __uint_as_float(h << 16)); } }
    convert_items<0>(c, 0, gw, NGW, 2 * IT_MIX, scr);
    convert_items<1>(c, 0, gw, NGW, IT_MOE, scr);
}

__device__ __forceinline__ u32x4 pack8(const f32x4 a, const f32x4 b);
__device__ __forceinline__ void norm_row_store(const f32x4 (&v)[4], const float* g, const float* shift, const float* scale, bf16_t* orow, int lane) {
    float s = 0.f;
#pragma unroll
    for (int j = 0; j < 4; ++j) s += (v[j].x * v[j].x + v[j].y * v[j].y) + (v[j].z * v[j].z + v[j].w * v[j].w);
    const float rstd = __builtin_amdgcn_rsqf(wave_sum(s) * (1.f / D) + EPS);
#pragma unroll
    for (int h = 0; h < 2; ++h) { const int col = 8 * lane + 512 * h; f32x4 o[2];
#pragma unroll
        for (int e = 0; e < 2; ++e) { const f32x4 gv = *(const f32x4*)(g + col + 4 * e), sh = *(const f32x4*)(shift + col + 4 * e), sc = *(const f32x4*)(scale + col + 4 * e); o[e] = v[2 * h + e] * rstd * gv * (sc + 1.f) + sh; }
        *(u32x4*)(orow + col) = pack8(o[0], o[1]); }
}
__device__ __forceinline__ void phase_norm1(const Ctx& c, int l) {
    const int gw = c.bid * NWAVES + c.wave, NGW = c.nb * NWAVES;
    const float* xin = (l == 0) ? c.in[0] : c.out; const float* mod = (const float*)(c.ws + WS_CTL + CTL_MOD);
    bf16_t* H = (bf16_t*)(c.ws + WS_H);
    for (int m0 = gw; m0 < T; m0 += 4 * NGW) {
        f32x4 v[4][4];
#pragma unroll
        for (int i = 0; i < 4; ++i) { const int m = (m0 + i * NGW < T) ? m0 + i * NGW : m0;
#pragma unroll
            for (int j = 0; j < 4; ++j) v[i][j] = __builtin_nontemporal_load((const f32x4*)(xin + (size_t)m * D + 8 * c.lane + 512 * (j >> 1) + 4 * (j & 1))); }
#pragma unroll
        for (int i = 0; i < 4; ++i) { const int m = m0 + i * NGW; if (m < T) { const float* mb = mod + (l * 2 + m / L) * 6144; norm_row_store(v[i], c.in[4] + l * D, mb, mb + D, H + (size_t)m * D, c.lane); } }
    }
}

namespace pg8 {
#define PG8_LAS __attribute__((address_space(3)))
constexpr int BM = 256, BK = 64, HALF = 128, HTB = HALF * BK * 2  , STAGE_BYTES = 8 * HTB, NXCD = 8, WGM = 8;
__host__ __device__ __forceinline__ int lds_byte(int r, int c) { const int st = (r >> 4) * 2 + (c >> 5), rr = r & 15, cc = c & 31, ob = rr * 64 + cc * 2; return st * 1024 + (ob ^ (((ob >> 9) & 1) << 5)); }
__host__ __device__ __forceinline__ void stage_rc(int b, int& R, int& C) { const int st = b / 1024, sb = b % 1024, swz = sb ^ (((sb >> 9) & 1) << 5); R = (st >> 1) * 16 + swz / 64; C = (st & 1) * 32 + (swz % 64) / 2; }
__host__ __device__ __forceinline__ int perm32(int rho) { const int n = rho >> 4, i = rho & 15; return 8 * (i >> 2) + 4 * n + (i & 3); }
struct GUnit { const char* A; const char* B; const int* rows; int pm, pn, aux, row0; };
struct Gemm { int lda, ldb, K, M; };
__device__ __forceinline__ void tile_order(int L, int nM, int nN, int& pm, int& pn) {
    const int nwg = nM * nN; int wgid = L; { const int q = nwg / NXCD, r = nwg % NXCD, xcd = wgid % NXCD, off = wgid / NXCD; wgid = (xcd < r ? xcd * (q + 1) : r * (q + 1) + (xcd - r) * q) + off; }
    const int nig = WGM * nN, gid = wgid / nig, fm = gid * WGM, gsz = (nM - fm) < WGM ? (nM - fm) : WGM;
    pm = fm + ((wgid % nig) % gsz); pn = (wgid % nig) / gsz;
}
template <class Epi, class Sched, bool ALIGN_EPI = false, bool SP2 = false, bool GATHER = false>
__device__ __forceinline__ void gemm_phase(PG8_LAS unsigned char* lds, const Gemm g, const Sched& S, const Epi& E, const int tid_in) {
    const int tid = tid_in, wid = __builtin_amdgcn_readfirstlane(tid >> 6), lane = tid & 63, wr = wid >> 2, wc = wid & 3, fr = lane & 15, fq = lane >> 4;
    const int K = g.K, nt = K / BK;
    unsigned voffA[2], voffB[2];
#pragma unroll
    for (int i = 0; i < 2; ++i) { int R, C; stage_rc(tid * 16 + i * 8192, R, C); const int Rb = Epi::PERM ? ((R & ~31) + perm32(R & 31)) : R;
        voffA[i] = (unsigned)(R * g.lda + C) * 2u; voffB[i] = (unsigned)(Rb * g.ldb + C) * 2u; }
    const size_t kstep = (size_t)(BK * 2);
    const size_t hstepA = (size_t)HALF * g.lda * 2, hstepB = (size_t)HALF * g.ldb * 2;
    const unsigned ldsw = (unsigned)wid * 1024u;
    const int aoff = lds_byte(wr * 64 + fr, fq * 8), boff = lds_byte(wc * 32 + fr, fq * 8);
#define PG8_SA(b, h) (((b) * 2 + (h)) * HTB)
#define PG8_SB(b, h) ((4 + (b) * 2 + (h)) * HTB)
#define PG8_STAGE(bufoff, gbase, voff) do { _Pragma("unroll") for (int _i = 0; _i < 2; ++_i) \
        __builtin_amdgcn_global_load_lds((const unsigned*)((const char*)(gbase) + (voff)[_i]), (PG8_LAS unsigned*)(lds + (bufoff) + ldsw + _i * 8192), 16, 0, 0); } while (0)
#define PG8_STAGE_A(bufoff, gbase, off2) do { _Pragma("unroll") for (int _i = 0; _i < 2; ++_i) \
        __builtin_amdgcn_global_load_lds((const unsigned*)((const char*)(gbase) + (off2)[_i]), (PG8_LAS unsigned*)(lds + (bufoff) + ldsw + _i * 8192), 16, 0, Sched::A_AUX); } while (0)
#define PG8_LDA(dst, b, h) do { _Pragma("unroll") for (int m = 0; m < 4; ++m) _Pragma("unroll") for (int k = 0; k < 2; ++k) dst[m][k] = *(const PG8_LAS bf16x8*)(lds + PG8_SA(b, h) + aoff + m * 2048 + k * 1024); } while (0)
#define PG8_LDB(dst, b, h) do { _Pragma("unroll") for (int n = 0; n < 2; ++n) _Pragma("unroll") for (int k = 0; k < 2; ++k) dst[n][k] = *(const PG8_LAS bf16x8*)(lds + PG8_SB(b, h) + boff + n * 2048 + k * 1024); } while (0)
#define PG8_MMA(ai, bj, At, Bt) do { __builtin_amdgcn_s_setprio(1); _Pragma("unroll") for (int m = 0; m < 4; ++m) _Pragma("unroll") for (int n = 0; n < 2; ++n) _Pragma("unroll") for (int k = 0; k < 2; ++k) \
        acc[ai][bj][m][n] = __builtin_amdgcn_mfma_f32_16x16x32_bf16(Bt[n][k], At[m][k], acc[ai][bj][m][n], 0, 0, 0); __builtin_amdgcn_s_setprio(0); } while (0)
#define PG8_WAIT_V(n) asm volatile("s_waitcnt vmcnt(" #n ")" ::: "memory")
#define PG8_WAIT_L(n) asm volatile("s_waitcnt lgkmcnt(" #n ")" ::: "memory")
#define PG8_BAR __builtin_amdgcn_s_barrier()
#define PG8_SCHED __builtin_amdgcn_sched_barrier(0)
    GUnit cur, nxt; int ui = 0;
    if (!S.next(0, cur)) return;
    f32x4 acc[2][2][4][2];
#pragma unroll
    for (int a = 0; a < 2; ++a)
#pragma unroll
        for (int b = 0; b < 2; ++b)
#pragma unroll
            for (int m = 0; m < 4; ++m)
#pragma unroll
                for (int n = 0; n < 2; ++n) acc[a][b][m][n] = (f32x4){0.f, 0.f, 0.f, 0.f};
    bf16x8 At[4][2], B0[2][2], B1[2][2];
    const char* cA = cur.A; const char* cB = cur.B;
    int stR[2], stC[2];
#pragma unroll
    for (int i = 0; i < 2; ++i) stage_rc(tid * 16 + i * 8192, stR[i], stC[i]);
    unsigned coff[2][2], noff[2][2];
#pragma unroll
    for (int h = 0; h < 2; ++h)
#pragma unroll
        for (int i = 0; i < 2; ++i) { if (GATHER) { int r = cur.rows[128 * h + stR[i]]; r = (unsigned)r < (unsigned)g.M ? r : 0; coff[h][i] = ((unsigned)r * (unsigned)g.lda + (unsigned)stC[i]) * 2u; } else coff[h][i] = voffA[i] + (unsigned)(h * hstepA); noff[h][i] = coff[h][i]; }
    S.a_ready(cur);
    if constexpr (SP2) {
        PG8_STAGE(PG8_SB(0, 0), cB, voffB); PG8_STAGE(PG8_SB(0, 1), cB + hstepB, voffB); PG8_STAGE_A(PG8_SA(0, 0), cA, coff[0]); PG8_STAGE_A(PG8_SA(0, 1), cA, coff[1]);
        if (wr == 1) PG8_BAR;
        PG8_WAIT_V(2); PG8_BAR;
        PG8_STAGE(PG8_SB(1, 0), cB + kstep, voffB); PG8_STAGE_A(PG8_SA(1, 0), cA + kstep, coff[0]); PG8_STAGE(PG8_SB(1, 1), cB + hstepB + kstep, voffB);
        PG8_WAIT_V(6); PG8_BAR;
    } else {
        PG8_STAGE(PG8_SB(0, 0), cB, voffB); PG8_STAGE_A(PG8_SA(0, 0), cA, coff[0]); PG8_STAGE(PG8_SB(0, 1), cB + hstepB, voffB); PG8_STAGE_A(PG8_SA(0, 1), cA, coff[1]);
        if (wr == 1) PG8_BAR;
        PG8_WAIT_V(4); PG8_BAR;
        PG8_STAGE(PG8_SB(1, 0), cB + kstep, voffB); PG8_STAGE_A(PG8_SA(1, 0), cA + kstep, coff[0]); PG8_STAGE(PG8_SB(1, 1), cB + hstepB + kstep, voffB);
        PG8_WAIT_V(6); PG8_BAR;
    }
    for (;;) {
        const bool has_next = S.next(ui + 1, nxt);
        const char* nA = has_next ? nxt.A : cA; const char* nB = has_next ? nxt.B : cB;
        if (GATHER) {
#pragma unroll
            for (int h = 0; h < 2; ++h)
#pragma unroll
                for (int i = 0; i < 2; ++i) { if (has_next) { int r = nxt.rows[128 * h + stR[i]]; r = (unsigned)r < (unsigned)g.M ? r : 0; noff[h][i] = ((unsigned)r * (unsigned)g.lda + (unsigned)stC[i]) * 2u; } else noff[h][i] = coff[h][i]; } }
        for (int t = 0; t < nt; t += 2) {
            const bool last = (t == nt - 2);
            const char* a1 = cA + (size_t)(t + 1) * kstep;
            const char* a2 = last ? nA : cA + (size_t)(t + 2) * kstep; const char* b2 = last ? nB : cB + (size_t)(t + 2) * kstep;
            const char* a3 = a2 + kstep; const char* b3 = b2 + kstep;
            unsigned xoff[2][2];
#pragma unroll
            for (int h = 0; h < 2; ++h)
#pragma unroll
                for (int i = 0; i < 2; ++i) xoff[h][i] = (GATHER && last) ? noff[h][i] : coff[h][i];
            if (last && has_next) S.a_ready(nxt);
            if constexpr (SP2) {
            PG8_LDB(B0, 0, 0); PG8_LDB(B1, 0, 1); PG8_SCHED; PG8_LDA(At, 0, 0); PG8_STAGE_A(PG8_SA(1, 1), a1, coff[1]);
            PG8_WAIT_V(8); PG8_WAIT_L(0); PG8_BAR; PG8_MMA(0, 0, At, B0); PG8_MMA(0, 1, At, B1); PG8_BAR; PG8_SCHED;
            PG8_LDA(At, 0, 1); PG8_STAGE(PG8_SB(0, 0), b2, voffB); PG8_STAGE(PG8_SB(0, 1), b2 + hstepB, voffB); PG8_STAGE_A(PG8_SA(0, 0), a2, xoff[0]);
            PG8_WAIT_V(8); PG8_WAIT_L(0); PG8_BAR; PG8_MMA(1, 0, At, B0); PG8_MMA(1, 1, At, B1); PG8_BAR; PG8_SCHED;
            PG8_LDB(B0, 1, 0); PG8_LDB(B1, 1, 1); PG8_SCHED; PG8_LDA(At, 1, 0); PG8_STAGE_A(PG8_SA(0, 1), a2, xoff[1]);
            PG8_WAIT_V(8); PG8_WAIT_L(0); PG8_BAR; PG8_MMA(0, 0, At, B0); PG8_MMA(0, 1, At, B1); PG8_BAR; PG8_SCHED;
            PG8_LDA(At, 1, 1); PG8_STAGE(PG8_SB(1, 0), b3, voffB); PG8_STAGE(PG8_SB(1, 1), b3 + hstepB, voffB); PG8_STAGE_A(PG8_SA(1, 0), a3, xoff[0]);
            PG8_WAIT_V(8); PG8_WAIT_L(0); PG8_BAR; PG8_MMA(1, 0, At, B0); PG8_MMA(1, 1, At, B1); PG8_BAR; PG8_SCHED;
            } else {
            PG8_LDB(B0, 0, 0); PG8_SCHED; PG8_LDA(At, 0, 0); PG8_STAGE_A(PG8_SA(1, 1), a1, coff[1]);
            PG8_WAIT_L(8); PG8_BAR; PG8_WAIT_L(0); PG8_MMA(0, 0, At, B0); PG8_BAR; PG8_SCHED;
            PG8_LDB(B1, 0, 1); PG8_STAGE(PG8_SB(0, 0), b2, voffB);
            PG8_BAR; PG8_WAIT_L(0); PG8_MMA(0, 1, At, B1); PG8_BAR;
            PG8_LDA(At, 0, 1); PG8_STAGE_A(PG8_SA(0, 0), a2, xoff[0]);
            PG8_BAR; PG8_WAIT_L(0); PG8_MMA(1, 0, At, B0); PG8_BAR; PG8_SCHED;
            PG8_STAGE(PG8_SB(0, 1), b2 + hstepB, voffB);
            PG8_WAIT_V(6); PG8_BAR; PG8_MMA(1, 1, At, B1); PG8_BAR;
            PG8_LDB(B0, 1, 0); PG8_SCHED; PG8_LDA(At, 1, 0); PG8_STAGE_A(PG8_SA(0, 1), a2, xoff[1]);
            PG8_WAIT_L(8); PG8_BAR; PG8_WAIT_L(0); PG8_MMA(0, 0, At, B0); PG8_BAR; PG8_SCHED;
            PG8_LDB(B1, 1, 1); PG8_STAGE(PG8_SB(1, 0), b3, voffB);
            PG8_BAR; PG8_WAIT_L(0); PG8_MMA(0, 1, At, B1); PG8_BAR;
            PG8_LDA(At, 1, 1); PG8_STAGE_A(PG8_SA(1, 0), a3, xoff[0]);
            PG8_BAR; PG8_WAIT_L(0); PG8_MMA(1, 0, At, B0); PG8_BAR; PG8_SCHED;
            PG8_STAGE(PG8_SB(1, 1), b3 + hstepB, voffB);
            PG8_WAIT_V(6); PG8_BAR; PG8_MMA(1, 1, At, B1); PG8_BAR;
            }
        }
        if constexpr (ALIGN_EPI) { if (wr == 0) PG8_BAR; }
        if constexpr (!Epi::AFTER_DRAIN) { E(acc, cur, wr, wc, fr, fq); S.done(cur); }
        if (!has_next) break;
#pragma unroll
        for (int a = 0; a < 2; ++a)
#pragma unroll
            for (int b = 0; b < 2; ++b)
#pragma unroll
                for (int m = 0; m < 4; ++m)
#pragma unroll
                    for (int n = 0; n < 2; ++n) acc[a][b][m][n] = (f32x4){0.f, 0.f, 0.f, 0.f};
        cur = nxt; cA = nA; cB = nB; ++ui;
        if (GATHER) {
#pragma unroll
            for (int h = 0; h < 2; ++h)
#pragma unroll
                for (int i = 0; i < 2; ++i) coff[h][i] = noff[h][i]; }
        if constexpr (ALIGN_EPI) { if (wr == 1) PG8_BAR; }
    }
    PG8_WAIT_V(0);
    if constexpr (!ALIGN_EPI) { if (wr == 0) PG8_BAR; }
    PG8_BAR;
    if constexpr (Epi::AFTER_DRAIN) { E.fused(acc, cur, wr, wc, fr, fq, lds, wid, lane); S.done(cur); }
#undef PG8_SA
#undef PG8_SB
#undef PG8_STAGE
#undef PG8_STAGE_A
#undef PG8_LDA
#undef PG8_LDB
#undef PG8_MMA
#undef PG8_WAIT_V
#undef PG8_WAIT_L
#undef PG8_BAR
#undef PG8_SCHED
}
}
using pg8::GUnit;
#define EPI_COMMON_P static constexpr bool PERM = true, AFTER_DRAIN = false; \
    __device__ __forceinline__ void operator()(const f32x4 (&acc)[2][2][4][2], const GUnit& u, int wr, int wc, int fr, int fq) const { half(acc[0], 0, u, wr, wc, fr, fq); half(acc[1], 1, u, wr, wc, fr, fq); }
#define EPI_COMMON static constexpr bool PERM = false, AFTER_DRAIN = false; \
    __device__ __forceinline__ void operator()(const f32x4 (&acc)[2][2][4][2], const GUnit& u, int wr, int wc, int fr, int fq) const { half(acc[0], 0, u, wr, wc, fr, fq); half(acc[1], 1, u, wr, wc, fr, fq); }

__device__ __forceinline__ u32x2 pack4(const f32x4 v) { u32x2 w; w.x = pk2(v.x, v.y); w.y = pk2(v.z, v.w); return w; }
__device__ __forceinline__ u32x4 pack8(const f32x4 a, const f32x4 b) { return (u32x4){pk2(a.x, a.y), pk2(a.z, a.w), pk2(b.x, b.y), pk2(b.z, b.w)}; }
typedef unsigned v4u_ __attribute__((vector_size(16)));
__device__ __forceinline__ void st16_wt(const void* base, unsigned off, const u32x4 v) {
    __builtin_amdgcn_raw_buffer_store_b128(__builtin_bit_cast(v4u_, v), __builtin_amdgcn_make_buffer_rsrc(const_cast<void*>(base), 0, 0x7FFFFFFF, 0x00020000), (int)off, 0, 16);
}
__device__ __forceinline__ f32x4 unpack4(const u32x2 w) { return (f32x4){bflo(w.x), bfhi(w.x), bflo(w.y), bfhi(w.y)}; }

struct EpiIn {
    EPI_COMMON_P
    bf16_t* uglu; bf16_t* rawb; float* rawf; bf16_t* gates;
    __device__ __forceinline__ void half(const f32x4 (&acc)[2][4][2], int ai, const GUnit& u, int wr, int wc, int fr, int fq) const {
        const int pn = u.pn, c8 = 32 * wc + 8 * fq;
#pragma unroll
        for (int m = 0; m < 4; ++m) { const size_t row = (size_t)u.row0 + 128 * ai + 64 * wr + 16 * m + fr;
            if (pn < 4) { f32x4 o[2];
#pragma unroll
                for (int n = 0; n < 2; ++n)
#pragma unroll
                    for (int i = 0; i < 4; ++i) o[n][i] = acc[0][m][n][i] * sigmoidf_(acc[1][m][n][i]);
                *(u32x4*)(uglu + row * 512 + 128 * pn + c8) = pack8(o[0], o[1]);
            } else if (pn == 6) {
#pragma unroll
                for (int bj = 0; bj < 2; ++bj)
#pragma unroll
                    for (int n = 0; n < 2; ++n) *(f32x4*)(rawf + row * 256 + 128 * bj + c8 + 4 * n) = acc[bj][m][n];
            } else if (pn < 8) { const int cb0 = (pn == 7) ? 512 : 256 * (pn - 4);
#pragma unroll
                for (int bj = 0; bj < 2; ++bj) *(u32x4*)(rawb + row * 768 + cb0 + 128 * bj + c8) = pack8(acc[bj][m][0], acc[bj][m][1]);
            } else {
#pragma unroll
                for (int bj = 0; bj < 2; ++bj) { f32x4 o[2];
#pragma unroll
                    for (int n = 0; n < 2; ++n)
#pragma unroll
                        for (int i = 0; i < 4; ++i) o[n][i] = sigmoidf_(acc[bj][m][n][i]);
                    *(u32x4*)(gates + row * 2048 + 256 * (pn - 8) + 128 * bj + c8) = pack8(o[0], o[1]); }
            } }
    }
};
struct SchedIn { static constexpr int A_AUX = 0; const char* A; const char* B; int G, c;
    __device__ __forceinline__ bool next(int i, GUnit& u) const { const int Lq = i * G + c; if (Lq >= 64 * 16) return false; int pm, pn; pg8::tile_order(Lq, 64, 16, pm, pn);
        u.pm = pm; u.pn = pn; u.aux = 0; u.row0 = pm * 256; u.rows = nullptr; u.A = A + (size_t)pm * 256 * D * 2; u.B = B + (size_t)pn * 256 * D * 2; return true; }
    __device__ __forceinline__ void a_ready(const GUnit&) const {}
    __device__ __forceinline__ void done(const GUnit&) const {}
};
__device__ __forceinline__ void phase_gemm_in(const Ctx& c, int l) {
    SchedIn S{(const char*)(c.ws + WS_H), (const char*)(c.ws + WS_WIN) + (size_t)l * NINP * D * 2, c.nb, c.bid};
    EpiIn E{(bf16_t*)(c.ws + WS_UGLU), (bf16_t*)(c.ws + WS_RAW), (float*)(c.ws + WS_RAWF), (bf16_t*)(c.ws + WS_GATES)};
    pg8::gemm_phase<EpiIn, SchedIn, true, true>(c.lds, pg8::Gemm{D, D, opaque_u(D), T}, S, E, c.tid);
}

template <int PART>
__device__ __forceinline__ void phase_post_conv(const Ctx& c, int l) {
    const int gw = c.bid * NWAVES + c.wave, NGW = c.nb * NWAVES, lane = c.lane;
    const bf16_t* RAWB = (const bf16_t*)(c.ws + WS_RAW); const float* RAWF = (const float*)(c.ws + WS_RAWF);
    const float* cosH = (const float*)(c.ws + WS_TAB); const float* sinH = cosH + L * 32; const float* cosI = sinH + L * 32; const float* sinI = cosI + L * 16;
    bf16_t* QN = (bf16_t*)(c.ws + WS_QN); bf16_t* KN = (bf16_t*)(c.ws + WS_KN); bf16_t* VB = (bf16_t*)(c.ws + WS_VB);
    bf16_t* IQ = (bf16_t*)(c.ws + WS_IQ); bf16_t* IK = (bf16_t*)(c.ws + WS_IK); float* IW = (float*)(c.ws + WS_IW);
    const float* qg = c.in[6] + l * HD; const float* kg = c.in[7] + l * HD; float* PRo = (float*)(c.ws + WS_PR);
    float mxk0 = 0.f, mxk1 = 0.f;
    struct PostIn { f32x4 q0, q1, kv0, kv1, iq, ik, ch0, ch1, sh0, sh1, ci, si; float iw; };
    const int cc = lane & 7, c4 = cc & 3; const bool hi = cc >= 4;
    auto load_in = [&](int m) { PostIn p; const int t = m % L; const bf16_t* rb_ = RAWB + (size_t)m * 768; const float* r = RAWF + (size_t)m * 256;
        { const u32x4 wq = *(const u32x4*)(rb_ + 8 * lane); p.q0 = (f32x4){bflo(wq.x), bfhi(wq.x), bflo(wq.y), bfhi(wq.y)}; p.q1 = (f32x4){bflo(wq.z), bfhi(wq.z), bflo(wq.w), bfhi(wq.w)}; }
        const int off = (lane < 8) ? (8 * lane) : (64 + 8 * (lane & 7)); p.kv0 = *(const f32x4*)(r + off); p.kv1 = *(const f32x4*)(r + off + 4);
        { const u32x2 wi = *(const u32x2*)(rb_ + 512 + 4 * lane); p.iq = (f32x4){bflo(wi.x), bfhi(wi.x), bflo(wi.y), bfhi(wi.y)}; }
        p.ik = *(const f32x4*)(r + 128 + 4 * (lane & 7)); p.iw = r[160 + (lane & 7)];
        p.ch0 = *(const f32x4*)(cosH + t * 32 + 8 * c4); p.ch1 = *(const f32x4*)(cosH + t * 32 + 8 * c4 + 4); p.sh0 = *(const f32x4*)(sinH + t * 32 + 8 * c4); p.sh1 = *(const f32x4*)(sinH + t * 32 + 8 * c4 + 4);
        p.ci = *(const f32x4*)(cosI + t * 16 + 4 * c4); p.si = *(const f32x4*)(sinI + t * 16 + 4 * c4); return p; };
    float qgr[8], kgr[8];
    { const f32x4 a = *(const f32x4*)(qg + 8 * cc), b = *(const f32x4*)(qg + 8 * cc + 4), d = *(const f32x4*)(kg + 8 * cc), e = *(const f32x4*)(kg + 8 * cc + 4);
        qgr[0] = a.x; qgr[1] = a.y; qgr[2] = a.z; qgr[3] = a.w; qgr[4] = b.x; qgr[5] = b.y; qgr[6] = b.z; qgr[7] = b.w;
        kgr[0] = d.x; kgr[1] = d.y; kgr[2] = d.z; kgr[3] = d.w; kgr[4] = e.x; kgr[5] = e.y; kgr[6] = e.z; kgr[7] = e.w; }
    LAS unsigned* mxl = (LAS unsigned*)(c.lds + 64512);
    if (c.tid < 2) mxl[c.tid] = 0u;
    __syncthreads();
    const bf16_t* UG = (const bf16_t*)(c.ws + WS_UGLU);
    const int ntl = (PART & 2) ? T / 32 : 0;
    u32x4 sv[8];
    auto img_load = [&](int tile_) { const int m0_ = tile_ * 32, tl0_ = m0_ % L;
#pragma unroll
        for (int k = 0; k < 8; ++k) { const int i = c.tid + NTHREADS * k, row = i >> 6, pc = i & 63; sv[k] = (u32x4){0u, 0u, 0u, 0u};
            if (row < 62 && tl0_ - 30 + row >= 0) sv[k] = *(const u32x4*)(UG + (size_t)(m0_ - 30 + row) * 512 + 8 * pc); } };
    if (c.bid < ntl) img_load(c.bid);
    PostIn nx = load_in(gw < T ? gw : 0);
    for (int m = gw; m < ((PART & 1) ? T : 0); m += NGW) {
        const PostIn p = nx; { const int mn = m + NGW; nx = load_in(mn < T ? mn : m); }
        const float csq[8] = {p.ch0.x, p.ch0.y, p.ch0.z, p.ch0.w, p.ch1.x, p.ch1.y, p.ch1.z, p.ch1.w}, snq[8] = {p.sh0.x, p.sh0.y, p.sh0.z, p.sh0.w, p.sh1.x, p.sh1.y, p.sh1.z, p.sh1.w};
        {
            float x[8] = {p.q0.x, p.q0.y, p.q0.z, p.q0.w, p.q1.x, p.q1.y, p.q1.z, p.q1.w}; float s = 0.f;
#pragma unroll
            for (int i = 0; i < 8; ++i) s += x[i] * x[i];
            s = oct_sum(s);
            const float rstd = __builtin_amdgcn_rsqf(s * (1.f / 64.f) + EPS); float o[8];
#pragma unroll
            for (int i = 0; i < 8; ++i) x[i] = x[i] * rstd * qgr[i];
#pragma unroll
            for (int i = 0; i < 8; ++i) { const float other = __shfl_xor(x[i], 4); o[i] = (hi ? (x[i] * csq[i] + other * snq[i]) : (x[i] * csq[i] - other * snq[i])) * 0.125f; }
            u32x4 w; w.x = pk2(o[0], o[1]); w.y = pk2(o[2], o[3]); w.z = pk2(o[4], o[5]); w.w = pk2(o[6], o[7]);
            *(u32x4*)(QN + (size_t)m * 512 + 8 * lane) = w;
        }
        {
            float x[8] = {p.kv0.x, p.kv0.y, p.kv0.z, p.kv0.w, p.kv1.x, p.kv1.y, p.kv1.z, p.kv1.w}; float s = 0.f;
#pragma unroll
            for (int i = 0; i < 8; ++i) s += x[i] * x[i];
            s = oct_sum(s);
            const float rstd = __builtin_amdgcn_rsqf(s * (1.f / 64.f) + EPS); float xn[8], o[8];
#pragma unroll
            for (int i = 0; i < 8; ++i) xn[i] = x[i] * rstd * kgr[i];
#pragma unroll
            for (int i = 0; i < 8; ++i) { const float other = __shfl_xor(xn[i], 4); o[i] = hi ? (xn[i] * csq[i] + other * snq[i]) : (xn[i] * csq[i] - other * snq[i]); }
            if (lane < 8) { u32x4 w; w.x = pk2(o[0], o[1]); w.y = pk2(o[2], o[3]); w.z = pk2(o[4], o[5]); w.w = pk2(o[6], o[7]); *(u32x4*)(KN + (size_t)m * 64 + 8 * lane) = w; }
            else if (lane < 16) { u32x4 w; w.x = pk2(x[0], x[1]); w.y = pk2(x[2], x[3]); w.z = pk2(x[4], x[5]); w.w = pk2(x[6], x[7]); *(u32x4*)(VB + (size_t)m * 64 + 8 * (lane & 7)) = w; }
        }
        const float csi[4] = {p.ci.x, p.ci.y, p.ci.z, p.ci.w}, sni[4] = {p.si.x, p.si.y, p.si.z, p.si.w};
        {
            const f32x4 a = p.iq; float o[4];
#pragma unroll
            for (int i = 0; i < 4; ++i) { const float other = __shfl_xor(a[i], 4); o[i] = hi ? (a[i] * csi[i] + other * sni[i]) : (a[i] * csi[i] - other * sni[i]); }
            u32x2 w; w.x = pk2(o[0], o[1]); w.y = pk2(o[2], o[3]); *(u32x2*)(IQ + (size_t)m * 256 + 4 * lane) = w;
            float n2 = bflo(w.x) * bflo(w.x) + bfhi(w.x) * bfhi(w.x) + bflo(w.y) * bflo(w.y) + bfhi(w.y) * bfhi(w.y);
            n2 = oct_sum(n2);
            const float wh = __shfl(p.iw, lane >> 3);
            const float prs = wave_sum((lane & 7) == 0 ? fabsf(wh) * sqrtf(n2) : 0.f);
            if (lane == 0) PRo[m] = prs;
        }
        {
            const f32x4 a = p.ik; float o[4];
#pragma unroll
            for (int i = 0; i < 4; ++i) { const float other = __shfl_xor(a[i], 4); o[i] = hi ? (a[i] * csi[i] + other * sni[i]) : (a[i] * csi[i] - other * sni[i]); }
            u32x2 w; w.x = pk2(o[0], o[1]); w.y = pk2(o[2], o[3]);
            if (lane < 8) *(u32x2*)(IK + (size_t)m * 32 + 4 * lane) = w;
            else if (lane < 16) IW[(size_t)m * 8 + (lane & 7)] = p.iw;
            float n2 = bflo(w.x) * bflo(w.x) + bfhi(w.x) * bfhi(w.x) + bflo(w.y) * bflo(w.y) + bfhi(w.y) * bfhi(w.y);
            n2 = oct_sum(n2);
            if (m < L) mxk0 = fmaxf(mxk0, n2); else mxk1 = fmaxf(mxk1, n2);
        }
    }
    if (lane == 0) { __hip_atomic_fetch_max(mxl, __float_as_uint(mxk0), __ATOMIC_RELAXED, __HIP_MEMORY_SCOPE_WORKGROUP); __hip_atomic_fetch_max(mxl + 1, __float_as_uint(mxk1), __ATOMIC_RELAXED, __HIP_MEMORY_SCOPE_WORKGROUP); }
    bf16_t* YO = (bf16_t*)(c.ws + WS_YO);
    const float* cw = c.in[8] + (size_t)l * CONV_W * CONV_CH; const float* cb = c.in[9] + l * CONV_CH; const float* lg = c.in[10] + l * CONV_CH; const float* lb = c.in[11] + l * CONV_CH;
    LAS unsigned char* ut = c.lds; LAS float* st = (LAS float*)(c.lds + 63488); LAS f32x2* ys = (LAS f32x2*)(c.lds + 65536) + c.wave * 1024;
    const int half = c.wave >> 2, wq = c.wave & 3, ch = 128 * wq + 2 * lane;
    f32x2 w2[CONV_W];
#pragma unroll
    for (int j = 0; j < CONV_W; ++j) w2[j] = *(const f32x2*)(cw + j * CONV_CH + ch);
    const f32x2 bv = *(const f32x2*)(cb + ch);
    const int ch8 = 128 * wq + 8 * (lane & 15);
    const f32x4 g8a = *(const f32x4*)(lg + ch8), g8b = *(const f32x4*)(lg + ch8 + 4), l8a = *(const f32x4*)(lb + ch8), l8b = *(const f32x4*)(lb + ch8 + 4);
    for (int tile = c.bid; tile < ntl; tile += c.nb) {
        const int m0 = tile * 32;
        __syncthreads();
#pragma unroll
        for (int k = 0; k < 8; ++k) { const int i = c.tid + NTHREADS * k, row = i >> 6, pc = i & 63; if (row < 62) *(LAS u32x4*)(ut + row * 1024 + 16 * pc) = sv[k]; }
        __syncthreads();
        if (tile + c.nb < ntl) img_load(tile + c.nb);
        {
            f32x2 y16[16];
#pragma unroll
            for (int tk = 0; tk < 16; ++tk) y16[tk] = bv;
            const LAS unsigned char* ub = ut + (16 * half) * 1024 + ch * 2;
#pragma unroll
            for (int i = 0; i < 46; ++i) { const unsigned uu = *(const LAS unsigned*)(ub + i * 1024); const f32x2 u2 = {bflo(uu), bfhi(uu)};
#pragma unroll
                for (int tk = 0; tk < 16; ++tk) if (i - tk >= 0 && i - tk < CONV_W) y16[tk] = __builtin_elementwise_fma(u2, w2[i - tk], y16[tk]); }
#pragma unroll
            for (int tk = 0; tk < 16; ++tk) { const int tr = 16 * half + tk; const f32x2 y2 = y16[tk];
                ys[tk * 64 + lane] = y2;
                const float s1 = wave_sum(y2.x + y2.y), s2 = wave_sum(y2.x * y2.x + y2.y * y2.y);
                if (lane == 0) { st[(tr * 4 + wq) * 2] = s1; st[(tr * 4 + wq) * 2 + 1] = s2; } } }
        __syncthreads();
#pragma unroll 1
        for (int i = 0; i < 4; ++i) { const int tk = (lane >> 4) + 4 * i, tr = 16 * half + tk, cg = lane & 15;
            const f32x4 ya = *(const LAS f32x4*)(ys + tk * 64 + 4 * cg), yb = *(const LAS f32x4*)(ys + tk * 64 + 4 * cg + 2);
            const f32x4 sa = *(const LAS f32x4*)(st + tr * 8), sb = *(const LAS f32x4*)(st + tr * 8 + 4);
            const float mu = ((sa.x + sa.z) + (sb.x + sb.z)) * (1.f / CONV_CH), ex2 = ((sa.y + sa.w) + (sb.y + sb.w)) * (1.f / CONV_CH);
            const float rstd = __builtin_amdgcn_rsqf(fmaxf(ex2 - mu * mu, 0.f) + EPS);
            f32x4 o0, o1;
#pragma unroll
            for (int e = 0; e < 4; ++e) { o0[e] = siluf_((ya[e] - mu) * rstd * g8a[e] + l8a[e]); o1[e] = siluf_((yb[e] - mu) * rstd * g8b[e] + l8b[e]); }
            *(u32x4*)(YO + (size_t)(m0 + tr) * 1024 + 128 * wq + 8 * cg) = pack8(o0, o1); }
    }
    __syncthreads();
    if (c.tid < 2) atomicMax((unsigned*)(c.ws + WS_CTL + CTL_MAXIK) + l * 2 + c.tid, mxl[c.tid]);
}

typedef float f32x16 __attribute__((ext_vector_type(16)));
typedef short s16x4 __attribute__((ext_vector_type(4)));
constexpr int IDX_NB = 2048, IDX_QB = 16, IDX_G = 4;
#ifndef IDX_ZOOM
#define IDX_ZOOM 3
#endif
#ifndef IDX_CAP
#define IDX_CAP 256
#endif
constexpr int IL_HIST = 0;
constexpr int IL_FHIST = 32768;
constexpr int IL_VS = 32768;
constexpr int IL_MASK = 114688;
constexpr int IL_SEL = 131072;
constexpr int IL_QI = 139264;
constexpr int IL_FMISC = IL_QI + 512;
constexpr int IL_FIQ = IL_FMISC + 128;

__device__ __forceinline__ unsigned score_key(float s) { s += 0.f; const unsigned u = __float_as_uint(s); return (u & 0x80000000u) ? ~u : (u | 0x80000000u); }

template <int L> __device__ __forceinline__ void wlane(unsigned& mv, unsigned sv) { asm("s_nop 1\n\tv_writelane_b32 %0, %1, %2" : "+v"(mv) : "s"(sv), "n"(L)); }
__device__ __forceinline__ void wlane2(unsigned& mv, unsigned lo, unsigned hi_, int idx) {
    switch (idx) { case 0: wlane<0>(mv, lo); wlane<1>(mv, hi_); break; case 1: wlane<2>(mv, lo); wlane<3>(mv, hi_); break; case 2: wlane<4>(mv, lo); wlane<5>(mv, hi_); break; case 3: wlane<6>(mv, lo); wlane<7>(mv, hi_); break;
                   case 4: wlane<8>(mv, lo); wlane<9>(mv, hi_); break; case 5: wlane<10>(mv, lo); wlane<11>(mv, hi_); break; case 6: wlane<12>(mv, lo); wlane<13>(mv, hi_); break; default: wlane<14>(mv, lo); wlane<15>(mv, hi_); break; } }
template <int PASS, int MODE, bool EDGE>
__device__ __forceinline__ void idx_tile(LAS unsigned char* lds, const bf16x8 b0, const bf16x8 b1, int kt, const bf16x8 (&A)[IDX_G][2], const float (&w)[IDX_G][16], const float (&scq)[IDX_G][2], const float (&thr)[IDX_G][2], const float (&thr1)[IDX_G][2], const f32x16& zero16, int t0, int lane) {
    const int r32 = lane & 31, hi = lane >> 5, key = kt * 32 + r32;
    LAS unsigned* mask = (LAS unsigned*)(lds + IL_MASK); LAS int* qi = (LAS int*)(lds + IL_QI); LAS u32x2* cand = (LAS u32x2*)(lds + IL_HIST);
    const unsigned hb0 = (unsigned)(unsigned long long)(lds + IL_HIST + 2 * hi * 4096);
    unsigned mv = 0u;
#pragma unroll
    for (int g = 0; g < IDX_G; ++g) {
        f32x16 acc = __builtin_amdgcn_mfma_f32_32x32x16_bf16(A[g][0], b0, zero16, 0, 0, 0);
        acc = __builtin_amdgcn_mfma_f32_32x32x16_bf16(A[g][1], b1, acc, 0, 0, 0);
#pragma unroll
        for (int j = 0; j < 2; ++j) {
            float sA = (float)(IDX_NB / 2), sB = 0.f;
#pragma unroll
            for (int h = 0; h < 8; h += 2) { const float r0 = __builtin_amdgcn_fmed3f(acc[8 * j + h], 0.f, 3.0e38f), r1 = __builtin_amdgcn_fmed3f(acc[8 * j + h + 1], 0.f, 3.0e38f);
                sA = fmaf(r0, w[g][8 * j + h], sA); sB = fmaf(r1, w[g][8 * j + h + 1], sB); }
            asm volatile("" : "+v"(sA), "+v"(sB));
            const float xu = sA + sB;
            const int ql = 4 * g + 2 * hi + j;
            const bool valid = !EDGE || key <= t0 + ql;
            const float x = (PASS == 1) ? __builtin_amdgcn_fmed3f(xu, 0.f, (float)IDX_NB - 0.5f) : xu;
            if (PASS == 1) { const unsigned bin = (unsigned)x;
                if (MODE & 4) { asm volatile("" :: "v"(bin), "v"((int)valid)); }
                else { unsigned addr; asm("v_lshl_add_u32 %0, %1, 1, %2" : "=v"(addr) : "v"(bin & 0x7feu), "v"(hb0)); unsigned val = 1u << ((bin << 4) & 31u); if (EDGE) val = valid ? val : 0u;
                    lds_add((LAS unsigned*)((LAS unsigned char*)addr + (4 * g + j) * 4096), val); }
            } else {
                const bool ge1 = x >= thr1[g][j], ge0 = x >= thr[g][j];
                const bool above = valid && ge1, cnd = valid && ge0 && !ge1;
                const unsigned long long bal = __ballot(above);
                wlane2(mv, (unsigned)bal, (unsigned)(bal >> 32), 2 * g + j);
                if (cnd) { const int pos = lds_addi(qi + ql * 8 + 3, 1); if (pos < IDX_CAP) cand[ql * 256 + pos] = (u32x2){__float_as_uint(xu + 0.f), (unsigned)key}; }
            }
        }
    }
    if (PASS == 2 && lane < 16) { const int d = lane >> 1, qm = 4 * (d >> 1) + 2 * (lane & 1) + (d & 1); mask[qm * 256 + kt] = mv; }
}
constexpr int IDX_RING = 2;
__device__ __forceinline__ void idx_ring_fill(bf16x8 (&rb)[IDX_RING][2], const bf16_t* IKb, int NT, int wave, int lane) {
    const bf16_t* kp = IKb + (size_t)(lane & 31) * 32 + 8 * (lane >> 5);
#pragma unroll
    for (int d = 0; d < IDX_RING; ++d) { int k2 = wave + 8 * d; k2 = k2 < NT ? k2 : NT - 1; rb[d][0] = *(const bf16x8*)(kp + (size_t)k2 * 1024); rb[d][1] = *(const bf16x8*)(kp + (size_t)k2 * 1024 + 16); }
}
template <int PASS, int MODE>
__device__ __forceinline__ void idx_pass(LAS unsigned char* lds, const bf16_t* IKb, bf16x8 (&rb)[IDX_RING][2], const bf16x8 (&A)[IDX_G][2], const float (&w)[IDX_G][16], const float (&scq)[IDX_G][2], const float (&thr)[IDX_G][2], const float (&thr1)[IDX_G][2], int t0, int NT, int wave, int lane) {
    const int r32 = lane & 31, hi = lane >> 5;
    const bf16_t* kp = IKb + (size_t)r32 * 32 + 8 * hi;
    f32x16 zero16;
#pragma unroll
    for (int i = 0; i < 16; ++i) zero16[i] = 0.f;
    asm volatile("" : "+v"(zero16));
#pragma unroll 1
    for (int kt = wave; kt < NT; kt += IDX_RING * NWAVES) {
#pragma unroll
        for (int d = 0; d < IDX_RING; ++d) { const int ktd = kt + 8 * d;
            const bf16x8 c0 = rb[d][0], c1 = rb[d][1];
            { int k2 = ktd + IDX_RING * NWAVES; if (k2 >= NT) { k2 = wave + 8 * d; k2 = k2 < NT ? k2 : NT - 1; } rb[d][0] = *(const bf16x8*)(kp + (size_t)k2 * 1024); rb[d][1] = *(const bf16x8*)(kp + (size_t)k2 * 1024 + 16); }
            if (ktd < NT) { if (32 * ktd + 31 <= t0) idx_tile<PASS, MODE, false>(lds, c0, c1, ktd, A, w, scq, thr, thr1, zero16, t0, lane); else idx_tile<PASS, MODE, true>(lds, c0, c1, ktd, A, w, scq, thr, thr1, zero16, t0, lane); } }
    }
}

__device__ __forceinline__ void idx_fallback(const Ctx& c, const bf16_t* IQ, const bf16_t* IK, const float* IW, size_t kb, int t, int ql) {
    LAS unsigned* keys = (LAS unsigned*)(c.lds + IL_HIST); LAS unsigned* hist = (LAS unsigned*)(c.lds + IL_FHIST); LAS int* misc = (LAS int*)(c.lds + IL_FMISC);
    LAS float* iqs = (LAS float*)(c.lds + IL_FIQ); LAS float* iws = iqs + 256; LAS unsigned* mask = (LAS unsigned*)(c.lds + IL_MASK);
    const int tid = c.tid, lane = c.lane, wave = c.wave, n = t + 1; const size_t q = kb + t;
    if (tid < 256) iqs[tid] = bf2f(IQ[q * 256 + tid]);
    if (tid < 8) iws[tid] = IW[q * 8 + tid];
    if (tid == 0) { misc[0] = 0; misc[1] = TOPK; }
    __syncthreads();
#pragma unroll 1
    for (int s = tid; s < n; s += NTHREADS) {
        const u32x4* kr = (const u32x4*)(IK + (kb + s) * 32);
        float sc = 0.f;
#pragma unroll 1
        for (int h = 0; h < 8; ++h) { float d = 0.f;
#pragma unroll 1
            for (int i = 0; i < 4; ++i) { asm volatile("" ::: "memory"); const u32x4 w = kr[i]; const f32x4 q0 = *(const LAS f32x4*)(iqs + 32 * h + 8 * i), q1 = *(const LAS f32x4*)(iqs + 32 * h + 8 * i + 4);
                d += q0.x * bflo(w.x) + q0.y * bfhi(w.x) + q0.z * bflo(w.y) + q0.w * bfhi(w.y) + q1.x * bflo(w.z) + q1.y * bfhi(w.z) + q1.z * bflo(w.w) + q1.w * bfhi(w.w); }
            sc = fmaf(fmaxf(d, 0.f), iws[h], sc); }
        keys[s] = score_key(sc);
    }
    for (int rd = 0; rd < 4; ++rd) {
        const int shift = 24 - 8 * rd;
        if (tid < 256) hist[tid] = 0u;
        __syncthreads();
        const unsigned prefix = (unsigned)misc[0];
        for (int s = tid; s < n; s += NTHREADS) { const unsigned k = keys[s]; if (rd == 0 || (k >> (shift + 8)) == prefix) lds_add(&hist[(k >> shift) & 255u], 1u); }
        __syncthreads();
        if (wave == 0) {
            const int need = misc[1];
            unsigned cb[4]; unsigned sl = 0;
#pragma unroll
            for (int j = 0; j < 4; ++j) { cb[j] = hist[4 * lane + j]; sl += cb[j]; }
            const unsigned pre = wave_incl_scan(sl), totw = (unsigned)__builtin_amdgcn_readlane((int)pre, 63);
            const unsigned suf = totw - pre + sl;
            unsigned above = suf - sl;
            if (above < (unsigned)need && (unsigned)need <= suf) {
                bool done = false;
#pragma unroll
                for (int j = 3; j >= 0; --j) { if (!done) { if ((unsigned)need <= above + cb[j]) { misc[0] = (int)((prefix << 8) | (unsigned)(4 * lane + j)); misc[1] = need - (int)above; misc[2] = (int)cb[j]; done = true; } else above += cb[j]; } }
            }
        }
        __syncthreads();
    }
    const unsigned Tk = (unsigned)misc[0]; const int need_eq = misc[1];
    const int seg = (((n + 7) >> 3) + 63) & ~63, s_lo = wave * seg, s_hi = (s_lo + seg < n) ? (s_lo + seg) : n;
    int neq = 0;
    for (int s0 = s_lo; s0 < s_hi; s0 += 64) { const int s = s0 + lane; const bool eq = (s < s_hi) && keys[s] == Tk; neq += __popcll(__ballot(eq)); }
    if (lane == 0) misc[12 + wave] = neq;
    __syncthreads();
    int peq = 0;
    for (int w = 0; w < wave; ++w) peq += misc[12 + w];
    for (int s0 = s_lo; s0 < s_hi; s0 += 64) { const int s = s0 + lane; const unsigned k = (s < s_hi) ? keys[s] : 0u; const bool gt = (s < s_hi) && k > Tk, eq = (s < s_hi) && k == Tk;
        const unsigned long long be_ = __ballot(eq); const int myeq = peq + __popcll(be_ & ((1ull << lane) - 1ull));
        const unsigned long long bs = __ballot(gt || (eq && myeq < need_eq));
        if (lane == 0) { mask[ql * 256 + (s0 >> 5)] = (unsigned)bs; if ((s0 >> 5) + 1 < 256) mask[ql * 256 + (s0 >> 5) + 1] = (unsigned)(bs >> 32); }
        peq += __popcll(be_); }
    __syncthreads();
}

__device__ __forceinline__ void idx_attend(LAS unsigned char* lds, const bf16_t* QN, const bf16_t* KN, const bf16_t* VB, bf16_t* YO, size_t kb, int t, int ql, int NT, int wave, int lane) {
    LAS unsigned* mask = (LAS unsigned*)(lds + IL_MASK) + ql * 256; LAS int* sel = (LAS int*)(lds + IL_SEL) + wave * 256; LAS unsigned char* vs = lds + IL_VS + wave * 10240;
    const size_t tok = kb + t; const int fr = lane & 15, fq = lane >> 4;
    unsigned wd[4]; int cntl = 0;
#pragma unroll
    for (int i = 0; i < 4; ++i) { const int kt = 4 * lane + i; wd[i] = (kt < NT) ? mask[kt] : 0u; cntl += __popc(wd[i]); }
    const int incl = (int)wave_incl_scan((unsigned)cntl);
    const int nsel = __builtin_amdgcn_readlane(incl, 63); int pos = incl - cntl;
#pragma unroll
    for (int i = 0; i < 4; ++i) { unsigned wv = wd[i]; while (wv) { const int bpos = __builtin_ctz(wv); if (pos < 256) sel[(pos & 15) * 16 + (pos >> 4)] = (4 * lane + i) * 32 + bpos; ++pos; wv &= wv - 1u; } }
    for (int p = nsel + lane; p < 256; p += 64) sel[(p & 15) * 16 + (p >> 4)] = 0;
    asm volatile("s_waitcnt lgkmcnt(0)" ::: "memory");
    const bf16_t* qrow = QN + tok * 512 + (fr & 7) * 64 + 8 * fq; const bf16x8 qb0 = *(const bf16x8*)qrow, qb1 = *(const bf16x8*)(qrow + 32);
    const char* KNb = (const char*)(KN + kb * 64); const char* VBb = (const char*)(VB + kb * 64);
    const unsigned vlo = 16u * (unsigned)(lane & 7), klo = 16u * (unsigned)fq;
    u32x4 vr[2][8];
#pragma unroll
    for (int c2 = 0; c2 < 2; ++c2)
    { const i32x4 ev = *(const LAS i32x4*)(sel + 16 * (lane >> 3) + 4 * c2), od = *(const LAS i32x4*)(sel + 16 * ((lane >> 3) + 8) + 4 * c2);
#pragma unroll
        for (int i = 0; i < 8; ++i) { const unsigned key = (unsigned)((i & 1) ? od[i >> 1] : ev[i >> 1]); vr[c2][i] = *(const u32x4*)(VBb + (key * 128u + vlo)); } }
    f32x4 sc[16];
#pragma unroll
    for (int hb = 0; hb < 2; ++hb) {
        bf16x8 kf[8][2];
        const i32x4 ka = *(const LAS i32x4*)(sel + 16 * fr + 8 * hb), kc = *(const LAS i32x4*)(sel + 16 * fr + 8 * hb + 4);
#pragma unroll
        for (int k8 = 0; k8 < 8; ++k8) { const unsigned key = (unsigned)((k8 < 4) ? ka[k8 & 3] : kc[k8 & 3]); const char* kr = KNb + (key * 128u + klo); kf[k8][0] = *(const bf16x8*)kr; kf[k8][1] = *(const bf16x8*)(kr + 64); }
        __builtin_amdgcn_sched_barrier(0);
#pragma unroll
        for (int k8 = 0; k8 < 8; ++k8) { f32x4 a = {0.f, 0.f, 0.f, 0.f}; a = __builtin_amdgcn_mfma_f32_16x16x32_bf16(kf[k8][0], qb0, a, 0, 0, 0); a = __builtin_amdgcn_mfma_f32_16x16x32_bf16(kf[k8][1], qb1, a, 0, 0, 0); sc[8 * hb + k8] = a; }
        __builtin_amdgcn_sched_barrier(0);
    }
    float mx = -INFINITY;
    if (nsel < 256) {
#pragma unroll
        for (int kt = 0; kt < 16; ++kt)
#pragma unroll
            for (int i = 0; i < 4; ++i) if (16 * kt + 4 * fq + i >= nsel) sc[kt][i] = -INFINITY; }
#pragma unroll
    for (int kt = 0; kt < 16; ++kt)
#pragma unroll
        for (int i = 0; i < 4; ++i) mx = fmaxf(mx, sc[kt][i]);
    mx = fmaxf(mx, xor16_f(mx)); mx = max_x32(mx);
    float sm = 0.f;
#pragma unroll
    for (int kt = 0; kt < 16; ++kt)
#pragma unroll
        for (int i = 0; i < 4; ++i) { sc[kt][i] = __expf(sc[kt][i] - mx); sm += sc[kt][i]; }
    sm += xor16_f(sm); sm = sum_x32(sm);
    const float inv = __builtin_amdgcn_rcpf(sm);
    bf16x8 pf[8];
#pragma unroll
    for (int s = 0; s < 8; ++s) { const u32x2 lo = pack4(sc[2 * s] * inv), hi2 = pack4(sc[2 * s + 1] * inv); const u32x4 w4 = {lo.x, lo.y, hi2.x, hi2.y}; pf[s] = __builtin_bit_cast(bf16x8, w4); }
    f32x4 o[4];
#pragma unroll
    for (int dt = 0; dt < 4; ++dt) o[dt] = (f32x4){0.f, 0.f, 0.f, 0.f};
#pragma unroll
    for (int ch = 0; ch < 4; ++ch) {
#pragma unroll
        for (int i = 0; i < 8; ++i) *(LAS u32x4*)(vs + ((lane >> 3) + 8 * i) * 160 + 16 * (lane & 7)) = vr[ch & 1][i];
        if (ch < 2) {
            { const i32x4 ev = *(const LAS i32x4*)(sel + 16 * (lane >> 3) + 4 * (ch + 2)), od = *(const LAS i32x4*)(sel + 16 * ((lane >> 3) + 8) + 4 * (ch + 2));
#pragma unroll
            for (int i = 0; i < 8; ++i) { const unsigned key = (unsigned)((i & 1) ? od[i >> 1] : ev[i >> 1]); vr[ch & 1][i] = *(const u32x4*)(VBb + (key * 128u + vlo)); } } }
        __builtin_amdgcn_sched_barrier(0);
        bf16x8 vf[2][4];
#pragma unroll
        for (int ls = 0; ls < 2; ++ls)
#pragma unroll
            for (int dt = 0; dt < 4; ++dt) {
                LAS unsigned char* ad = vs + (32 * ls + 4 * fq + (fr >> 2)) * 160 + (16 * dt + 4 * (lane & 3)) * 2;
                const s16x4 lo = __builtin_amdgcn_ds_read_tr16_b64_v4i16((LAS s16x4*)ad), hi2 = __builtin_amdgcn_ds_read_tr16_b64_v4i16((LAS s16x4*)(ad + 16 * 160));
                vf[ls][dt] = (bf16x8){lo[0], lo[1], lo[2], lo[3], hi2[0], hi2[1], hi2[2], hi2[3]};
            }
        __builtin_amdgcn_sched_barrier(0);
#pragma unroll
        for (int ls = 0; ls < 2; ++ls)
#pragma unroll
            for (int dt = 0; dt < 4; ++dt) o[dt] = __builtin_amdgcn_mfma_f32_16x16x32_bf16(vf[ls][dt], pf[2 * ch + ls], o[dt], 0, 0, 0);
        __builtin_amdgcn_sched_barrier(0);
    }
    if (fr < 8) {
#pragma unroll
        for (int dt = 0; dt < 4; ++dt) *(u32x2*)(YO + tok * 1024 + 512 + fr * 64 + 16 * dt + 4 * fq) = pack4(o[dt]);
    }
}

template <int MODE  >
__device__ __forceinline__ void phase_idx_attn(const Ctx& c, int l) {
    const int tid = c.tid, lane = c.lane, wave = c.wave;
    const bf16_t* QN = (const bf16_t*)(c.ws + WS_QN); const bf16_t* KN = (const bf16_t*)(c.ws + WS_KN); const bf16_t* VB = (const bf16_t*)(c.ws + WS_VB);
    const bf16_t* IQ = (const bf16_t*)(c.ws + WS_IQ); const bf16_t* IK = (const bf16_t*)(c.ws + WS_IK); const float* IW = (const float*)(c.ws + WS_IW);
    bf16_t* YO = (bf16_t*)(c.ws + WS_YO);
    LAS int* qi = (LAS int*)(c.lds + IL_QI);
    const unsigned* maxik = (const unsigned*)(c.ws + WS_CTL + CTL_MAXIK) + l * 2; const float* PR = (const float*)(c.ws + WS_PR);
    constexpr int UPB = L / IDX_QB;
    for (int o = c.bid; o < 2 * UPB; o += c.nb) {
        const int b = o / UPB, w_ = o % UPB, ub = (w_ < UPB / 2) ? w_ : (UPB + UPB / 2 - 1 - w_);
        const int t0 = ub * IDX_QB, NT = (t0 + IDX_QB + 31) >> 5; const size_t kb = (size_t)b * L;
        const bool need_select = (t0 + IDX_QB - 1 >= TOPK) && !(MODE & 2);
        __syncthreads();
        { LAS u32x4* h4 = (LAS u32x4*)(c.lds + IL_HIST);
#pragma unroll
            for (int i = 0; i < 8; ++i) h4[tid + NTHREADS * i] = (u32x4){0u, 0u, 0u, 0u}; }
        if (tid < IDX_QB) { qi[tid * 8 + 1] = -1; qi[tid * 8 + 2] = 0; qi[tid * 8 + 3] = 0; qi[tid * 8 + 4] = 0; }
        const int NTP = (MODE & 16) ? 8 : NT;
        if (need_select) {
            int lane1 = lane; asm volatile("" : "+v"(lane1));
            const int r32 = lane1 & 31, hi = lane1 >> 5;
            bf16x8 A[IDX_G][2]; float w[IDX_G][16]; float scq[IDX_G][2]; float thr[IDX_G][2], thr1[IDX_G][2]; bf16x8 rb[IDX_RING][2];
            const int qsel = 2 * ((r32 >> 2) & 1) + ((r32 >> 4) & 1), head = (r32 & 3) + 4 * ((r32 >> 3) & 1);
            const float mk = sqrtf(__uint_as_float(maxik[b])) * 1.001f;
#pragma unroll
            for (int g = 0; g < IDX_G; ++g) { const bf16_t* ar = IQ + (kb + t0 + 4 * g + qsel) * 256 + head * 32 + 8 * hi; A[g][0] = *(const bf16x8*)ar; A[g][1] = *(const bf16x8*)(ar + 16);
#pragma unroll
                for (int j = 0; j < 2; ++j) { const int ql = 4 * g + 2 * hi + j; const f32x4 w0 = *(const f32x4*)(IW + (kb + t0 + ql) * 8), w1 = *(const f32x4*)(IW + (kb + t0 + ql) * 8 + 4);
                    w[g][8 * j + 0] = w0.x; w[g][8 * j + 1] = w0.y; w[g][8 * j + 2] = w0.z; w[g][8 * j + 3] = w0.w; w[g][8 * j + 4] = w1.x; w[g][8 * j + 5] = w1.y; w[g][8 * j + 6] = w1.z; w[g][8 * j + 7] = w1.w;
                    scq[g][j] = (float)(IDX_ZOOM * (IDX_NB / 2)) / (PR[kb + t0 + ql] * mk + 1e-20f); thr[g][j] = -1.f; thr1[g][j] = 0.f;
#pragma unroll
                    for (int h = 0; h < 8; ++h) w[g][8 * j + h] *= scq[g][j]; } }
            idx_ring_fill(rb, IK + kb * 32, NTP, wave, lane1);
            __syncthreads();
            idx_pass<1, MODE>(c.lds, IK + kb * 32, rb, A, w, scq, thr, thr1, t0, NTP, wave, lane1);
            __syncthreads();
#pragma unroll 1
            for (int qq = 0; qq < 2; ++qq) { const int ql = 2 * wave + qq;
                if (t0 + ql + 1 > TOPK) {
                    const LAS u32x4* hq = (const LAS u32x4*)(c.lds + IL_HIST + ql * 4096) + 4 * lane; unsigned wv[16]; unsigned tot = 0;
#pragma unroll
                    for (int i = 0; i < 4; ++i) { const u32x4 x = hq[i]; wv[4 * i] = x.x; wv[4 * i + 1] = x.y; wv[4 * i + 2] = x.z; wv[4 * i + 3] = x.w; }
#pragma unroll
                    for (int i = 0; i < 16; ++i) tot += (wv[i] & 0xffffu) + (wv[i] >> 16);
                    const unsigned pre = wave_incl_scan(tot), totw = (unsigned)__builtin_amdgcn_readlane((int)pre, 63);
                    const unsigned suf = totw - pre + tot;
                    const unsigned above = suf - tot;
                    const unsigned long long bm = __ballot(above < (unsigned)TOPK && (unsigned)TOPK <= suf);
                    if (bm) { const int Ls = __builtin_ctzll(bm); const unsigned ab = (unsigned)__builtin_amdgcn_readlane((int)above, Ls);
                        const int b = 31 - (lane & 31); unsigned cb = 0;
                        if (lane < 32) cb = *(const LAS unsigned short*)(c.lds + IL_HIST + ql * 4096 + (32 * Ls + b) * 2);
                        const unsigned pre = wave_incl_scan(cb);
                        if (lane < 32 && ab + pre >= (unsigned)TOPK && ab + pre - cb < (unsigned)TOPK) { qi[ql * 8 + 1] = 32 * Ls + b; qi[ql * 8 + 2] = TOPK - (int)(ab + pre - cb); } }
                } }
            __syncthreads();
#pragma unroll
            for (int g = 0; g < IDX_G; ++g)
#pragma unroll
                for (int j = 0; j < 2; ++j) { const int tb = qi[(4 * g + 2 * hi + j) * 8 + 1]; const float tf = (float)tb; thr[g][j] = (tb <= 0) ? -INFINITY : tf; thr1[g][j] = (tb < 0) ? -INFINITY : ((tb >= IDX_NB - 1) ? INFINITY : tf + 1.f); }
            if (!(MODE & 8)) idx_pass<2, MODE>(c.lds, IK + kb * 32, rb, A, w, scq, thr, thr1, t0, NTP, wave, lane1);
            __syncthreads();
#pragma unroll 1
            for (int qq = 0; qq < 2; ++qq) { const int ql = 2 * wave + qq; const int cn = qi[ql * 8 + 3], need = qi[ql * 8 + 2];
                if (cn > IDX_CAP) { if (lane == 0) qi[ql * 8 + 4] = 1; }
                else { const LAS u32x2* cd = (const LAS u32x2*)(c.lds + IL_HIST) + ql * 256; LAS unsigned* mq = (LAS unsigned*)(c.lds + IL_MASK) + ql * 256;
                    for (int i0 = 0; i0 < cn; i0 += 64) { const int i = i0 + lane; const u32x2 me = cd[i < cn ? i : 0]; const float ms = __uint_as_float(me.x); int rank = 0;
                        for (int j = 0; j < cn; ++j) { const u32x2 ot = cd[j]; const float os = __uint_as_float(ot.x); rank += (os > ms || (os == ms && ot.y < me.y)) ? 1 : 0; }
                        if (i < cn && rank < need) __hip_atomic_fetch_or(mq + (me.y >> 5), 1u << (me.y & 31u), __ATOMIC_RELAXED, __HIP_MEMORY_SCOPE_WORKGROUP); } } }
            __syncthreads();
            { unsigned long long ovf = __ballot(lane < IDX_QB && qi[(lane & (IDX_QB - 1)) * 8 + 4] != 0);
#pragma unroll 1
              while (ovf) { const int ql = __builtin_ctzll(ovf); ovf &= ovf - 1ull; idx_fallback(c, IQ, IK, IW, kb, t0 + ql, ql); } }
        } else {
            __syncthreads();
            LAS unsigned* mask = (LAS unsigned*)(c.lds + IL_MASK);
            for (int i = tid; i < IDX_QB * NT; i += NTHREADS) { const int ql = i / NT, kt = i % NT; const int hi_key = t0 + ql - 32 * kt;
                mask[ql * 256 + kt] = hi_key < 0 ? 0u : (hi_key >= 31 ? 0xffffffffu : ((2u << hi_key) - 1u)); }
            __syncthreads();
        }
        if (!(MODE & 1)) {
#pragma unroll 1
            for (int qq = 0; qq < 2; ++qq) { int lane2 = lane; asm volatile("" : "+v"(lane2)); idx_attend(c.lds, QN, KN, VB, YO, kb, t0 + 2 * wave + qq, 2 * wave + qq, NT, wave, lane2); } }
    }
}

struct EpiD1 {
    EPI_COMMON_P
    const bf16_t* gates; const float* bc; bf16_t* Mo;
    __device__ __forceinline__ void half(const f32x4 (&acc)[2][4][2], int ai, const GUnit& u, int wr, int wc, int fr, int fq) const {
        const int which = u.aux;
#pragma unroll
        for (int m = 0; m < 4; ++m) { const size_t row = (size_t)u.row0 + 128 * ai + 64 * wr + 16 * m + fr;
#pragma unroll
            for (int bj = 0; bj < 2; ++bj) { const int col = 256 * u.pn + 128 * bj + 32 * wc + 8 * fq;
                const u32x4 gw = *(const u32x4*)(gates + row * 2048 + which * 1024 + col);
                const f32x4 g0 = {bflo(gw.x), bfhi(gw.x), bflo(gw.y), bfhi(gw.y)}, g1 = {bflo(gw.z), bfhi(gw.z), bflo(gw.w), bfhi(gw.w)}; f32x4 o0, o1;
                if (which == 0) { o0 = g0 * (acc[bj][m][0] + *(const f32x4*)(bc + col)); o1 = g1 * (acc[bj][m][1] + *(const f32x4*)(bc + col + 4)); }
                else { const u32x4 pw = *(const u32x4*)(Mo + row * 1024 + col);
                    o0 = (f32x4){bflo(pw.x), bfhi(pw.x), bflo(pw.y), bfhi(pw.y)} + g0 * acc[bj][m][0]; o1 = (f32x4){bflo(pw.z), bfhi(pw.z), bflo(pw.w), bfhi(pw.w)} + g1 * acc[bj][m][1]; }
                *(u32x4*)(Mo + row * 1024 + col) = pack8(o0, o1); } }
    }
};
struct SchedD1 { static constexpr int A_AUX = 0; const char* A; const char* B; int G, c;
    __device__ __forceinline__ bool next(int i, GUnit& u) const { const int Lq = (i >> 1) * G + c, which = i & 1; if (Lq >= 64 * 4) return false; int pm, pn; pg8::tile_order(Lq, 64, 4, pm, pn);
        u.pm = pm; u.pn = pn; u.aux = which; u.row0 = pm * 256; u.rows = nullptr; u.A = A + ((size_t)pm * 256 * 1024 + which * 512) * 2; u.B = B + ((size_t)pn * 256 * 1024 + which * 512) * 2; return true; }
    __device__ __forceinline__ void a_ready(const GUnit&) const {}
    __device__ __forceinline__ void done(const GUnit&) const {}
};
__device__ __forceinline__ void phase_gemm_d1(const Ctx& c, int l) {
    SchedD1 S{(const char*)(c.ws + WS_YO), (const char*)(c.ws + WS_WCA) + (size_t)l * D * D * 2, c.nb, c.bid};
    EpiD1 E{(const bf16_t*)(c.ws + WS_GATES), c.in[13] + l * D, (bf16_t*)(c.ws + WS_H)};
    pg8::gemm_phase<EpiD1, SchedD1, true, true>(c.lds, pg8::Gemm{1024, 1024, opaque_u(512), T}, S, E, c.tid);
}
template <bool XBF>
struct EpiD2 {
    EPI_COMMON_P
    const void* xin; bf16_t* xout; const float* gate;
    __device__ __forceinline__ void half(const f32x4 (&acc)[2][4][2], int ai, const GUnit& u, int wr, int wc, int fr, int fq) const {
        const float* gb = gate + (u.row0 / L) * 6144;
#pragma unroll
        for (int m = 0; m < 4; ++m) { const size_t row = (size_t)u.row0 + 128 * ai + 64 * wr + 16 * m + fr;
#pragma unroll
            for (int bj = 0; bj < 2; ++bj) { const int col = 256 * u.pn + 128 * bj + 32 * wc + 8 * fq; f32x4 x0, x1;
                if (XBF) { const u32x4 xw = *(const u32x4*)((const bf16_t*)xin + row * D + col); x0 = (f32x4){bflo(xw.x), bfhi(xw.x), bflo(xw.y), bfhi(xw.y)}; x1 = (f32x4){bflo(xw.z), bfhi(xw.z), bflo(xw.w), bfhi(xw.w)}; }
                else { x0 = *(const f32x4*)((const float*)xin + row * D + col); x1 = *(const f32x4*)((const float*)xin + row * D + col + 4); }
                const f32x4 g0 = *(const f32x4*)(gb + col), g1 = *(const f32x4*)(gb + col + 4);
                *(u32x4*)(xout + row * D + col) = pack8(x0 + g0 * acc[bj][m][0], x1 + g1 * acc[bj][m][1]); } }
    }
};
struct SchedD2 { static constexpr int A_AUX = 0; const char* A; const char* B; int G, c;
    __device__ __forceinline__ bool next(int i, GUnit& u) const { const int Lq = i * G + c; if (Lq >= 64 * 4) return false; int pm, pn; pg8::tile_order(Lq, 64, 4, pm, pn);
        u.pm = pm; u.pn = pn; u.aux = 0; u.row0 = pm * 256; u.rows = nullptr; u.A = A + (size_t)pm * 256 * D * 2; u.B = B + (size_t)pn * 256 * D * 2; return true; }
    __device__ __forceinline__ void a_ready(const GUnit&) const {}
    __device__ __forceinline__ void done(const GUnit&) const {}
};
__device__ __forceinline__ void phase_gemm_d2(const Ctx& c, int l) {
    SchedD2 S{(const char*)(c.ws + WS_H), (const char*)(c.ws + WS_WO) + (size_t)l * D * D * 2, c.nb, c.bid};
    const float* gate = (const float*)(c.ws + WS_CTL + CTL_MOD) + (l * 2) * 6144 + 2 * D; bf16_t* X1 = (bf16_t*)(c.ws + WS_X1);
    if (l == 0) { EpiD2<false> E{c.in[0], X1, gate}; pg8::gemm_phase<EpiD2<false>, SchedD2, true, true>(c.lds, pg8::Gemm{D, D, opaque_u(D), T}, S, E, c.tid); }
    else { EpiD2<true> E{c.out, X1, gate}; pg8::gemm_phase<EpiD2<true>, SchedD2, true, true>(c.lds, pg8::Gemm{D, D, opaque_u(D), T}, S, E, c.tid); }
}

constexpr int RT_ROWE = 1032, RT_WLO = 36 * RT_ROWE * 2, RT_LG = 2 * RT_WLO;
template <bool DRY>
__device__ __forceinline__ void phase_norm2_route(const Ctx& c, int l) {
    LAS bf16_t* Whi = (LAS bf16_t*)c.lds; LAS bf16_t* Wlo = (LAS bf16_t*)(c.lds + RT_WLO);
    constexpr int IMG_STEPS = (RT_LG / 16 + NTHREADS - 1) / NTHREADS;
    u32x4 im[IMG_STEPS];
    { const u32x4* img = (const u32x4*)(c.ws + WS_RTW + (size_t)l * RT_LG);
#pragma unroll
        for (int k = 0; k < IMG_STEPS; ++k) { const int i = c.tid + NTHREADS * k; im[k] = (i < RT_LG / 16) ? img[i] : (u32x4){0u, 0u, 0u, 0u}; } }
    bool staged = false;
    LAS int* lcnt = (LAS int*)(c.lds + RT_LG + 12288 + 128); LAS int* gbase = lcnt + 64;
    const int lane = c.lane, wave = c.wave, tk = lane & 7, fr = lane & 15, fq = lane >> 4;
    const float* mod = (const float*)(c.ws + WS_CTL + CTL_MOD); const float* g2 = c.in[16] + l * D;
    int* cnt = (int*)(c.ws + WS_CTL + CTL_CNT) + l * NE; bf16_t* H2 = (bf16_t*)(c.ws + WS_H2);
    i32x4* rt = (i32x4*)(c.ws + WS_ROUTE); f32x2* rw = (f32x2*)(c.ws + WS_ROUTE + 512 * 1024); int* inv = (int*)(c.ws + WS_INV);
    const float* bg = c.in[18] + l * NG; const float* br = c.in[20] + l * NE;
    LAS float* LG = (LAS float*)(c.lds + RT_LG) + wave * (8 * 48);
    for (int m0 = c.bid * 64; m0 < T; m0 += c.nb * 64) {
        const int m = m0 + 8 * wave + tk; const float* mb = mod + (l * 2 + m0 / L) * 6144; const bf16_t* xr = (const bf16_t*)(c.ws + WS_X1) + (size_t)m * D + 8 * fq;
        float ssq = 0.f;
#pragma unroll
        for (int ch = 0; ch < 2; ++ch) { u32x4 xw[16];
#pragma unroll
            for (int s8 = 0; s8 < 16; ++s8) xw[s8] = *(const u32x4*)(xr + 32 * (16 * ch + s8));
#pragma unroll
            for (int s8 = 0; s8 < 16; ++s8) { const f32x4 xa = {bflo(xw[s8].x), bfhi(xw[s8].x), bflo(xw[s8].y), bfhi(xw[s8].y)}, xb = {bflo(xw[s8].z), bfhi(xw[s8].z), bflo(xw[s8].w), bfhi(xw[s8].w)};
                ssq += (xa.x * xa.x + xa.y * xa.y) + (xa.z * xa.z + xa.w * xa.w) + (xb.x * xb.x + xb.y * xb.y) + (xb.z * xb.z + xb.w * xb.w); } }
        ssq += xor16_f(ssq); ssq = sum_x32(ssq);
        if (!staged) { staged = true; LAS u32x4* dst = (LAS u32x4*)c.lds;
#pragma unroll
            for (int k = 0; k < IMG_STEPS; ++k) { const int i = c.tid + NTHREADS * k; if (i < RT_LG / 16) dst[i] = im[k]; }
            if (c.tid < NE) lcnt[c.tid] = 0;
            __syncthreads(); }
        const float rstd = __builtin_amdgcn_rsqf(ssq * (1.f / D) + EPS);
        f32x4 acc[3];
#pragma unroll
        for (int n = 0; n < 3; ++n) acc[n] = (f32x4){0.f, 0.f, 0.f, 0.f};
        const int wrow[3] = {fr, 16 + fr, (32 + fr) < 36 ? 32 + fr : 35};
#pragma unroll 2
        for (int s = 0; s < 32; ++s) { const int k0 = 32 * s + 8 * fq;
            const u32x4 xw = *(const u32x4*)(xr + 32 * s); const f32x4 x0 = {bflo(xw.x), bfhi(xw.x), bflo(xw.y), bfhi(xw.y)}, x1 = {bflo(xw.z), bfhi(xw.z), bflo(xw.w), bfhi(xw.w)};
            const f32x4 ga = *(const f32x4*)(g2 + k0), gb = *(const f32x4*)(g2 + k0 + 4), sa = *(const f32x4*)(mb + 4 * D + k0), sb = *(const f32x4*)(mb + 4 * D + k0 + 4), ha = *(const f32x4*)(mb + 3 * D + k0), hb = *(const f32x4*)(mb + 3 * D + k0 + 4);
            const f32x4 h0 = x0 * rstd * ga * (sa + 1.f) + ha, h1 = x1 * rstd * gb * (sb + 1.f) + hb;
            const u32x4 hi4 = {pk2(h0.x, h0.y), pk2(h0.z, h0.w), pk2(h1.x, h1.y), pk2(h1.z, h1.w)};
            const f32x4 l0 = h0 - (f32x4){bflo(hi4.x), bfhi(hi4.x), bflo(hi4.y), bfhi(hi4.y)}, l1 = h1 - (f32x4){bflo(hi4.z), bfhi(hi4.z), bflo(hi4.w), bfhi(hi4.w)};
            const u32x4 lo4 = {pk2(l0.x, l0.y), pk2(l0.z, l0.w), pk2(l1.x, l1.y), pk2(l1.z, l1.w)};
            if (!DRY && fr < 8) *(u32x4*)(H2 + (size_t)m * D + k0) = hi4;
            const bf16x8 ahi = __builtin_bit_cast(bf16x8, hi4), alo = __builtin_bit_cast(bf16x8, lo4);
#pragma unroll
            for (int n = 0; n < 3; ++n) { const bf16x8 bhi = *(const LAS bf16x8*)(Whi + wrow[n] * RT_ROWE + k0), blo = *(const LAS bf16x8*)(Wlo + wrow[n] * RT_ROWE + k0);
                acc[n] = __builtin_amdgcn_mfma_f32_16x16x32_bf16(ahi, bhi, acc[n], 0, 0, 0);
                acc[n] = __builtin_amdgcn_mfma_f32_16x16x32_bf16(ahi, blo, acc[n], 0, 0, 0);
                acc[n] = __builtin_amdgcn_mfma_f32_16x16x32_bf16(alo, bhi, acc[n], 0, 0, 0); } }
        if (fq < 2) {
#pragma unroll
            for (int n = 0; n < 3; ++n)
#pragma unroll
                for (int i = 0; i < 4; ++i) LG[(4 * fq + i) * 48 + 16 * n + fr] = acc[n][i]; }
        asm volatile("s_waitcnt lgkmcnt(0)" ::: "memory");
        int ea = 0, eb = 0, la = 0, lb = 0; float wa = 0.f, wb = 0.f;
        if (lane < 8) { const LAS f32x4* lg4 = (const LAS f32x4*)(LG + lane * 48);
            const f32x4 g4 = lg4[0];
            float gl[4] = {g4.x + bg[0], g4.y + bg[1], g4.z + bg[2], g4.w + bg[3]}; int gs = 0; float gm = gl[0];
#pragma unroll
            for (int g = 1; g < 4; ++g) if (gl[g] > gm) { gm = gl[g]; gs = g; }
            float gsum = 0.f;
#pragma unroll
            for (int g = 0; g < 4; ++g) gsum += __expf(gl[g] - gm);
            const float pg = __builtin_amdgcn_rcpf(gsum);
            const f32x4 ea4 = lg4[1 + 2 * gs], eb4 = lg4[2 + 2 * gs]; const f32x4 ba4 = *(const f32x4*)(br + 8 * gs), bb4 = *(const f32x4*)(br + 8 * gs + 4);
            const float ev[8] = {ea4.x + ba4.x, ea4.y + ba4.y, ea4.z + ba4.z, ea4.w + ba4.w, eb4.x + bb4.x, eb4.y + bb4.y, eb4.z + bb4.z, eb4.w + bb4.w};
            int i1 = 0; float v1 = ev[0];
#pragma unroll
            for (int e = 1; e < 8; ++e) if (ev[e] > v1) { v1 = ev[e]; i1 = e; }
            int i2 = -1; float v2 = -INFINITY;
#pragma unroll
            for (int e = 0; e < 8; ++e) { if (e != i1 && (i2 < 0 || ev[e] > v2)) { i2 = e; v2 = ev[e]; } }
            const float e2 = __expf(v2 - v1), p1 = __builtin_amdgcn_rcpf(1.f + e2), p2 = e2 * p1;
            if (DRY) { asm volatile("" :: "v"(pg * p1), "v"(pg * p2), "v"(gs * 8 + i1), "v"(gs * 8 + i2)); }
            else { ea = gs * 8 + i1; eb = gs * 8 + i2; wa = pg * p1; wb = pg * p2; la = lds_addi(lcnt + ea, 1); lb = lds_addi(lcnt + eb, 1); } }
        if (!DRY) {
            __syncthreads();
            if (c.tid < NE) { const int n = lcnt[c.tid]; gbase[c.tid] = n ? atomicAdd(cnt + c.tid, n) : 0; }
            __syncthreads();
            if (lane < 8) { const int mt = m0 + 8 * wave + lane; const int ra = gbase[ea] + la, rb = gbase[eb] + lb;
                rt[mt] = (i32x4){ea, ra, eb, rb}; rw[mt] = (f32x2){wa, wb}; inv[(size_t)ea * T + ra] = mt; inv[(size_t)eb * T + rb] = mt; }
            __syncthreads();
            if (c.tid < NE) lcnt[c.tid] = 0;
            __syncthreads();
        }
    }
}
__device__ __forceinline__ void expert_bases(const int* cnt, LAS int* base  , int tid) {
    if (tid < 64) {
        const int n = (tid < NE) ? cnt[tid] : 0, nt_ = (n + 255) >> 8; const int incl = (int)wave_incl_scan((unsigned)nt_), start = incl - nt_;
        if (tid < NE) { base[tid] = start << 8; for (int i = 0; i < nt_; ++i) base[40 + start + i] = tid; }
        if (tid == NE - 1) base[NE] = incl << 8; }
    __syncthreads();
}
__device__ __forceinline__ void phase_scatter(const Ctx& c, int l) {
    LAS int* base = (LAS int*)(c.lds + 131072); const int* cnt = (const int*)(c.ws + WS_CTL + CTL_CNT) + l * NE;
    expert_bases(cnt, base, c.tid);
    const i32x4* rt = (const i32x4*)(c.ws + WS_ROUTE); int* slots = (int*)(c.ws + WS_ROUTE + 768 * 1024); int* rowl = (int*)(c.ws + WS_ROWL);
    for (int m = c.bid * NTHREADS + c.tid; m < T; m += c.nb * NTHREADS) { const i32x4 r = rt[m]; const int s1 = base[r.x] + r.y, s2 = base[r.z] + r.w;
        slots[2 * m] = s1; slots[2 * m + 1] = s2; rowl[s1] = m; rowl[s2] = m; }
    for (int e = c.bid; e < NE; e += c.nb) for (int sidx = base[e] + cnt[e] + c.tid; sidx < base[e + 1]; sidx += NTHREADS) rowl[sidx] = -1;
}
struct EpiMoe1 {
    EPI_COMMON_P
    bf16_t* hid;
    __device__ __forceinline__ void half(const f32x4 (&acc)[2][4][2], int ai, const GUnit& u, int wr, int wc, int fr, int fq) const {
#pragma unroll
        for (int m = 0; m < 4; ++m) { const size_t row = (size_t)u.row0 + 128 * ai + 64 * wr + 16 * m + fr; f32x4 o[2];
#pragma unroll
            for (int n = 0; n < 2; ++n)
#pragma unroll
                for (int i = 0; i < 4; ++i) o[n][i] = siluf_(acc[0][m][n][i]) * acc[1][m][n][i];
            st16_wt(hid, (unsigned)(row * DE + 128 * u.pn + 32 * wc + 8 * fq) * 2u, pack8(o[0], o[1])); }
    }
};
struct EpiMoe2 {
    EPI_COMMON_P
    bf16_t* ys;
    __device__ __forceinline__ void half(const f32x4 (&acc)[2][4][2], int ai, const GUnit& u, int wr, int wc, int fr, int fq) const {
#pragma unroll
        for (int m = 0; m < 4; ++m) { const size_t row = (size_t)u.row0 + 128 * ai + 64 * wr + 16 * m + fr;
#pragma unroll
            for (int bj = 0; bj < 2; ++bj) *(u32x4*)(ys + row * D + 256 * u.pn + 128 * bj + 32 * wc + 8 * fq) = pack8(acc[bj][m][0], acc[bj][m][1]); }
    }
};
__device__ __forceinline__ int tile_expert(const LAS int* base, int rt) { return __builtin_amdgcn_readfirstlane(base[40 + rt]); }
__device__ __forceinline__ void seam_wait(unsigned* f, unsigned target) {
    unsigned sp = 0;
    while (__hip_atomic_load(f, __ATOMIC_RELAXED, __HIP_MEMORY_SCOPE_AGENT) < target) { __builtin_amdgcn_s_sleep(2); if (++sp > (1u << 20)) break; }
    asm volatile("" ::: "memory");
}
struct SchedMoe1 { static constexpr int A_AUX = 0; const char* A; const char* B; const int* rowl; const LAS int* base; unsigned* flag; int nunit, G, c;
    __device__ __forceinline__ bool next(int i, GUnit& u) const { const int Lq = i * G + c; if (Lq >= nunit) return false; const int rt = Lq >> 1, j = Lq & 1, e = tile_expert(base, rt);
        u.pm = rt; u.pn = j; u.aux = e; u.row0 = rt * 256; u.rows = rowl + (size_t)e * T + (rt * 256 - __builtin_amdgcn_readfirstlane(base[e])); u.A = A; u.B = B + ((size_t)e * 512 + 256 * j) * D * 2; return true; }
    __device__ __forceinline__ void a_ready(const GUnit&) const {}
    __device__ __forceinline__ void done(const GUnit& u) const {
        asm volatile("s_waitcnt vmcnt(0)" ::: "memory");
        if ((threadIdx.x & 63) == 0) __hip_atomic_fetch_add(flag + u.pm * 16, 1u, __ATOMIC_RELAXED, __HIP_MEMORY_SCOPE_AGENT); }
};
struct SchedMoe2 { static constexpr int A_AUX = 16; const char* A; const char* B; const LAS int* base; unsigned* flag; int nunit, G, c, heavy;
    __device__ __forceinline__ bool next(int i, GUnit& u) const { if (c < heavy) return false; const int Lq = i * (G - heavy) + (c - heavy); if (Lq >= nunit) return false; const int rt = Lq >> 2, pn = Lq & 3, e = tile_expert(base, rt);
        u.pm = rt; u.pn = pn; u.aux = e; u.row0 = rt * 256; u.rows = nullptr; u.A = A + (size_t)rt * 256 * DE * 2; u.B = B + ((size_t)e * D + 256 * pn) * DE * 2; return true; }
    __device__ __forceinline__ void a_ready(const GUnit& u) const { seam_wait(flag + u.pm * 16, 16u); }
    __device__ __forceinline__ void done(const GUnit&) const {}
};
__device__ __forceinline__ void phase_moe(const Ctx& c, int l) {
    LAS int* base = (LAS int*)(c.lds + 131072); const int* cnt = (const int*)(c.ws + WS_CTL + CTL_CNT) + l * NE;
    expert_bases(cnt, base, c.tid);
    unsigned* flag = (unsigned*)(c.ws + WS_CTL + CTL_MFLAG) + l * 4096;
    const int ntile = __builtin_amdgcn_readfirstlane(base[NE] / 256), n1 = 2 * ntile, heavy = (n1 > c.nb) ? ((n1 - c.nb < c.nb / 2) ? n1 - c.nb : c.nb / 2) : 0;
    { SchedMoe1 S{(const char*)(c.ws + WS_H2), (const char*)(c.ws + WS_WGU), (const int*)(c.ws + WS_INV), base, flag, n1, c.nb, c.bid};
      EpiMoe1 E{(bf16_t*)(c.ws + WS_HID)};
      pg8::gemm_phase<EpiMoe1, SchedMoe1, true, true, true>(c.lds, pg8::Gemm{D, D, opaque_u(D), T}, S, E, c.tid); }
    { SchedMoe2 S{(const char*)(c.ws + WS_HID), (const char*)(c.ws + WS_WD), base, flag, 4 * ntile, c.nb, c.bid, heavy};
      EpiMoe2 E{(bf16_t*)(c.ws + WS_YS)};
      pg8::gemm_phase<EpiMoe2, SchedMoe2, true, true>(c.lds, pg8::Gemm{DE, DE, opaque_u(DE), MAXSLOT}, S, E, c.tid); }
}
template <bool DRY>
__device__ __forceinline__ void phase_combine(const Ctx& c, int l) {
    const int gw = c.bid * NWAVES + c.wave, NGW = c.nb * NWAVES, lane = c.lane;
    const float* mod = (const float*)(c.ws + WS_CTL + CTL_MOD);
    const bf16_t* YS = (const bf16_t*)(c.ws + WS_YS); const i32x4* rt = (const i32x4*)(c.ws + WS_ROUTE); const f32x2* rw = (const f32x2*)(c.ws + WS_ROUTE + 512 * 1024);
    LAS int* base = (LAS int*)(c.lds + 131072); expert_bases((const int*)(c.ws + WS_CTL + CTL_CNT) + l * NE, base, c.tid);
    bf16_t* H = (bf16_t*)(c.ws + WS_H); const bf16_t* X1 = (const bf16_t*)(c.ws + WS_X1);
    for (int m0 = gw; m0 < T; m0 += 4 * NGW) {
        int s1[4], s2[4]; f32x2 w[4]; u32x4 xv[4][2]; u32x4 y1[4][2], y2[4][2];
#pragma unroll
        for (int i = 0; i < 4; ++i) { const int m = (m0 + i * NGW < T) ? m0 + i * NGW : m0; { const i32x4 r = rt[m]; s1[i] = base[r.x] + r.y; s2[i] = base[r.z] + r.w; } w[i] = rw[m];
#pragma unroll
            for (int h = 0; h < 2; ++h) xv[i][h] = *(const u32x4*)(X1 + (size_t)m * D + 8 * lane + 512 * h); }
#pragma unroll
        for (int i = 0; i < 4; ++i)
#pragma unroll
            for (int h = 0; h < 2; ++h) { y1[i][h] = *(const u32x4*)(YS + (size_t)s1[i] * D + 8 * lane + 512 * h); y2[i][h] = *(const u32x4*)(YS + (size_t)s2[i] * D + 8 * lane + 512 * h); }
#pragma unroll
        for (int i = 0; i < 4; ++i) { const int m = m0 + i * NGW; if (m < T) { const int b = m / L; const float* mb = mod + (l * 2 + b) * 6144;
            f32x4 v[4];
#pragma unroll
            for (int h = 0; h < 2; ++h) { const int col = 8 * lane + 512 * h;
#pragma unroll
                for (int e = 0; e < 2; ++e) { const f32x4 gv = *(const f32x4*)(mb + 5 * D + col + 4 * e);
                    const u32x2 xw = e ? (u32x2){xv[i][h].z, xv[i][h].w} : (u32x2){xv[i][h].x, xv[i][h].y}, ya = e ? (u32x2){y1[i][h].z, y1[i][h].w} : (u32x2){y1[i][h].x, y1[i][h].y}, yb = e ? (u32x2){y2[i][h].z, y2[i][h].w} : (u32x2){y2[i][h].x, y2[i][h].y};
                    v[2 * h + e] = unpack4(xw) + gv * (unpack4(ya) * w[i].x + unpack4(yb) * w[i].y); }
                if (DRY) { asm volatile("" :: "v"(v[2 * h]), "v"(v[2 * h + 1])); }
                else if (l == 0) *(u32x4*)((bf16_t*)c.out + (size_t)m * D + col) = pack8(v[2 * h], v[2 * h + 1]);
                else { __builtin_nontemporal_store(v[2 * h], (f32x4*)(c.out + (size_t)m * D + col)); __builtin_nontemporal_store(v[2 * h + 1], (f32x4*)(c.out + (size_t)m * D + col + 4)); } }
            if (l == 0 && !DRY) { const float* m1 = mod + (2 + b) * 6144; norm_row_store(v, c.in[4] + D, m1, m1 + D, H + (size_t)m * D, lane); } } }
    }
    if (l == 0) { LAS float* scr = (LAS float*)(c.lds + c.wave * 8704); convert_items<1>(c, 1, gw, NGW, IT_MOE, scr); }
}

__device__ __forceinline__ void phase_valutest(const Ctx& c) {
    float a[8];
#pragma unroll
    for (int i = 0; i < 8; ++i) a[i] = (float)(c.lane + i);
    const float m = 1.0000001f, b = 1e-9f;
#pragma unroll 1
    for (int it = 0; it < 4096; ++it) {
#pragma unroll
        for (int i = 0; i < 8; ++i) a[i] = fmaf(a[i], m, b);
        asm volatile("" : "+v"(a[0]), "+v"(a[1]), "+v"(a[2]), "+v"(a[3]), "+v"(a[4]), "+v"(a[5]), "+v"(a[6]), "+v"(a[7]));
    }
    float s = 0.f;
#pragma unroll
    for (int i = 0; i < 8; ++i) s += a[i];
    if (s == 12345.678f) ((float*)(c.ws + WS_XS))[c.tid] = s;
}
template <int TB>
__device__ __forceinline__ void phase_memtest(const Ctx& c) {
    const int gw = c.bid * NWAVES + c.wave, NGW = c.nb * NWAVES;
    float* dst = (float*)(c.ws + WS_XS);
    for (int m0 = gw; m0 < T; m0 += TB * NGW) {
        f32x4 v[TB][4];
#pragma unroll
        for (int i = 0; i < TB; ++i) { const int m = (m0 + i * NGW < T) ? m0 + i * NGW : m0;
#pragma unroll
            for (int j = 0; j < 4; ++j) v[i][j] = *(const f32x4*)(c.out + (size_t)m * D + 4 * c.lane + 256 * j); }
#pragma unroll
        for (int i = 0; i < TB; ++i) { const int m = m0 + i * NGW; if (m < T) {
#pragma unroll
            for (int j = 0; j < 4; ++j) *(f32x4*)(dst + (size_t)m * D + 4 * c.lane + 256 * j) = v[i][j]; } }
    }
}

#define XB_TMO      128
#define XB_XCNT(j)  (256  + 64 * (j))
#define XB_XSUB(j)  (1280 + 64 * (j))
#define XB_XGEN(j)  (2304 + 64 * (j))
#define XB_TOP      3328
#define XB_TOPGEN   3392
#define XCD_BAR_WORDS 3456
#define XB_SPIN_CAP (1u << 18)

__device__ __forceinline__ unsigned xb_ld(unsigned* p)              { return __hip_atomic_load(p, __ATOMIC_RELAXED, __HIP_MEMORY_SCOPE_AGENT); }
__device__ __forceinline__ unsigned xb_add(unsigned* p, unsigned v) { return __hip_atomic_fetch_add(p, v, __ATOMIC_RELAXED, __HIP_MEMORY_SCOPE_AGENT); }
__device__ __forceinline__ unsigned xb_xcc_id() { return (unsigned)__builtin_amdgcn_s_getreg((3 << 11) | 20) & 0xFu; }
#define XB_SPIN(cond, bar) do { unsigned _sp = 0; while (cond) { __builtin_amdgcn_s_sleep(1); \
    if ((++_sp & 255u) == 0u) { if (xb_ld(&(bar)[XB_TMO])) break; if (_sp > XB_SPIN_CAP) { atomicAdd(&(bar)[XB_TMO], 1u); break; } } } } while (0)

struct XcdBarrier {
    unsigned* bar; unsigned x;
    volatile LAS unsigned* st;
};

__device__ __forceinline__ XcdBarrier xcd_barrier_post(unsigned* bar, volatile LAS unsigned* st) {
    XcdBarrier b; b.bar = bar; b.x = xb_xcc_id(); b.st = st;
    if (threadIdx.x == 0) (void)xb_add(&bar[XB_XCNT(b.x)], 1u);
    return b;
}
__device__ __forceinline__ void xcd_barrier_complete(unsigned* bar, unsigned x, unsigned& nloc, unsigned& nx) {
    const unsigned G = gridDim.x * gridDim.y * gridDim.z;
    unsigned sum, cnt, mine, sp = 0u;
    for (;;) {
        sum = 0u; cnt = 0u; mine = 0u;
#pragma unroll
        for (unsigned j = 0; j < 16; ++j) { const unsigned c = xb_ld(&bar[XB_XCNT(j)]); sum += c; cnt += (c > 0u) ? 1u : 0u; mine = (j == x) ? c : mine; }
        if (sum == G) break;
        __builtin_amdgcn_s_sleep(1);
        if ((++sp & 255u) == 0u) { if (xb_ld(&bar[XB_TMO])) break; if (sp > XB_SPIN_CAP) { atomicAdd(&bar[XB_TMO], 1u); break; } }
    }
    nloc = mine > 0u ? mine : 1u; nx = cnt > 0u ? cnt : 1u;
}

__device__ __forceinline__ void xcd_barrier(const XcdBarrier& b, bool leader_thread) {
    asm volatile("s_waitcnt vmcnt(0)" ::: "memory");
    __syncthreads();
    if (leader_thread) {
        unsigned* bar = b.bar;
        __builtin_amdgcn_s_waitcnt(0);
        unsigned nloc = b.st[0], nx = b.st[1];
        if (nloc == 0u) { xcd_barrier_complete(bar, b.x, nloc, nx); b.st[0] = nloc; b.st[1] = nx; }
        const unsigned old = xb_add(&bar[XB_XSUB(b.x)], 1u);
        const unsigned gen = old / nloc;
        if (old + 1u == (gen + 1u) * nloc) {
            __builtin_amdgcn_fence(__ATOMIC_RELEASE, "agent");
            asm volatile("s_waitcnt vmcnt(0)" ::: "memory");
            const unsigned og = xb_add(&bar[XB_TOP], 1u);
            const unsigned tg = og / nx;
            if (og + 1u == (tg + 1u) * nx) xb_add(&bar[XB_TOPGEN], 1u);
            else XB_SPIN(xb_ld(&bar[XB_TOPGEN]) == tg, bar);
            __builtin_amdgcn_fence(__ATOMIC_ACQUIRE, "agent");
            xb_add(&bar[XB_XGEN(b.x)], 1u);
            asm volatile("s_waitcnt vmcnt(0)" ::: "memory");
        } else {
            XB_SPIN(xb_ld(&bar[XB_XGEN(b.x)]) == gen, bar);
            __builtin_amdgcn_fence(__ATOMIC_ACQUIRE, "agent");
            asm volatile("s_waitcnt vmcnt(0)" ::: "memory");
        }
    }
    __syncthreads();
}

__global__ void __launch_bounds__(NTHREADS, 2) __attribute__((amdgpu_waves_per_eu(2, 2))) mega(Params p) {
    extern __shared__ __attribute__((aligned(16))) unsigned char lds[];
    Ctx c; c.in = p.in; c.out = p.out; c.ws = p.ws; c.lds = (LAS unsigned char*)lds;
    c.tid = threadIdx.x; c.lane = c.tid & 63; c.wave = __builtin_amdgcn_readfirstlane(c.tid >> 6); c.bid = blockIdx.x; c.nb = gridDim.x;
    const int lo = p.ph_lo, hi = p.ph_hi;
#if ONE_LAUNCH
    volatile LAS unsigned* bmisc = (volatile LAS unsigned*)(c.lds + LDS_BYTES - 64);
    if (c.tid < 16) bmisc[c.tid] = 0u;
    __syncthreads();
    const XcdBarrier bar = xcd_barrier_post((unsigned*)(p.ws + WS_CTL + CTL_BAR), bmisc);
#define SEAM(k) do { if ((k) + 1 < hi) xcd_barrier(bar, cc.tid == 0); } while (0)
#else
#define SEAM(k) do { } while (0)
#endif
#ifdef ONLY_PHASE
#define IN(k) ((k) == ONLY_PHASE)
#else
#define IN(k) (lo <= (k) && (k) < hi)
#endif
#ifndef REP_PH
#define REP_PH -1
#define REP_N 1
#endif
#define PHASE(k, call) do { if (IN(k)) for (int rep_ = 0; rep_ < (((k) == REP_PH) ? REP_N : 1); ++rep_) { Ctx cc = c; cc.ws = opaque_p(cc.ws); cc.out = opaque_p(cc.out); cc.wave = opaque_u(cc.wave); cc.lane = (int)__builtin_amdgcn_mbcnt_hi(~0u, __builtin_amdgcn_mbcnt_lo(~0u, 0u)); cc.tid = cc.wave * 64 + cc.lane; asm volatile("" : "+v"(cc.tid), "+v"(cc.lane)); cc.bid = opaque_u(cc.bid); cc.nb = opaque_u(cc.nb); call; SEAM(k); } } while (0)
    PHASE(0, phase_prep(cc));
    PHASE(1, phase_norm1(cc, 0));
#ifdef DUP_MODE
#define DUPX(k, call) PHASE(k, call)
#else
#define DUPX(k, call)
#endif
#ifndef DUP_PH
#define DUP_PH -1
#endif
#ifndef DUP_PART
#define DUP_PART 3
#endif
#define DUPQ(r, k, call) do { if (DUP_PH == (r)) PHASE(k, call); } while (0)
#define LAYER(l) do { constexpr int p0 = 2 + 10 * (l); \
        DUPQ(0, p0 + 0, phase_gemm_in(cc, l)); \
        PHASE(p0 + 0, phase_gemm_in(cc, l)); \
        DUPQ(1, p0 + 1, phase_post_conv<DUP_PART>(cc, l)); \
        PHASE(p0 + 1, phase_post_conv<3>(cc, l)); \
        DUPX(p0 + 2, phase_idx_attn<DUP_MODE>(cc, l)); \
        PHASE(p0 + 2, phase_idx_attn<0>(cc, l)); \
        DUPQ(3, p0 + 3, phase_gemm_d1(cc, l)); \
        PHASE(p0 + 3, phase_gemm_d1(cc, l)); \
        PHASE(p0 + 4, phase_gemm_d2(cc, l)); \
        DUPQ(53, p0 + 5, (void)0); \
        DUPQ(54, p0 + 5, (void)0); DUPQ(54, p0 + 5, (void)0); DUPQ(54, p0 + 5, (void)0); DUPQ(54, p0 + 5, (void)0); \
        DUPQ(52, p0 + 5, phase_valutest(cc)); \
        DUPQ(50, p0 + 5, phase_memtest<4>(cc)); \
        DUPQ(51, p0 + 5, phase_memtest<8>(cc)); \
        DUPQ(5, p0 + 5, phase_norm2_route<true>(cc, l)); \
        PHASE(p0 + 5, phase_norm2_route<false>(cc, l)); \
        PHASE(p0 + 7, phase_moe(cc, l)); \
        DUPQ(9, p0 + 9, phase_combine<true>(cc, l)); \
        PHASE(p0 + 9, phase_combine<false>(cc, l)); } while (0)
    LAYER(0);
    LAYER(1);
#undef LAYER
#undef PHASE
#undef IN
#undef SEAM
}

extern "C" void kernel_launch(void* const* d_in, const int* in_sizes, int n_in, void* d_out, int out_size, void* d_ws, size_t ws_size, hipStream_t stream) {
    static int grid = 0;
    if (grid == 0) {
        if (n_in != 24 || out_size != T * D || ws_size < WS_END) { fprintf(stderr, "kernel_launch: unexpected shapes (n_in %d out %d ws %zu)\n", n_in, out_size, ws_size); grid = -1; return; }
        int dev = 0, cus = 0, per_cu = 0;
        hipGetDevice(&dev); hipDeviceGetAttribute(&cus, hipDeviceAttributeMultiprocessorCount, dev);
        if (hipFuncSetAttribute((const void*)mega, hipFuncAttributeMaxDynamicSharedMemorySize, LDS_BYTES) != hipSuccess) { fprintf(stderr, "kernel_launch: hipFuncSetAttribute failed\n"); grid = -1; return; }
        if (hipOccupancyMaxActiveBlocksPerMultiprocessor(&per_cu, (const void*)mega, NTHREADS, LDS_BYTES) != hipSuccess || per_cu < 1) { fprintf(stderr, "kernel_launch: occupancy query says %d\n", per_cu); per_cu = 1; }
        (void)hipGetLastError();
        grid = cus;
    }
    if (grid < 0) return;
    hipMemsetAsync((char*)d_ws + WS_CTL, 0, CTL_ZERO, stream);
    Params p{};
    for (int i = 0; i < 24; ++i) p.in[i] = (const float*)d_in[i];
    p.out = (float*)d_out; p.ws = (unsigned char*)d_ws;
#if ONE_LAUNCH
    p.ph_lo = 0; p.ph_hi = NPH;
    hipLaunchKernelGGL(mega, dim3(grid), dim3(NTHREADS), LDS_BYTES, stream, p);
#else
    for (int ph = 0; ph < NPH; ++ph) { p.ph_lo = ph; p.ph_hi = ph + 1; hipLaunchKernelGGL(mega, dim3(grid), dim3(NTHREADS), LDS_BYTES, stream, p); }
#endif
}
```
